# Optimizing an MI355X kernel written in HIP

```python
import jax
import jax.numpy as jnp
from jax import lax
import numpy as np

D_MODEL = 2048
BATCH = 2
SEQ = 8192
DEPTH = 1

PLE_DIM = 256
NORM_EPS = 1e-6

RWKV_HEADS = 16
RWKV_HEAD = 64
RWKV_WIDTH = RWKV_HEADS * RWKV_HEAD
DECAY_LORA = 64
AAA_LORA = 64
GATE_LORA = 160
GN_EPS = 64e-5

MLA_HEADS = 8
Q_LORA = 512
KV_LORA = 512
QK_NOPE = 128
QK_ROPE = 64
QK_HEAD = QK_NOPE + QK_ROPE
V_HEAD = 128
MLA_WIDTH = MLA_HEADS * V_HEAD
ROPE_THETA = 10000.0
Q_BLOCK = 128

N_EXPERTS = 64
TOP_K = 8
N_GROUPS = 8
TOPK_GROUPS = 4
MOE_INTER = 512
SHARED_INTER = 512
ROUTED_SCALE = 2.5
EXPERT_BLOCK = 128

RWKV_COLS = 3 * RWKV_WIDTH + DECAY_LORA + AAA_LORA + GATE_LORA
MLA_COLS = Q_LORA + KV_LORA + QK_ROPE
GATE_COLS = 2 * D_MODEL
IN_COLS = RWKV_COLS + MLA_COLS + GATE_COLS

kernel_name = 'hybrid_rwkv7_mla_moe_ple'


def rms_norm(x, g, eps=NORM_EPS):
    xf = x.astype(jnp.float32)
    y = xf * lax.rsqrt(jnp.mean(xf * xf, axis=-1, keepdims=True) + eps)
    return (y * g.astype(jnp.float32)).astype(x.dtype)


def token_shift_mix(u, mu):
    prev = jnp.pad(u, ((0, 0), (1, 0), (0, 0)))[:, :-1]
    return u + (prev - u) * mu


def rwkv7_time_mix(u, w0, w2, a0, a2, g2, k_k, k_a, r_k, gn_w, gn_b):
    B, S, _ = u.shape
    H, N = RWKV_HEADS, RWKV_HEAD
    f32 = jnp.float32
    cuts = [RWKV_WIDTH, 2 * RWKV_WIDTH, 3 * RWKV_WIDTH,
            3 * RWKV_WIDTH + DECAY_LORA, 3 * RWKV_WIDTH + DECAY_LORA + AAA_LORA]
    r, k, v, dw, da, dg = jnp.split(u.astype(f32), cuts, axis=-1)
    w_log = -jax.nn.softplus(-(w0 + jnp.tanh(dw) @ w2)) - 0.5
    decay = jnp.exp(-jnp.exp(w_log))
    a = jax.nn.sigmoid(a0 + da @ a2)
    g = jax.nn.sigmoid(dg) @ g2
    heads = lambda t: t.reshape(B, S, H, N)
    r, k, v, a, decay = heads(r), heads(k), heads(v), heads(a), heads(decay)
    kk = k * k_k
    kk = kk / jnp.maximum(jnp.linalg.norm(kk, axis=-1, keepdims=True), 1e-12)
    k = k * (1.0 + (a - 1.0) * k_a)

    def step(state, inp):
        r_t, w_t, k_t, v_t, kk_t, a_t = inp
        sk = jnp.einsum('bhij,bhj->bhi', state, kk_t)
        state = (state * w_t[:, :, None, :]
                 - sk[..., None] * (kk_t * a_t)[:, :, None, :]
                 + v_t[..., None] * k_t[:, :, None, :])
        return state, jnp.einsum('bhij,bhj->bhi', state, r_t)

    xs = tuple(jnp.moveaxis(t, 1, 0) for t in (r, decay, k, v, kk, a))
    _, ys = lax.scan(step, jnp.zeros((B, H, N, N), f32), xs)
    y = jnp.moveaxis(ys, 0, 1)
    mean = jnp.mean(y, axis=-1, keepdims=True)
    var = jnp.mean(jnp.square(y - mean), axis=-1, keepdims=True)
    y = (y - mean) * lax.rsqrt(var + GN_EPS) * gn_w.reshape(H, N) + gn_b.reshape(H, N)
    y = y + jnp.sum(r * k * r_k, axis=-1, keepdims=True) * v
    return (y.reshape(B, S, RWKV_WIDTH) * g).astype(u.dtype)


def rope(t, positions):
    half = QK_ROPE // 2
    inv_freq = ROPE_THETA ** (-jnp.arange(half, dtype=jnp.float32) / half)
    ang = positions.astype(jnp.float32)[..., None] * inv_freq
    cos = jnp.cos(ang)[:, :, None, :]
    sin = jnp.sin(ang)[:, :, None, :]
    tf = t.astype(jnp.float32)
    t1, t2 = tf[..., :half], tf[..., half:]
    return jnp.concatenate([t1 * cos - t2 * sin, t1 * sin + t2 * cos], axis=-1).astype(t.dtype)


def causal_attention(q, k, v):
    B, S, H, Dh = q.shape
    nb = S // Q_BLOCK
    scale = Dh ** -0.5
    kf = k.astype(jnp.float32)
    vf = v.astype(jnp.float32)
    qb = jnp.moveaxis(q.astype(jnp.float32).reshape(B, nb, Q_BLOCK, H, Dh), 1, 0)
    key_pos = jnp.arange(S)

    def block(args):
        q_blk, start = args
        s = jnp.einsum('bqhd,bkhd->bhqk', q_blk, kf) * scale
        causal = key_pos[None, :] <= (start + jnp.arange(Q_BLOCK))[:, None]
        s = jnp.where(causal, s, -jnp.inf)
        return jnp.einsum('bhqk,bkhd->bqhd', jax.nn.softmax(s, axis=-1), vf)

    out = lax.map(block, (qb, jnp.arange(nb) * Q_BLOCK))
    return jnp.moveaxis(out, 0, 1).reshape(B, S, H, v.shape[-1]).astype(v.dtype)


def mla(cq, ckv, k_rope, positions, g_qa, g_kva, w_uq, w_ukv, g_qn, g_kn):
    B, S, _ = cq.shape
    H = MLA_HEADS
    q = (rms_norm(cq, g_qa) @ w_uq).reshape(B, S, H, QK_HEAD)
    kv = (rms_norm(ckv, g_kva) @ w_ukv).reshape(B, S, H, QK_NOPE + V_HEAD)
    k_nope, v = kv[..., :QK_NOPE], kv[..., QK_NOPE:]
    k = jnp.concatenate([k_nope, jnp.broadcast_to(k_rope[:, :, None, :], (B, S, H, QK_ROPE))], axis=-1)
    q = rms_norm(q, g_qn)
    k = rms_norm(k, g_kn)
    q = jnp.concatenate([q[..., :QK_NOPE], rope(q[..., QK_NOPE:], positions)], axis=-1)
    k = jnp.concatenate([k[..., :QK_NOPE], rope(k[..., QK_NOPE:], positions)], axis=-1)
    return causal_attention(q, k, v).reshape(B, S, MLA_WIDTH)


def swiglu(h, w_gate, w_up, w_down):
    return (jax.nn.silu(h @ w_gate) * (h @ w_up)) @ w_down


def moe_route(h, w_router, router_bias):
    T = h.shape[0]
    scores = jax.nn.sigmoid(h.astype(jnp.float32) @ w_router.astype(jnp.float32))
    choice = scores + router_bias.astype(jnp.float32)
    grp = choice.reshape(T, N_GROUPS, N_EXPERTS // N_GROUPS)
    grp_score = jnp.sum(lax.top_k(grp, 2)[0], axis=-1)
    _, gidx = lax.top_k(grp_score, TOPK_GROUPS)
    gmask = jnp.any(gidx[..., None] == jnp.arange(N_GROUPS), axis=-2)
    emask = jnp.repeat(gmask, N_EXPERTS // N_GROUPS, axis=-1)
    _, eidx = lax.top_k(jnp.where(emask, choice, -jnp.inf), TOP_K)
    wts = jnp.take_along_axis(scores, eidx, axis=-1)
    wts = wts / (jnp.sum(wts, axis=-1, keepdims=True) + 1e-20) * ROUTED_SCALE
    return eidx, wts


def moe_routed(h, eidx, wts, w_gate, w_up, w_down):
    T, Dm = h.shape
    E, BLK = N_EXPERTS, EXPERT_BLOCK
    A = T * TOP_K
    flat_e = eidx.reshape(-1).astype(jnp.int32)
    flat_tok = jnp.repeat(jnp.arange(T, dtype=jnp.int32), TOP_K)
    flat_w = wts.reshape(-1)
    order = jnp.argsort(flat_e)
    se, stok, sw = flat_e[order], flat_tok[order], flat_w[order]
    counts = jnp.bincount(flat_e, length=E).astype(jnp.int32)
    starts = jnp.cumsum(counts) - counts
    pcounts = (counts + BLK - 1) // BLK * BLK
    pends = jnp.cumsum(pcounts)
    pstarts = pends - pcounts
    dest = pstarts[se] + jnp.arange(A, dtype=jnp.int32) - starts[se]
    P = ((A + BLK - 1) // BLK + E) * BLK
    nblk = P // BLK
    row_tok = jnp.full((P,), T, jnp.int32).at[dest].set(stok)
    row_w = jnp.zeros((P,), jnp.float32).at[dest].set(sw)
    blk_e = jnp.clip(jnp.searchsorted(pends, jnp.arange(nblk, dtype=jnp.int32) * BLK, side='right'), 0, E - 1)
    h_pad = jnp.concatenate([h, jnp.zeros((1, Dm), h.dtype)], axis=0)

    def body(acc, blk):
        tok, w, e = blk
        xb = h_pad[tok]
        y = swiglu(xb, w_gate[e], w_up[e], w_down[e])
        return acc.at[tok].add((y * w[:, None]).astype(acc.dtype)), None

    acc, _ = lax.scan(body, jnp.zeros((T + 1, Dm), h.dtype),
                      (row_tok.reshape(nblk, BLK), row_w.reshape(nblk, BLK), blk_e))
    return acc[:T]


def setup_inputs(seed: int = 0) -> dict:
    key = jax.random.key(seed)
    counter = [0]
    f32 = jnp.float32

    def nk():
        counter[0] += 1
        return jax.random.fold_in(key, counter[0])

    def nrm(shape, scale=1.0):
        return jax.random.normal(nk(), shape, f32) * scale

    def gain(shape):
        return 1.0 + 0.02 * jax.random.normal(nk(), shape, f32)

    L, D = DEPTH, D_MODEL
    x = nrm((BATCH, SEQ, D))
    p = nrm((L, BATCH, SEQ, PLE_DIM))
    offsets = jax.random.randint(nk(), (BATCH, 1), 0, 1024, dtype=jnp.int32)
    positions = offsets + jnp.arange(SEQ, dtype=jnp.int32)[None, :]
    return {
        'x': x,
        'p': p,
        'positions': positions,
        'g_mix': gain((L, D)),
        'w_in': nrm((L, D, IN_COLS), D ** -0.5),
        'mu_rwkv': jax.random.uniform(nk(), (L, RWKV_COLS), f32),
        'w0': jax.random.uniform(nk(), (L, RWKV_WIDTH), f32, -6.0, 1.0),
        'w2': nrm((L, DECAY_LORA, RWKV_WIDTH), 0.5 * DECAY_LORA ** -0.5),
        'a0': nrm((L, RWKV_WIDTH), 0.5),
        'a2': nrm((L, AAA_LORA, RWKV_WIDTH), AAA_LORA ** -0.5),
        'g2': nrm((L, GATE_LORA, RWKV_WIDTH), GATE_LORA ** -0.5),
        'k_k': 1.0 + 0.1 * nrm((L, RWKV_HEADS, RWKV_HEAD)),
        'k_a': 1.0 + 0.1 * nrm((L, RWKV_HEADS, RWKV_HEAD)),
        'r_k': nrm((L, RWKV_HEADS, RWKV_HEAD), 0.1),
        'gn_w': gain((L, RWKV_WIDTH)),
        'gn_b': nrm((L, RWKV_WIDTH), 0.02),
        'w_a_up': nrm((L, RWKV_WIDTH, D), RWKV_WIDTH ** -0.5),
        'g_qa': gain((L, Q_LORA)),
        'g_kva': gain((L, KV_LORA)),
        'w_uq': nrm((L, Q_LORA, MLA_HEADS * QK_HEAD), Q_LORA ** -0.5),
        'w_ukv': nrm((L, KV_LORA, MLA_HEADS * (QK_NOPE + V_HEAD)), KV_LORA ** -0.5),
        'g_qn': gain((L, QK_HEAD)),
        'g_kn': gain((L, QK_HEAD)),
        'w_b_up': nrm((L, MLA_WIDTH, D), MLA_WIDTH ** -0.5),
        'w_o': nrm((L, D, D), D ** -0.5),
        'g_ffn': gain((L, D)),
        'w_router': nrm((L, D, N_EXPERTS), D ** -0.5),
        'router_bias': nrm((L, N_EXPERTS), 0.01),
        'w_exp_gate': nrm((L, N_EXPERTS, D, MOE_INTER), D ** -0.5),
        'w_exp_up': nrm((L, N_EXPERTS, D, MOE_INTER), D ** -0.5),
        'w_exp_down': nrm((L, N_EXPERTS, MOE_INTER, D), MOE_INTER ** -0.5),
        'w_sh_gate': nrm((L, D, SHARED_INTER), D ** -0.5),
        'w_sh_up': nrm((L, D, SHARED_INTER), D ** -0.5),
        'w_sh_down': nrm((L, SHARED_INTER, D), SHARED_INTER ** -0.5),
        'w_ple': nrm((L, PLE_DIM, D), PLE_DIM ** -0.5),
        'g_ple_post': gain((L, D)),
        'g_ple_in': gain((L, D)),
        'w_ple_gate': nrm((L, D, D), D ** -0.5),
    }


def reference(x, p, positions, g_mix, w_in, mu_rwkv, w0, w2, a0, a2, g2, k_k, k_a, r_k,
              gn_w, gn_b, w_a_up, g_qa, g_kva, w_uq, w_ukv, g_qn, g_kn, w_b_up, w_o,
              g_ffn, w_router, router_bias, w_exp_gate, w_exp_up, w_exp_down,
              w_sh_gate, w_sh_up, w_sh_down, w_ple, g_ple_post, g_ple_in, w_ple_gate):
    B, S, Dm = x.shape
    for i in range(DEPTH):
        h = rms_norm(x, g_mix[i])
        proj = h @ w_in[i]
        u_rwkv, u_mla, gate_a, gate_b = jnp.split(
            proj, [RWKV_COLS, RWKV_COLS + MLA_COLS, RWKV_COLS + MLA_COLS + D_MODEL], axis=-1)
        u_rwkv = token_shift_mix(u_rwkv, mu_rwkv[i])
        o_a = rwkv7_time_mix(u_rwkv, w0[i], w2[i], a0[i], a2[i], g2[i], k_k[i], k_a[i],
                             r_k[i], gn_w[i], gn_b[i])
        cq, ckv, k_rope = jnp.split(u_mla, [Q_LORA, Q_LORA + KV_LORA], axis=-1)
        o_b = mla(cq, ckv, k_rope, positions, g_qa[i], g_kva[i], w_uq[i], w_ukv[i],
                  g_qn[i], g_kn[i])
        merged = (jax.nn.sigmoid(gate_a) * (o_a @ w_a_up[i])
                  + jax.nn.sigmoid(gate_b) * (o_b @ w_b_up[i]))
        x = x + merged @ w_o[i]
        h2 = rms_norm(x, g_ffn[i]).reshape(B * S, Dm)
        eidx, wts = moe_route(h2, w_router[i], router_bias[i])
        moe = (swiglu(h2, w_sh_gate[i], w_sh_up[i], w_sh_down[i])
               + moe_routed(h2, eidx, wts, w_exp_gate[i], w_exp_up[i], w_exp_down[i]))
        x = x + moe.reshape(B, S, Dm)
        ple = rms_norm(p[i] @ w_ple[i], g_ple_post[i])
        ple_gate = jax.nn.sigmoid(rms_norm(x, g_ple_in[i]) @ w_ple_gate[i])
        x = x + ple_gate * ple
    return x
```

```cpp
#include <hip/hip_runtime.h>
#include <cstdio>
#include <cstdint>

#define GAS __attribute__((address_space(1)))
#define LAS __attribute__((address_space(3)))
typedef unsigned short bf16_t;
typedef short bf16x8 __attribute__((ext_vector_type(8)));
typedef float f32x4 __attribute__((ext_vector_type(4)));
typedef float f32x16 __attribute__((ext_vector_type(16)));
typedef unsigned u32x4 __attribute__((ext_vector_type(4)));
typedef unsigned u32x2 __attribute__((ext_vector_type(2)));

constexpr int T = 16384, SEQ = 8192, NB = 2, D = 2048;
constexpr int NPH = 19;
constexpr float NORM_EPS = 1e-6f, GN_EPS = 64e-5f;
constexpr int NTH = 288;
constexpr int PMAX = 147456;

constexpr size_t MiB = 1u << 20;
constexpr size_t WS_CTL = 0, ZERO_BYTES = 8 * MiB;
constexpr size_t WS_WL = 1 * MiB;
constexpr size_t WS_WR = 4 * MiB;
constexpr size_t WS_WIN8G = 26 * MiB  , WS_HB8 = 316 * MiB  ;
constexpr size_t WS_WIN = 8 * MiB;
constexpr size_t WS_WUQ = 42 * MiB, WS_WUKV = 44 * MiB, WS_WA = 46 * MiB, WS_WB = 50 * MiB, WS_WO = 54 * MiB;
constexpr size_t WS_WSHGU = 62 * MiB, WS_WSHD = 66 * MiB, WS_WPLE = 68 * MiB, WS_WPG = 70 * MiB, WS_PBF = 78 * MiB;
constexpr size_t WS_SMALL = 86 * MiB;
constexpr size_t WS_RSTDQ = WS_SMALL, WS_RSTDKV = WS_SMALL + 65536, WS_RSTDP = WS_SMALL + 2 * 65536, WS_BONUS = WS_SMALL + 3 * 65536;
constexpr size_t WS_EIDX = WS_SMALL + 2 * MiB, WS_WTS = WS_EIDX + 512 * 1024, WS_POS = WS_WTS + 512 * 1024, WS_SLOT = WS_POS + 512 * 1024;
constexpr size_t WS_ROWTOK = WS_SMALL + 4 * MiB, WS_ROWW = WS_ROWTOK + 640 * 1024, WS_TILEE = WS_ROWW + 640 * 1024;
constexpr size_t WS_GATES = 92 * MiB, WS_OM = 220 * MiB, WS_AA = 252 * MiB, WS_GG = 284 * MiB;
constexpr size_t WS_R = 636 * MiB, WS_KP = 668 * MiB, WS_KK = 812 * MiB, WS_BB = 968 * MiB, WS_VB = 444 * MiB, WS_RECB = 316 * MiB  , WS_YDBG = 1020 * MiB  , WS_QF = 476 * MiB, WS_KF = 524 * MiB, WS_VTF = 572 * MiB;
constexpr size_t WS_Y = 604 * MiB, WS_OB = 252 * MiB  , WS_OA = 316 * MiB  , WS_MERGED = 476 * MiB  , WS_MERGED8 = 540 * MiB  ;
constexpr size_t WS_WEG = 636 * MiB, WS_WED = 892 * MiB, WS_H2F8 = 764 * MiB;
constexpr size_t WS_H = 636 * MiB, WS_RKV = 700 * MiB, WS_MISC = 796 * MiB, WS_CQKV = 812 * MiB, WS_L = 844 * MiB, WS_QRAW = 856 * MiB, WS_KVRAW = 904 * MiB;
constexpr size_t WS_H2 = 92 * MiB, WS_LOGIT = 220 * MiB  , WS_ACTSH = 252 * MiB, WS_ACT = 268 * MiB, WS_PLERAW = 412 * MiB;
constexpr size_t WS_YSH = 92 * MiB  ;
constexpr size_t WS_Y2 = 92 * MiB, WS_Y2B = 476 * MiB, WS_XN3 = 268 * MiB;
constexpr int Y2A_TILES = 176;
constexpr float ACT8_SCALE = 8.f, W8_SCALE = 64.f;
constexpr float O8_SCALE = 4.f;
constexpr float Y8_SCALE = 8.f;
constexpr size_t WS_END = 1020 * MiB;
static_assert(WS_AA == WS_OM + 32 * MiB && WS_GG == WS_AA + 32 * MiB && WS_ACT + (size_t)PMAX * 512 * 2 <= WS_PLERAW && WS_Y2 + (size_t)Y2A_TILES * MiB <= WS_ACT && WS_Y2B + (size_t)(PMAX / 256 - Y2A_TILES) * MiB <= WS_WED
              && WS_PLERAW + 64 * MiB <= WS_Y2B && WS_KVRAW + 64 * MiB <= WS_END, "ws map");
constexpr int CW_BAR = 4096, CW_CNT = 65536, CW_ATTQ = 66560, CW_CVQ = 67072, CW_CVH = 67136, CW_DBG = 67200;
#ifndef CHUNKED
#define CHUNKED 1
#endif
#ifndef CHUNK_DEBUG
#define CHUNK_DEBUG 0
#endif
#ifndef DBG_GAIN
#define DBG_GAIN 30.0f
#endif
#ifndef DBG_TMAX
#define DBG_TMAX 8192
#endif

constexpr int RING_BYTES = 131072, LDSCTL_OFF = RING_BYTES, LDS_BYTES = 147456;

#define LDS_WAIT() asm volatile("s_waitcnt lgkmcnt(0)" ::: "memory")
#define VM_WAIT() asm volatile("s_waitcnt vmcnt(0)" ::: "memory")
__device__ __forceinline__ unsigned f2bf(float f) { unsigned u = __builtin_bit_cast(unsigned, f); return (u + 0x7fffu + ((u >> 16) & 1u)) >> 16; }
__device__ __forceinline__ unsigned pk2(float lo, float hi) { return f2bf(lo) | (f2bf(hi) << 16); }
__device__ __forceinline__ int fbits(float x) { return __builtin_bit_cast(int, x); }
__device__ __forceinline__ float bf2f(unsigned b) { return __builtin_bit_cast(float, b << 16); }
__device__ __forceinline__ float bflo(unsigned w) { return __builtin_bit_cast(float, w << 16); }
__device__ __forceinline__ float bfhi(unsigned w) { return __builtin_bit_cast(float, w & 0xffff0000u); }
__device__ __forceinline__ unsigned cvt_pk_bf16(float lo, float hi) { unsigned r; asm volatile("v_cvt_pk_bf16_f32 %0, %1, %2" : "=v"(r) : "v"(lo), "v"(hi)); return r; }
__device__ __forceinline__ u32x4 pack8(f32x4 a, f32x4 b) { unsigned x, y, z, w;
    asm volatile("s_nop 0\n\tv_cvt_pk_bf16_f32 %0, %4, %5\n\tv_cvt_pk_bf16_f32 %1, %6, %7\n\tv_cvt_pk_bf16_f32 %2, %8, %9\n\tv_cvt_pk_bf16_f32 %3, %10, %11"
                 : "=&v"(x), "=&v"(y), "=&v"(z), "=&v"(w) : "v"(a[0]), "v"(a[1]), "v"(a[2]), "v"(a[3]), "v"(b[0]), "v"(b[1]), "v"(b[2]), "v"(b[3]));
    return (u32x4){x, y, z, w}; }
__device__ __forceinline__ void unpack8(u32x4 w, float (&v)[8]) { v[0] = bflo(w.x); v[1] = bfhi(w.x); v[2] = bflo(w.y); v[3] = bfhi(w.y); v[4] = bflo(w.z); v[5] = bfhi(w.z); v[6] = bflo(w.w); v[7] = bfhi(w.w); }
__device__ __forceinline__ unsigned pk4_fp8(f32x4 v) {
    const float a = __builtin_amdgcn_fmed3f(v[0], -448.f, 448.f), b = __builtin_amdgcn_fmed3f(v[1], -448.f, 448.f), c = __builtin_amdgcn_fmed3f(v[2], -448.f, 448.f), d = __builtin_amdgcn_fmed3f(v[3], -448.f, 448.f);
    int r = 0; r = __builtin_amdgcn_cvt_pk_fp8_f32(a, b, r, false); r = __builtin_amdgcn_cvt_pk_fp8_f32(c, d, r, true); return (unsigned)r; }
__device__ __forceinline__ float sigmoidf_(float x) { return __builtin_amdgcn_rcpf(1.0f + __expf(-x)); }
__device__ __forceinline__ float wave_sum(float v) {
#pragma unroll
    for (int o = 1; o < 64; o <<= 1) v += __shfl_xor(v, o);
    return v;
}

#define XB_TMO      128
#define XB_XCNT(j)  (256  + 64 * (j))
#define XB_XSUB(j)  (1280 + 64 * (j))
#define XB_XGEN(j)  (2304 + 64 * (j))
#define XB_TOP      3328
#define XB_TOPGEN   3392
#define XCD_BAR_WORDS 3456
#define XB_SPIN_CAP (1u << 22)
__device__ __forceinline__ unsigned xb_ld(unsigned* p)              { return __hip_atomic_load(p, __ATOMIC_RELAXED, __HIP_MEMORY_SCOPE_AGENT); }
__device__ __forceinline__ unsigned xb_add(unsigned* p, unsigned v) { return __hip_atomic_fetch_add(p, v, __ATOMIC_RELAXED, __HIP_MEMORY_SCOPE_AGENT); }
__device__ __forceinline__ unsigned xb_xcc_id() { return (unsigned)__builtin_amdgcn_s_getreg((3 << 11) | 20) & 0xFu; }
#define XB_SPIN(cond, bar) do { unsigned _sp = 0; while (cond) { __builtin_amdgcn_s_sleep(1); \
    if ((++_sp & 255u) == 0u) { if (xb_ld(&(bar)[XB_TMO])) break; if (_sp > XB_SPIN_CAP) { atomicAdd(&(bar)[XB_TMO], 1u); break; } } } } while (0)
struct XcdBarrier { unsigned* bar; unsigned x; volatile LAS unsigned* st; };
__device__ __forceinline__ XcdBarrier xcd_barrier_post(unsigned* bar, volatile LAS unsigned* st) {
    XcdBarrier b; b.bar = bar; b.x = xb_xcc_id(); b.st = st;
    if (threadIdx.x == 0) (void)xb_add(&bar[XB_XCNT(b.x)], 1u);
    return b;
}
__device__ __forceinline__ void xcd_barrier_complete(unsigned* bar, unsigned x, unsigned& nloc, unsigned& nx) {
    const unsigned G = gridDim.x * gridDim.y * gridDim.z;
    unsigned sum, cnt, mine, sp = 0u;
    for (;;) {
        sum = 0u; cnt = 0u; mine = 0u;
#pragma unroll
        for (unsigned j = 0; j < 16; ++j) { const unsigned c = xb_ld(&bar[XB_XCNT(j)]); sum += c; cnt += (c > 0u) ? 1u : 0u; mine = (j == x) ? c : mine; }
        if (sum == G) break;
        __builtin_amdgcn_s_sleep(1);
        if ((++sp & 255u) == 0u) { if (xb_ld(&bar[XB_TMO])) break; if (sp > XB_SPIN_CAP) { atomicAdd(&bar[XB_TMO], 1u); break; } }
    }
    nloc = mine > 0u ? mine : 1u; nx = cnt > 0u ? cnt : 1u;
}
__device__ __forceinline__ void xcd_barrier(const XcdBarrier& b) {
    asm volatile("s_waitcnt vmcnt(0)" ::: "memory");
    __syncthreads();
    if (threadIdx.x == 0) {
        unsigned* bar = b.bar;
        __builtin_amdgcn_s_waitcnt(0);
        unsigned nloc = b.st[0], nx = b.st[1];
        if (nloc == 0u) { xcd_barrier_complete(bar, b.x, nloc, nx); b.st[0] = nloc; b.st[1] = nx; }
        const unsigned old = xb_add(&bar[XB_XSUB(b.x)], 1u);
        const unsigned gen = old / nloc;
        if (old + 1u == (gen + 1u) * nloc) {
            __builtin_amdgcn_fence(__ATOMIC_RELEASE, "agent");
            asm volatile("s_waitcnt vmcnt(0)" ::: "memory");
            const unsigned og = xb_add(&bar[XB_TOP], 1u);
            const unsigned tg = og / nx;
            if (og + 1u == (tg + 1u) * nx) xb_add(&bar[XB_TOPGEN], 1u);
            else XB_SPIN(xb_ld(&bar[XB_TOPGEN]) == tg, bar);
            __builtin_amdgcn_fence(__ATOMIC_ACQUIRE, "agent");
            xb_add(&bar[XB_XGEN(b.x)], 1u);
            asm volatile("s_waitcnt vmcnt(0)" ::: "memory");
        } else {
            XB_SPIN(xb_ld(&bar[XB_XGEN(b.x)]) == gen, bar);
            __builtin_amdgcn_fence(__ATOMIC_ACQUIRE, "agent");
            asm volatile("s_waitcnt vmcnt(0)" ::: "memory");
        }
    }
    __syncthreads();
}

namespace pg8 {
constexpr int BM = 256, BK = 64, HALF = 128, HTB = HALF * BK * 2, STAGE_BYTES = 8 * HTB, NXCD = 8, WGM = 8;
__host__ __device__ __forceinline__ int lds_byte(int r, int c) { const int st = (r >> 4) * 2 + (c >> 5), rr = r & 15, cc = c & 31, ob = rr * 64 + cc * 2; return st * 1024 + (ob ^ (((ob >> 9) & 1) << 5)); }
__host__ __device__ __forceinline__ void stage_rc(int b, int& R, int& C) { const int st = b / 1024, sb = b % 1024, swz = sb ^ (((sb >> 9) & 1) << 5); R = (st >> 1) * 16 + swz / 64; C = (st & 1) * 32 + (swz % 64) / 2; }
__host__ __device__ __forceinline__ int perm32(int rho) { const int n = rho >> 4, i = rho & 15; return 8 * (i >> 2) + 4 * n + (i & 3); }

struct Unit { int pm, pn, pb, ko; };
struct Gemm { const bf16_t* A; const bf16_t* Bt; int lda, K, ldb; int sa, sb; };

struct DenseOrder {
    int nM, nN, nwg, G, c;
    __device__ void init(int nM_, int nN_, int G_, int c_) { nM = nM_; nN = nN_; nwg = nM * nN; G = G_; c = c_; }
    __device__ bool next(int i, Unit& u) const { return map((long)i * G + c, u); }
    __device__ bool map(long L, Unit& u) const {
        if (L >= nwg) return false;
        int wgid = (int)L; { const int q = nwg / NXCD, r = nwg % NXCD, xcd = wgid % NXCD, off = wgid / NXCD; wgid = (xcd < r ? xcd * (q + 1) : r * (q + 1) + (xcd - r) * q) + off; }
        const int nig = WGM * nN, gid = wgid / nig, fm = gid * WGM, gsz = (nM - fm) < WGM ? (nM - fm) : WGM;
        u.pm = fm + ((wgid % nig) % gsz); u.pn = (wgid % nig) / gsz; u.pb = u.pn; u.ko = 0; return true;
    }
    __device__ const int* rows(const Unit&) const { return nullptr; }
};
struct DenseOrderTail {
    DenseOrder d; int lo, hi;
    __device__ bool next(int i, Unit& u) const { const int h = d.G >> 1;
        if (i < lo) return d.map((long)i * d.G + d.c, u);
        if (d.c >= h && i < lo + hi) return d.map((long)lo * d.G + (long)(i - lo) * h + (d.c - h), u);
        return false; }
    __device__ const int* rows(const Unit&) const { return nullptr; }
};
struct RouterOrder {
    int G, c;
    __device__ bool next(int i, Unit& u) const { const int L = i * G + c; if (L >= 256) return false; u.pm = L >> 2; u.pn = L & 3; u.pb = 0; u.ko = (L & 3) * 1024; return true; }
    __device__ const int* rows(const Unit&) const { return nullptr; }
};
struct MoeOrder {
    int tile0, ntiles, npn, G, c; const int* tile_e; const int* row_tok;
    __device__ bool next(int i, Unit& u) const {
        const long L = (long)i * G + c; if (L >= (long)ntiles * npn) return false;
        const int tl = (int)L / npn, pn = (int)L % npn; u.pm = tile0 + tl; u.pn = pn; u.pb = tile_e[tile0 + tl] * npn + pn; u.ko = 0; return true;
    }
    __device__ const int* rows(const Unit& u) const { return row_tok + (size_t)u.pm * 256; }
};

#define PG8_EPI_ARGS const f32x4 (&acc)[2][2][4][2], const Unit& u, int wr, int wc, int fr, int fq

typedef int i32x4_ __attribute__((ext_vector_type(4))); typedef int i32x8_ __attribute__((ext_vector_type(8)));
template <class Epi, class Sched, bool GATHER, bool FP8 = false>
__device__ __forceinline__ void gemm_phase(LAS unsigned char* lds, const Gemm g, const Sched& S, const Epi& E, const int tid) {
    const int wid = __builtin_amdgcn_readfirstlane(tid >> 6), lane = tid & 63, wr = wid >> 2, wc = wid & 3, fr = lane & 15, fq = lane >> 4;
    const int K = g.K, nt = K / BK, lda = g.lda;
    unsigned voffB[2], va[2][2], vn[2][2]; int RA[2], CA[2];
#pragma unroll
    for (int i = 0; i < 2; ++i) { int R, C; stage_rc(tid * 16 + i * 8192, R, C); const int Rb = 64 * (R >> 5) + (Epi::PERM == 1 ? (R & 31) : Epi::PERM == 2 ? 16 * ((R & 15) >> 2) + 4 * ((R >> 4) & 1) + (R & 3) : perm32(R & 31)); RA[i] = R; CA[i] = C; voffB[i] = (unsigned)(Rb * g.ldb + C) * 2u; }
    const size_t kstep = (size_t)(BK * 2);
    const size_t hstepB = (size_t)(Epi::PERM == 2 ? 8 : 32) * g.ldb * 2, tstepB = (size_t)BM * g.ldb * 2, tstepA = (size_t)BM * lda * 2;
    const unsigned ldsw = (unsigned)wid * 1024u;
    const int aoff = lds_byte(wr * 64 + fr, fq * 8), boff = lds_byte(wc * 32 + fr, fq * 8);
#define PG8_SA(b, h) (((b) * 2 + (h)) * HTB)
#define PG8_SB(b, h) ((4 + (b) * 2 + (h)) * HTB)
#define PG8_STAGEB(bufoff, gbase) do { _Pragma("unroll") for (int _i = 0; _i < 2; ++_i) \
        __builtin_amdgcn_global_load_lds((const unsigned*)((const char*)(gbase) + voffB[_i]), (LAS unsigned*)(lds + (bufoff) + ldsw + _i * 8192), 16, 0, 0); } while (0)
#define PG8_STAGEA(bufoff, gbase, offs, h) do { _Pragma("unroll") for (int _i = 0; _i < 2; ++_i) \
        __builtin_amdgcn_global_load_lds((const unsigned*)((const char*)(gbase) + (offs)[h][_i]), (LAS unsigned*)(lds + (bufoff) + ldsw + _i * 8192), 16, 0, 0); } while (0)
#define PG8_LDA(dst, b, h) do { if constexpr (FP8) { _Pragma("unroll") for (int m = 0; m < 4; ++m) { const i32x4_ _lo = *(const LAS i32x4_*)(lds + PG8_SA(b, h) + aoff + m * 2048), _hi = *(const LAS i32x4_*)(lds + PG8_SA(b, h) + aoff + m * 2048 + 1024); \
            dst##8[m] = __builtin_shufflevector(_lo, _hi, 0, 1, 2, 3, 4, 5, 6, 7); } } \
        else { _Pragma("unroll") for (int m = 0; m < 4; ++m) _Pragma("unroll") for (int k = 0; k < 2; ++k) dst[m][k] = *(const LAS bf16x8*)(lds + PG8_SA(b, h) + aoff + m * 2048 + k * 1024); } } while (0)
#define PG8_LDB(dst, b, h) do { if constexpr (FP8) { _Pragma("unroll") for (int n = 0; n < 2; ++n) { const i32x4_ _lo = *(const LAS i32x4_*)(lds + PG8_SB(b, h) + boff + n * 2048), _hi = *(const LAS i32x4_*)(lds + PG8_SB(b, h) + boff + n * 2048 + 1024); \
            dst##8[n] = __builtin_shufflevector(_lo, _hi, 0, 1, 2, 3, 4, 5, 6, 7); } } \
        else { _Pragma("unroll") for (int n = 0; n < 2; ++n) _Pragma("unroll") for (int k = 0; k < 2; ++k) dst[n][k] = *(const LAS bf16x8*)(lds + PG8_SB(b, h) + boff + n * 2048 + k * 1024); } } while (0)
#define PG8_MMA(ai, bj, At, Bt) do { __builtin_amdgcn_s_setprio(1); \
        if constexpr (FP8) { _Pragma("unroll") for (int m = 0; m < 4; ++m) _Pragma("unroll") for (int n = 0; n < 2; ++n) \
            asm volatile("v_mfma_scale_f32_16x16x128_f8f6f4 %0, %1, %2, %0, %3, %4 op_sel_hi:[0,0,0]" : "+v"(acc[ai][bj][m][n]) : "v"(Bt##8[n]), "v"(At##8[m]), "v"(sbv), "v"(sav)); } \
        else { _Pragma("unroll") for (int m = 0; m < 4; ++m) _Pragma("unroll") for (int n = 0; n < 2; ++n) _Pragma("unroll") for (int k = 0; k < 2; ++k) \
            acc[ai][bj][m][n] = __builtin_amdgcn_mfma_f32_16x16x32_bf16(Bt[n][k], At[m][k], acc[ai][bj][m][n], 0, 0, 0); } \
        __builtin_amdgcn_s_setprio(0); } while (0)
#define PG8_WAIT_V(n) asm volatile("s_waitcnt vmcnt(" #n ")" ::: "memory")
#define PG8_WAIT_L(n) asm volatile("s_waitcnt lgkmcnt(" #n ")" ::: "memory")
#define PG8_BAR __builtin_amdgcn_s_barrier()
#define PG8_SCHED __builtin_amdgcn_sched_barrier(0)
    Unit cur, nxt, nx2; int ui = 0; bool hn = false, hn2 = false; unsigned xq[2][2] = {{0u, 0u}, {0u, 0u}}, xq2[2][2] = {{0u, 0u}, {0u, 0u}}; (void)nx2; (void)hn; (void)hn2; (void)xq; (void)xq2;
    if (!S.next(0, cur)) return;
    f32x4 acc[2][2][4][2];
#pragma unroll
    for (int a = 0; a < 2; ++a)
#pragma unroll
        for (int b = 0; b < 2; ++b)
#pragma unroll
            for (int m = 0; m < 4; ++m)
#pragma unroll
                for (int n = 0; n < 2; ++n) acc[a][b][m][n] = (f32x4){0.f, 0.f, 0.f, 0.f};
    const int sav = g.sa, sbv = g.sb; (void)sav; (void)sbv;
    bf16x8 At[4][2], B0[2][2], B1[2][2]; i32x8_ At8[4], B08[2], B18[2]; (void)At; (void)B0; (void)B1; (void)At8; (void)B08; (void)B18;
    const char* cA; const char* cB = (const char*)g.Bt + (size_t)cur.pb * tstepB + (size_t)cur.ko * 2;
    if constexpr (GATHER) {
        const int* rw = S.rows(cur); cA = (const char*)g.A;
#pragma unroll
        for (int h = 0; h < 2; ++h)
#pragma unroll
            for (int i = 0; i < 2; ++i) { unsigned x = (unsigned)rw[h * HALF + RA[i]]; asm volatile("s_waitcnt vmcnt(0)" : "+v"(x) :: "memory"); va[h][i] = (x * (unsigned)lda + (unsigned)CA[i]) * 2u; }
    } else {
        cA = (const char*)g.A + (size_t)cur.pm * tstepA + (size_t)cur.ko * 2;
#pragma unroll
        for (int h = 0; h < 2; ++h)
#pragma unroll
            for (int i = 0; i < 2; ++i) va[h][i] = (unsigned)((h * HALF + RA[i]) * lda + CA[i]) * 2u;
    }
#pragma unroll
    for (int h = 0; h < 2; ++h)
#pragma unroll
        for (int i = 0; i < 2; ++i) vn[h][i] = va[h][i];
    if constexpr (GATHER) {
        hn = S.next(1, nxt);
        if (hn) { const int* rw = S.rows(nxt);
#pragma unroll
            for (int h = 0; h < 2; ++h)
#pragma unroll
                for (int i = 0; i < 2; ++i) xq[h][i] = (unsigned)rw[h * HALF + RA[i]]; }
    }
    PG8_STAGEB(PG8_SB(0, 0), cB); PG8_STAGEB(PG8_SB(0, 1), cB + hstepB); PG8_STAGEA(PG8_SA(0, 0), cA, va, 0); PG8_STAGEA(PG8_SA(0, 1), cA, va, 1);
    if (wr == 1) PG8_BAR;
    PG8_WAIT_V(2); PG8_BAR;
    PG8_STAGEB(PG8_SB(1, 0), cB + kstep); PG8_STAGEA(PG8_SA(1, 0), cA + kstep, va, 0); PG8_STAGEB(PG8_SB(1, 1), cB + hstepB + kstep);
    PG8_WAIT_V(6); PG8_BAR;
    for (;;) {
        bool has_next;
        if constexpr (GATHER) has_next = hn; else has_next = S.next(ui + 1, nxt);
        const char* nA; const char* nB = has_next ? (const char*)g.Bt + (size_t)nxt.pb * tstepB + (size_t)nxt.ko * 2 : cB;
        if constexpr (GATHER) {
            nA = cA;
            if (has_next) {
#pragma unroll
                for (int h = 0; h < 2; ++h)
#pragma unroll
                    for (int i = 0; i < 2; ++i) vn[h][i] = (xq[h][i] * (unsigned)lda + (unsigned)CA[i]) * 2u; }
            hn2 = has_next && S.next(ui + 2, nx2);
            if (hn2) { const int* rw = S.rows(nx2);
#pragma unroll
                for (int h = 0; h < 2; ++h)
#pragma unroll
                    for (int i = 0; i < 2; ++i) xq2[h][i] = (unsigned)rw[h * HALF + RA[i]]; }
        } else {
            nA = has_next ? (const char*)g.A + (size_t)nxt.pm * tstepA + (size_t)nxt.ko * 2 : cA;
        }
#pragma unroll 1
        for (int t = 0; t < nt; t += 2) {
            const bool last = (t == nt - 2);
            const char* a1 = cA + (size_t)(t + 1) * kstep;
            const char* a2 = last ? nA : cA + (size_t)(t + 2) * kstep; const char* b2 = last ? nB : cB + (size_t)(t + 2) * kstep;
            const char* a3 = a2 + kstep; const char* b3 = b2 + kstep;
            unsigned v2[2][2];
#pragma unroll
            for (int h = 0; h < 2; ++h)
#pragma unroll
                for (int i = 0; i < 2; ++i) v2[h][i] = GATHER ? (last ? vn[h][i] : va[h][i]) : va[h][i];
            PG8_LDB(B0, 0, 0); PG8_LDB(B1, 0, 1); PG8_SCHED; PG8_LDA(At, 0, 0); PG8_STAGEA(PG8_SA(1, 1), a1, va, 1);
            PG8_WAIT_V(8); PG8_WAIT_L(0); PG8_BAR; PG8_MMA(0, 0, At, B0); PG8_MMA(0, 1, At, B1); PG8_BAR; PG8_SCHED;
            PG8_LDA(At, 0, 1); PG8_STAGEB(PG8_SB(0, 0), b2); PG8_STAGEB(PG8_SB(0, 1), b2 + hstepB); PG8_STAGEA(PG8_SA(0, 0), a2, v2, 0);
            PG8_WAIT_V(8); PG8_WAIT_L(0); PG8_BAR; PG8_MMA(1, 0, At, B0); PG8_MMA(1, 1, At, B1); PG8_BAR; PG8_SCHED;
            PG8_LDB(B0, 1, 0); PG8_LDB(B1, 1, 1); PG8_SCHED; PG8_LDA(At, 1, 0); PG8_STAGEA(PG8_SA(0, 1), a2, v2, 1);
            PG8_WAIT_V(8); PG8_WAIT_L(0); PG8_BAR; PG8_MMA(0, 0, At, B0); PG8_MMA(0, 1, At, B1); PG8_BAR; PG8_SCHED;
            PG8_LDA(At, 1, 1); PG8_STAGEB(PG8_SB(1, 0), b3); PG8_STAGEB(PG8_SB(1, 1), b3 + hstepB); PG8_STAGEA(PG8_SA(1, 0), a3, v2, 0);
            PG8_WAIT_V(8); PG8_WAIT_L(0); PG8_BAR; PG8_MMA(1, 0, At, B0); PG8_MMA(1, 1, At, B1); PG8_BAR; PG8_SCHED;
        }
        if constexpr (FP8) {
            asm volatile("s_nop 7\n\ts_nop 7" : "+v"(acc[0][0][0][0]), "+v"(acc[0][0][0][1]), "+v"(acc[0][0][1][0]), "+v"(acc[0][0][1][1]), "+v"(acc[0][0][2][0]), "+v"(acc[0][0][2][1]), "+v"(acc[0][0][3][0]), "+v"(acc[0][0][3][1]), "+v"(acc[0][1][0][0]), "+v"(acc[0][1][0][1]), "+v"(acc[0][1][1][0]), "+v"(acc[0][1][1][1]), "+v"(acc[0][1][2][0]), "+v"(acc[0][1][2][1]), "+v"(acc[0][1][3][0]), "+v"(acc[0][1][3][1]));
            asm volatile("" : "+v"(acc[1][0][0][0]), "+v"(acc[1][0][0][1]), "+v"(acc[1][0][1][0]), "+v"(acc[1][0][1][1]), "+v"(acc[1][0][2][0]), "+v"(acc[1][0][2][1]), "+v"(acc[1][0][3][0]), "+v"(acc[1][0][3][1]), "+v"(acc[1][1][0][0]), "+v"(acc[1][1][0][1]), "+v"(acc[1][1][1][0]), "+v"(acc[1][1][1][1]), "+v"(acc[1][1][2][0]), "+v"(acc[1][1][2][1]), "+v"(acc[1][1][3][0]), "+v"(acc[1][1][3][1])); }
        if (wr == 0) PG8_BAR;
        E(acc, cur, wr, wc, fr, fq);
        if (!has_next) break;
#pragma unroll
        for (int a = 0; a < 2; ++a)
#pragma unroll
            for (int b = 0; b < 2; ++b)
#pragma unroll
                for (int m = 0; m < 4; ++m)
#pragma unroll
                    for (int n = 0; n < 2; ++n) acc[a][b][m][n] = (f32x4){0.f, 0.f, 0.f, 0.f};
        cur = nxt; cA = nA; cB = nB; ++ui;
        if constexpr (GATHER) {
#pragma unroll
            for (int h = 0; h < 2; ++h)
#pragma unroll
                for (int i = 0; i < 2; ++i) { va[h][i] = vn[h][i]; xq[h][i] = xq2[h][i]; }
            nxt = nx2; hn = hn2;
        }
        if (wr == 1) PG8_BAR;
    }
    PG8_WAIT_V(0);
    PG8_BAR;
#undef PG8_SA
#undef PG8_SB
#undef PG8_STAGEA
#undef PG8_STAGEB
#undef PG8_LDA
#undef PG8_LDB
#undef PG8_MMA
#undef PG8_WAIT_V
#undef PG8_WAIT_L
#undef PG8_BAR
#undef PG8_SCHED
}

#define EPI_COLF(bj, n) (wc * 64 + (bj) * 32 + (n) * 16 + 4 * fq)
#define EPI_ROW(ai, m) (u.pm * 256 + (ai) * 128 + wr * 64 + (m) * 16 + fr)
#define EPI_COLT(bj) (wc * 64 + (bj) * 32 + 8 * fq)
struct EpiProj {
    static constexpr int PERM = 0;
    bf16_t *rkv, *misc, *cqkv, *gates;
    __device__ __forceinline__ void operator()(PG8_EPI_ARGS) const {
        const int pn = u.pn; bf16_t* dst; int ldc, ct; bool sig = false;
        if (pn < 12) { dst = rkv; ldc = 3072; ct = pn; } else if (pn < 14) { dst = misc; ldc = 512; ct = pn - 12; } else if (pn < 18) { dst = cqkv; ldc = 1024; ct = pn - 14; } else { dst = gates; ldc = 4096; ct = pn - 18; sig = true; }
#pragma unroll
        for (int ai = 0; ai < 2; ++ai)
#pragma unroll
            for (int m = 0; m < 4; ++m) { bf16_t* rowp = dst + (size_t)EPI_ROW(ai, m) * ldc + ct * 256;
#pragma unroll
                for (int bj = 0; bj < 2; ++bj) { f32x4 v0 = acc[ai][bj][m][0], v1 = acc[ai][bj][m][1];
                    if (sig) {
#pragma unroll
                        for (int e = 0; e < 4; ++e) { v0[e] = sigmoidf_(v0[e]); v1[e] = sigmoidf_(v1[e]); } }
                    *(u32x4*)(rowp + EPI_COLT(bj)) = pack8(v0, v1); } }
    }
};
struct EpiGates {
    static constexpr int PERM = 0;
    bf16_t* gates;
    __device__ __forceinline__ void operator()(PG8_EPI_ARGS) const {
#pragma unroll
        for (int ai = 0; ai < 2; ++ai)
#pragma unroll
            for (int m = 0; m < 4; ++m) { bf16_t* rowp = gates + (size_t)EPI_ROW(ai, m) * 4096 + u.pn * 256;
#pragma unroll
                for (int bj = 0; bj < 2; ++bj) { f32x4 v0 = acc[ai][bj][m][0], v1 = acc[ai][bj][m][1];
#pragma unroll
                    for (int e = 0; e < 4; ++e) { v0[e] = sigmoidf_(v0[e]); v1[e] = sigmoidf_(v1[e]); }
                    *(u32x4*)(rowp + EPI_COLT(bj)) = pack8(v0, v1); } }
    }
};
struct EpiLora {
    static constexpr int PERM = 0;
    bf16_t *om, *aa, *gg; const float *w0, *a0;
    __device__ __forceinline__ void operator()(PG8_EPI_ARGS) const {
        const int pn = u.pn; const int kind = pn >> 2, ct = pn & 3; bf16_t* dst = om + (size_t)kind * ((size_t)T * 1024);
#pragma unroll
        for (int bj = 0; bj < 2; ++bj) {
            const f32x4 bw0 = *(const f32x4*)(w0 + ct * 256 + EPI_COLT(bj)), bw1 = *(const f32x4*)(w0 + ct * 256 + EPI_COLT(bj) + 4);
            const f32x4 ba0 = *(const f32x4*)(a0 + ct * 256 + EPI_COLT(bj)), ba1 = *(const f32x4*)(a0 + ct * 256 + EPI_COLT(bj) + 4);
            const float sw = kind == 0 ? 1.f : 0.f, sa = kind == 1 ? 1.f : 0.f;
            const f32x4 b0 = bw0 * sw + ba0 * sa, b1 = bw1 * sw + ba1 * sa;
#pragma unroll
            for (int ai = 0; ai < 2; ++ai)
#pragma unroll
                for (int m = 0; m < 4; ++m) {
                    f32x4 v0 = acc[ai][bj][m][0] + b0, v1 = acc[ai][bj][m][1] + b1;
                    if (kind == 0) {
#pragma unroll
                        for (int e = 0; e < 4; ++e) {
                            { const float y = -v0[e]; const float sp = fmaxf(y, 0.f) + __logf(1.0f + __expf(-fabsf(y))); const float ew = __expf(-sp - 0.5f); v0[e] = 1.0f - __expf(-ew); }
                            { const float y = -v1[e]; const float sp = fmaxf(y, 0.f) + __logf(1.0f + __expf(-fabsf(y))); const float ew = __expf(-sp - 0.5f); v1[e] = 1.0f - __expf(-ew); } }
                    } else if (kind == 1) {
#pragma unroll
                        for (int e = 0; e < 4; ++e) { v0[e] = sigmoidf_(v0[e]); v1[e] = sigmoidf_(v1[e]); }
                    }
                    *(u32x4*)(dst + (size_t)EPI_ROW(ai, m) * 1024 + ct * 256 + EPI_COLT(bj)) = pack8(v0, v1);
                    __builtin_amdgcn_sched_barrier(0);
                }
        }
    }
};
struct EpiRowScale {
    static constexpr int PERM = 0;
    bf16_t* dst; int ldc; const float* rs;
    __device__ __forceinline__ void operator()(PG8_EPI_ARGS) const {
#pragma unroll
        for (int ai = 0; ai < 2; ++ai)
#pragma unroll
            for (int m = 0; m < 4; ++m) { const int row = EPI_ROW(ai, m); const float s = rs ? rs[row] : 1.0f; bf16_t* rowp = dst + (size_t)row * ldc + u.pn * 256;
#pragma unroll
                for (int bj = 0; bj < 2; ++bj) *(u32x4*)(rowp + EPI_COLT(bj)) = pack8(acc[ai][bj][m][0] * s, acc[ai][bj][m][1] * s); }
    }
};
template <int ACCUM> struct EpiMerge {
    static constexpr int PERM = 0;
    bf16_t* merged; const bf16_t* gates; int goff; unsigned char* merged8;
    __device__ __forceinline__ void operator()(PG8_EPI_ARGS) const {
#pragma unroll
        for (int ai = 0; ai < 2; ++ai)
#pragma unroll
            for (int m = 0; m < 4; ++m) { const int row = EPI_ROW(ai, m);
#pragma unroll
                for (int bj = 0; bj < 2; ++bj) { const int col = u.pn * 256 + EPI_COLT(bj);
                    float gv[8]; unpack8(*(const u32x4*)(gates + (size_t)row * 4096 + goff + col), gv);
                    f32x4 v0 = acc[ai][bj][m][0], v1 = acc[ai][bj][m][1];
                    bf16_t* p = merged + (size_t)row * 2048 + col;
                    float ov[8];
                    if (ACCUM) unpack8(*(const u32x4*)p, ov);
#pragma unroll
                    for (int e = 0; e < 4; ++e) { v0[e] = v0[e] * gv[e] + (ACCUM ? ov[e] : 0.f); v1[e] = v1[e] * gv[4 + e] + (ACCUM ? ov[4 + e] : 0.f); }
                    if (ACCUM) { u32x2 w8; w8.x = pk4_fp8(v0 * O8_SCALE); w8.y = pk4_fp8(v1 * O8_SCALE); *(u32x2*)(merged8 + (size_t)row * 2048 + col) = w8; }
                    else *(u32x4*)p = pack8(v0, v1); } }
    }
};
struct EpiResid {
    static constexpr int PERM = 1;
    const float* base; float* out;
    __device__ __forceinline__ void operator()(PG8_EPI_ARGS) const {
#pragma unroll
        for (int ai = 0; ai < 2; ++ai)
#pragma unroll
            for (int m = 0; m < 4; ++m) { const size_t ro = (size_t)EPI_ROW(ai, m) * 2048 + u.pn * 256;
#pragma unroll
                for (int bj = 0; bj < 2; ++bj)
#pragma unroll
                    for (int n = 0; n < 2; ++n) { const size_t o = ro + EPI_COLF(bj, n); *(f32x4*)(out + o) = *(const f32x4*)(base + o) + acc[ai][bj][m][n]; } }
    }
};
struct EpiLogit {
    static constexpr int PERM = 0;
    float* logit;
    __device__ __forceinline__ void operator()(PG8_EPI_ARGS) const {
#pragma unroll
        for (int ai = 0; ai < 2; ++ai)
#pragma unroll
            for (int m = 0; m < 4; ++m) { float* rowp = logit + (size_t)u.pn * ((size_t)T * 128) + (size_t)EPI_ROW(ai, m) * 128;
                if (wc < 2) {
#pragma unroll
                    for (int bj = 0; bj < 2; ++bj)
#pragma unroll
                        for (int n = 0; n < 2; ++n) *(f32x4*)(rowp + EPI_COLT(bj) + 4 * n) = acc[ai][bj][m][n]; } }
    }
};
struct EpiSwiglu {
    static constexpr int PERM = 0;
    bf16_t* act;
    __device__ __forceinline__ void operator()(PG8_EPI_ARGS) const {
#pragma unroll
        for (int ai = 0; ai < 2; ++ai)
#pragma unroll
            for (int m = 0; m < 4; ++m) { f32x4 v[2];
#pragma unroll
                for (int n = 0; n < 2; ++n)
#pragma unroll
                    for (int e = 0; e < 4; ++e) { const float gx = acc[ai][0][m][n][e]; v[n][e] = gx * sigmoidf_(gx) * acc[ai][1][m][n][e]; }
                *(u32x4*)(act + (size_t)EPI_ROW(ai, m) * 512 + u.pn * 128 + wc * 32 + 8 * fq) = pack8(v[0], v[1]); }
    }
};
struct EpiSwiglu8 {
    static constexpr int PERM = 0;
    unsigned char* act8;
    __device__ __forceinline__ void operator()(PG8_EPI_ARGS) const {
#pragma unroll
        for (int ai = 0; ai < 2; ++ai)
#pragma unroll
            for (int m = 0; m < 4; ++m) { f32x4 v[2];
#pragma unroll
                for (int n = 0; n < 2; ++n)
#pragma unroll
                    for (int e = 0; e < 4; ++e) { const float gx = acc[ai][0][m][n][e]; v[n][e] = gx * sigmoidf_(gx) * acc[ai][1][m][n][e] * ACT8_SCALE; }
                u32x2 w; w.x = pk4_fp8(v[0]); w.y = pk4_fp8(v[1]);
                *(u32x2*)(act8 + (size_t)EPI_ROW(ai, m) * 512 + u.pn * 128 + wc * 32 + 8 * fq) = w; }
    }
};
struct EpiDown {
    static constexpr int PERM = 2;
    unsigned char* y8; const float* roww;
    __device__ __forceinline__ void operator()(PG8_EPI_ARGS) const {
#pragma unroll
        for (int ai = 0; ai < 2; ++ai)
#pragma unroll
            for (int m = 0; m < 4; ++m) { const int row = EPI_ROW(ai, m); const float s = Y8_SCALE;
                u32x4 w; w.x = pk4_fp8(acc[ai][0][m][0] * s); w.y = pk4_fp8(acc[ai][0][m][1] * s); w.z = pk4_fp8(acc[ai][1][m][0] * s); w.w = pk4_fp8(acc[ai][1][m][1] * s);
                *(u32x4*)(y8 + (size_t)row * 2048 + u.pn * 256 + wc * 64 + 16 * fq) = w; }
    }
};
struct EpiFinal {
    static constexpr int PERM = 1;
    float* out; const bf16_t* pleraw; const float* rstdp; const float* gpost; float dsc;
    __device__ __forceinline__ void operator()(PG8_EPI_ARGS) const {
        f32x4 gv[2][2];
#pragma unroll
        for (int bj = 0; bj < 2; ++bj)
#pragma unroll
            for (int n = 0; n < 2; ++n) gv[bj][n] = *(const f32x4*)(gpost + u.pn * 256 + EPI_COLF(bj, n));
#pragma unroll
        for (int ai = 0; ai < 2; ++ai)
#pragma unroll
            for (int m = 0; m < 4; ++m) { const int row = EPI_ROW(ai, m); const float rs = rstdp[row];
#pragma unroll
                for (int bj = 0; bj < 2; ++bj)
#pragma unroll
                    for (int n = 0; n < 2; ++n) { const size_t o = (size_t)row * 2048 + u.pn * 256 + EPI_COLF(bj, n);
                        const uint2 pw = *(const uint2*)(pleraw + o); const f32x4 pv = {__builtin_bit_cast(float, pw.x << 16), __builtin_bit_cast(float, pw.x & 0xffff0000u), __builtin_bit_cast(float, pw.y << 16), __builtin_bit_cast(float, pw.y & 0xffff0000u)};
                        f32x4 x = *(const f32x4*)(out + o), a = acc[ai][bj][m][n];
#pragma unroll
                        for (int e = 0; e < 4; ++e) x[e] += sigmoidf_(a[e]) * (pv[e] * rs * gv[bj][n][e]);
                        *(f32x4*)(out + o) = x * dsc; } }
    }
};
}

struct Args { const float* in[38]; const int* pos; float* out; unsigned char* ws; int ph_lo, ph_hi; };

struct Frame {
    LAS unsigned char* lds; unsigned* ctl; unsigned char* ws;
    int tid, lane, wave, vcu, G, gw, NGW;
};

__device__ __forceinline__ void conv_item(const float* src, int ld_src, int kvalid, const float* kscale, int mode, bf16_t* dst, int ld_dst, LAS float* scr, int lane, int jstep = 8) {
    const int rr = lane >> 3, c4 = (lane & 7) * 4;
    f32x4 v[8];
#pragma unroll
    for (int i = 0; i < 8; ++i) { const int kk = 8 * i + rr; v[i] = (f32x4){0.f, 0.f, 0.f, 0.f};
        if (kk < kvalid) { v[i] = *(const f32x4*)(src + (size_t)kk * ld_src + c4); if (kscale) v[i] = v[i] * kscale[kk]; } }
#pragma unroll
    for (int i = 0; i < 8; ++i) { LAS float* s = scr + (8 * i + rr) * 33 + c4; s[0] = v[i][0]; s[1] = v[i][1]; s[2] = v[i][2]; s[3] = v[i][3]; }
    LDS_WAIT(); asm volatile("" ::: "memory");
    const int c = lane & 7;
    if (8 * c < kvalid) {
#pragma unroll
        for (int j = 0; j < 4; ++j) { const int n = (lane >> 3) + 8 * j; const LAS float* s = scr + (8 * c) * 33 + n;
            float x[8];
#pragma unroll
            for (int e = 0; e < 8; ++e) { x[e] = s[e * 33]; if (mode == 1) x[e] = x[e] - bf2f(f2bf(x[e])); }
            u32x4 o; o.x = pk2(x[0], x[1]); o.y = pk2(x[2], x[3]); o.z = pk2(x[4], x[5]); o.w = pk2(x[6], x[7]);
            *(u32x4*)(dst + (size_t)((lane >> 3) + jstep * j) * ld_dst + 8 * c) = o; }
    }
    LDS_WAIT(); asm volatile("" ::: "memory");
}
__device__ __forceinline__ void conv_load(const float* src, int ld_src, int lane, f32x4 (&v)[8]) {
    const int rr = lane >> 3, c4 = (lane & 7) * 4;
#pragma unroll
    for (int i = 0; i < 8; ++i) v[i] = *(const f32x4*)(src + (size_t)(8 * i + rr) * ld_src + c4);
}
__device__ __forceinline__ void conv_store(const f32x4 (&v)[8], bf16_t* dst, int ld_dst, LAS float* scr, int lane, int jstep = 8) {
    const int rr = lane >> 3, c4 = (lane & 7) * 4;
#pragma unroll
    for (int i = 0; i < 8; ++i) { LAS float* s = scr + (8 * i + rr) * 33 + c4; s[0] = v[i][0]; s[1] = v[i][1]; s[2] = v[i][2]; s[3] = v[i][3]; }
    LDS_WAIT(); asm volatile("" ::: "memory");
    const int c = lane & 7;
#pragma unroll
    for (int j = 0; j < 4; ++j) { const int n = (lane >> 3) + 8 * j; const LAS float* s = scr + (8 * c) * 33 + n;
        u32x4 o; o.x = pk2(s[0], s[33]); o.y = pk2(s[66], s[99]); o.z = pk2(s[132], s[165]); o.w = pk2(s[198], s[231]);
        *(u32x4*)(dst + (size_t)((lane >> 3) + jstep * j) * ld_dst + 8 * c) = o; }
    LDS_WAIT(); asm volatile("" ::: "memory");
}
__device__ __forceinline__ void conv_store8(const f32x4 (&v)[8], unsigned char* dst8, int ld_dst, LAS float* scr, int lane, float scale) {
    const int rr = lane >> 3, c4 = (lane & 7) * 4;
#pragma unroll
    for (int i = 0; i < 8; ++i) { LAS float* s = scr + (8 * i + rr) * 33 + c4; s[0] = v[i][0]; s[1] = v[i][1]; s[2] = v[i][2]; s[3] = v[i][3]; }
    LDS_WAIT(); asm volatile("" ::: "memory");
    const int c = lane & 7;
#pragma unroll
    for (int j = 0; j < 4; ++j) { const int n = (lane >> 3) + 8 * j; const LAS float* s = scr + (8 * c) * 33 + n;
        u32x2 o; o.x = pk4_fp8((f32x4){s[0], s[33], s[66], s[99]} * scale); o.y = pk4_fp8((f32x4){s[132], s[165], s[198], s[231]} * scale);
        *(u32x2*)(dst8 + (size_t)n * ld_dst + 8 * c) = o; }
    LDS_WAIT(); asm volatile("" ::: "memory");
}
__device__ __forceinline__ void conv_item8(const float* src, int ld_src, unsigned char* dst8, int ld_dst, LAS float* scr, int lane, float scale) { f32x4 v[8]; conv_load(src, ld_src, lane, v); conv_store8(v, dst8, ld_dst, scr, lane, scale); }
#define CONV_JOB8X(src_, ld_src_, c0_, ncols_, K_, dst8_, ld_dst_, r0_, js_) { const int nnb_ = (ncols_) / 32, n_ = nnb_ * ((K_) / 64); \
    if (r < n_) { const int kb = r / nnb_, nb = r % nnb_; \
        conv_item8((src_) + (size_t)kb * 64 * (ld_src_) + (c0_) + nb * 32, (ld_src_), (unsigned char*)(dst8_) + (size_t)((r0_) + nb * 4 * (js_)) * (ld_dst_) + kb * 64, (ld_dst_), scr, lane, W8_SCALE); continue; } \
    r -= n_; }
#define CONV_JOB(src_, ld_src_, c0_, ncols_, K_, kscale_, mode_, dst_, ld_dst_, r0_, k0_) CONV_JOBX(src_, ld_src_, c0_, ncols_, K_, kscale_, mode_, dst_, ld_dst_, r0_, k0_, 8)
#define CONV_JOBX(src_, ld_src_, c0_, ncols_, K_, kscale_, mode_, dst_, ld_dst_, r0_, k0_, js_) { const int nnb_ = (ncols_) / 32, n_ = nnb_ * (((K_) + 63) / 64); \
    if (r < n_) { const int kb = r / nnb_, nb = r % nnb_; const int kv = ((K_) - kb * 64) < 64 ? ((K_) - kb * 64) : 64; const float* ks_ = (kscale_); \
        conv_item((src_) + (size_t)kb * 64 * (ld_src_) + (c0_) + nb * 32, (ld_src_), kv, ks_ ? ks_ + kb * 64 : nullptr, (mode_), (dst_) + (size_t)((r0_) + nb * 4 * (js_)) * (ld_dst_) + (k0_) + kb * 64, (ld_dst_), scr, lane); continue; } \
    r -= n_; }
__device__ __forceinline__ void conv_job(const Frame& F, LAS float* scr, const float* src, int ld_src, int c0, int ncols, int K, const float* kscale, int mode, bf16_t* dst, int ld_dst, int r0, int k0) {
    const int nkb = (K + 63) / 64, nnb = ncols / 32, items = nkb * nnb;
    for (int it = F.gw; it < items; it += F.NGW) { const int kb = it / nnb, nb = it % nnb; const int kv = (K - kb * 64) < 64 ? (K - kb * 64) : 64;
        conv_item(src + (size_t)kb * 64 * ld_src + c0 + nb * 32, ld_src, kv, kscale ? kscale + kb * 64 : nullptr, mode, dst + (size_t)(r0 + nb * 32) * ld_dst + k0 + kb * 64, ld_dst, scr, F.lane); }
}

__device__ __forceinline__ void rms_row_bf16(const float* xrow, const float* gain, bf16_t* ohi, bf16_t* olo, int lane, unsigned char* o8 = nullptr) {
    const f32x4* xr = (const f32x4*)xrow + lane; const f32x4* gr = (const f32x4*)gain + lane;
    f32x4 v[8]; float s = 0.f;
#pragma unroll
    for (int j = 0; j < 8; ++j) { v[j] = xr[64 * j]; s += (v[j][0] * v[j][0] + v[j][1] * v[j][1]) + (v[j][2] * v[j][2] + v[j][3] * v[j][3]); }
    const float rstd = 1.0f / sqrtf(wave_sum(s) * (1.f / 2048.f) + NORM_EPS);
#pragma unroll
    for (int j = 0; j < 8; ++j) { const f32x4 gq = gr[64 * j]; const f32x4 y = v[j] * rstd * gq;
        u32x2 h; h.x = pk2(y[0], y[1]); h.y = pk2(y[2], y[3]);
        *((u32x2*)ohi + lane + 64 * j) = h;
        if (o8) ((unsigned*)o8)[lane + 64 * j] = pk4_fp8(y);
        if (olo) { u32x2 l; l.x = pk2(y[0] - bflo(h.x), y[1] - bfhi(h.x)); l.y = pk2(y[2] - bflo(h.y), y[3] - bfhi(h.y)); *((u32x2*)olo + lane + 64 * j) = l; } }
}

__device__ __forceinline__ void attn_unit(LAS unsigned char* lds, const bf16_t* Qf, const bf16_t* Kf, const bf16_t* Vtf, bf16_t* OB, int bh, int qb, int tid, int wid, int lane) {
    const int c = lane & 31, hi = lane >> 5;
    bf16x8 q[12];
    { const bf16x8* qp = (const bf16x8*)(Qf + ((size_t)(bh * 256 + qb * 8 + wid) * 12) * 512) + lane;
#pragma unroll
      for (int ks = 0; ks < 12; ++ks) q[ks] = qp[ks * 64]; }
    f32x16 o[4];
#pragma unroll
    for (int db = 0; db < 4; ++db)
#pragma unroll
        for (int e = 0; e < 16; ++e) o[db][e] = 0.f;
    float mrun = -1e30f, lrun = 0.f;
    const int ntiles = 4 * (qb + 1);
    const char* kbase = (const char*)(Kf + (size_t)bh * 256 * 12 * 512);
    const char* vbase = (const char*)(Vtf + (size_t)bh * 256 * 8 * 512);
#define ATT_LOAD(kt, buf) do { const char* _k = kbase + (size_t)(kt) * 24576 + tid * 16; const char* _v = vbase + (size_t)(kt) * 16384 + tid * 16; \
        _Pragma("unroll") for (int _j = 0; _j < 3; ++_j) __builtin_amdgcn_global_load_lds((const unsigned*)(_k + _j * 8192), (LAS unsigned*)(lds + (buf) * 40960 + _j * 8192 + wid * 1024), 16, 0, 0); \
        _Pragma("unroll") for (int _j = 0; _j < 2; ++_j) __builtin_amdgcn_global_load_lds((const unsigned*)(_v + _j * 8192), (LAS unsigned*)(lds + (buf) * 40960 + 24576 + _j * 8192 + wid * 1024), 16, 0, 0); } while (0)
    __builtin_amdgcn_s_barrier();
    ATT_LOAD(0, 0);
#pragma unroll 1
    for (int kt = 0; kt < ntiles; ++kt) {
        asm volatile("s_waitcnt vmcnt(0)" ::: "memory");
        __builtin_amdgcn_s_barrier();
        if (kt + 1 < ntiles) ATT_LOAD(kt + 1, (kt + 1) & 1);
        const int rel = kt - 4 * qb;
        if (rel <= (wid >> 1)) {
            const LAS unsigned char* tb = lds + (kt & 1) * 40960 + lane * 16;
            f32x16 s0, s1;
#pragma unroll
            for (int e = 0; e < 16; ++e) { s0[e] = 0.f; s1[e] = 0.f; }
#pragma unroll
            for (int g4 = 0; g4 < 3; ++g4) {
                bf16x8 ka[4], kc[4];
#pragma unroll
                for (int i = 0; i < 4; ++i) { ka[i] = *(const LAS bf16x8*)(tb + (4 * g4 + i) * 1024); kc[i] = *(const LAS bf16x8*)(tb + (12 + 4 * g4 + i) * 1024); }
                __builtin_amdgcn_sched_barrier(0);
#pragma unroll
                for (int i = 0; i < 4; ++i) { s0 = __builtin_amdgcn_mfma_f32_32x32x16_bf16(ka[i], q[4 * g4 + i], s0, 0, 0, 0); s1 = __builtin_amdgcn_mfma_f32_32x32x16_bf16(kc[i], q[4 * g4 + i], s1, 0, 0, 0); }
                __builtin_amdgcn_sched_barrier(0);
            }
            if (rel == (wid >> 1)) {
                const int qi = 32 * wid + c - 64 * rel - 4 * hi;
#pragma unroll
                for (int e = 0; e < 16; ++e) { const int kr = (e & 3) + 8 * (e >> 2);
                    s0[e] += __builtin_bit_cast(float, ((qi - kr) >> 31) & (int)0xff800000); s1[e] += __builtin_bit_cast(float, ((qi - 32 - kr) >> 31) & (int)0xff800000); }
            }
            float mt = fmaxf(s0[0], s1[0]);
#pragma unroll
            for (int e = 1; e < 16; ++e) mt = fmaxf(mt, fmaxf(s0[e], s1[e]));
            mt = fmaxf(mt, __shfl_xor(mt, 32));
            const float mnew = fmaxf(mrun, mt), alpha = __builtin_amdgcn_exp2f(mrun - mnew);
            mrun = mnew;
            float ls = 0.f;
#pragma unroll
            for (int e = 0; e < 16; ++e) { s0[e] = __builtin_amdgcn_exp2f(s0[e] - mnew); s1[e] = __builtin_amdgcn_exp2f(s1[e] - mnew); ls += s0[e] + s1[e]; }
            lrun = lrun * alpha + ls;
#pragma unroll
            for (int db = 0; db < 4; ++db)
#pragma unroll
                for (int e = 0; e < 16; ++e) o[db][e] *= alpha;
            bf16x8 p[2][2];
#pragma unroll
            for (int s = 0; s < 2; ++s) {
                u32x4 w0, w1;
                w0.x = cvt_pk_bf16(s0[8 * s + 0], s0[8 * s + 1]); w0.y = cvt_pk_bf16(s0[8 * s + 2], s0[8 * s + 3]); w0.z = cvt_pk_bf16(s0[8 * s + 4], s0[8 * s + 5]); w0.w = cvt_pk_bf16(s0[8 * s + 6], s0[8 * s + 7]);
                w1.x = cvt_pk_bf16(s1[8 * s + 0], s1[8 * s + 1]); w1.y = cvt_pk_bf16(s1[8 * s + 2], s1[8 * s + 3]); w1.z = cvt_pk_bf16(s1[8 * s + 4], s1[8 * s + 5]); w1.w = cvt_pk_bf16(s1[8 * s + 6], s1[8 * s + 7]);
                p[0][s] = __builtin_bit_cast(bf16x8, w0); p[1][s] = __builtin_bit_cast(bf16x8, w1);
            }
            const LAS unsigned char* vb = tb + 24576;
#pragma unroll
            for (int kb = 0; kb < 2; ++kb)
#pragma unroll
                for (int s = 0; s < 2; ++s) {
                    bf16x8 vf[4];
#pragma unroll
                    for (int db = 0; db < 4; ++db) vf[db] = *(const LAS bf16x8*)(vb + ((kb * 2 + s) * 4 + db) * 1024);
                    __builtin_amdgcn_sched_barrier(0);
#pragma unroll
                    for (int db = 0; db < 4; ++db) o[db] = __builtin_amdgcn_mfma_f32_32x32x16_bf16(vf[db], p[kb][s], o[db], 0, 0, 0);
                    __builtin_amdgcn_sched_barrier(0);
                }
        }
    }
#undef ATT_LOAD
    lrun += __shfl_xor(lrun, 32);
    const float inv = 1.0f / lrun;
    const int b = bh >> 3, h = bh & 7;
    unsigned char* orow = (unsigned char*)OB + ((size_t)(b * SEQ + qb * 256 + wid * 32 + c)) * 1024 + h * 128;
    const float inv4 = inv * O8_SCALE;
#pragma unroll
    for (int db = 0; db < 4; ++db)
#pragma unroll
        for (int gq = 0; gq < 4; ++gq) *(unsigned*)(orow + 32 * db + 8 * gq + 4 * hi) = pk4_fp8((f32x4){o[db][4 * gq], o[db][4 * gq + 1], o[db][4 * gq + 2], o[db][4 * gq + 3]} * inv4);
}

__device__ __forceinline__ float dpp_sum16(float v) {
    int x;
    x = __builtin_amdgcn_update_dpp(0, __builtin_bit_cast(int, v), 0xB1, 0xF, 0xF, false); v += __builtin_bit_cast(float, x);
    x = __builtin_amdgcn_update_dpp(0, __builtin_bit_cast(int, v), 0x4E, 0xF, 0xF, false); v += __builtin_bit_cast(float, x);
    x = __builtin_amdgcn_update_dpp(0, __builtin_bit_cast(int, v), 0x141, 0xF, 0xF, false); v += __builtin_bit_cast(float, x);
    x = __builtin_amdgcn_update_dpp(0, __builtin_bit_cast(int, v), 0x140, 0xF, 0xF, false); v += __builtin_bit_cast(float, x);
    return v;
}
__device__ __forceinline__ void dpp_sum16x2(float& a, float& b) {
    asm volatile(
        "s_nop 1\n\t"
        "v_add_f32_dpp %0, %0, %0 quad_perm:[1,0,3,2] row_mask:0xf bank_mask:0xf\n\t"
        "v_add_f32_dpp %1, %1, %1 quad_perm:[1,0,3,2] row_mask:0xf bank_mask:0xf\n\t"
        "s_nop 0\n\t"
        "v_add_f32_dpp %0, %0, %0 quad_perm:[2,3,0,1] row_mask:0xf bank_mask:0xf\n\t"
        "v_add_f32_dpp %1, %1, %1 quad_perm:[2,3,0,1] row_mask:0xf bank_mask:0xf\n\t"
        "s_nop 0\n\t"
        "v_add_f32_dpp %0, %0, %0 row_half_mirror row_mask:0xf bank_mask:0xf\n\t"
        "v_add_f32_dpp %1, %1, %1 row_half_mirror row_mask:0xf bank_mask:0xf\n\t"
        "s_nop 0\n\t"
        "v_add_f32_dpp %0, %0, %0 row_mirror row_mask:0xf bank_mask:0xf\n\t"
        "v_add_f32_dpp %1, %1, %1 row_mirror row_mask:0xf bank_mask:0xf\n\t"
        "s_nop 0"
        : "+v"(a), "+v"(b));
}
constexpr int SC_STEPS = 32, SC_STEPB = 1408, SC_BUF = SC_STEPS * SC_STEPB, SC_YOFF = 2 * SC_BUF, SC_YBUF = SC_STEPS * 128;
__device__ __forceinline__ void scan_block(LAS unsigned char* lds, const GAS unsigned char* ws, bf16_t* Y, int bh, int half, int tid, int wave, int lane) {
    const int ri = lane >> 4, c = lane & 15, b = bh >> 4, h = bh & 15;
    const size_t row0 = (size_t)b * SEQ * 1024 + h * 64;
    const int hi8 = tid >> 8, rem = tid & 255, sst = rem >> 3, seg = rem & 7;
    const size_t e01 = row0 + (size_t)sst * 1024 + seg * 8;
    const size_t o0 = (hi8 ? WS_BB : WS_KK) + e01 * 2, o1 = (hi8 ? WS_R : WS_KP) + e01 * 2;
    const int d0 = sst * SC_STEPB + hi8 * 256 + seg * 32, d1 = sst * SC_STEPB + (2 + hi8) * 256 + seg * 32;
    const int q = tid - 256, sv = (q >> 2) & 31, segv = q & 3;
    const bool has2 = tid < 384;
    const size_t o2 = hi8 ? (WS_VB + (row0 + (size_t)sv * 1024 + 32 * half + segv * 8) * 2) : (WS_OM + e01 * 2);
    const int d2 = hi8 ? (sv * SC_STEPB + 1280 + segv * 32) : (sst * SC_STEPB + 4 * 256 + seg * 32);
    u32x4 r0, r1, r2 = (u32x4){0u, 0u, 0u, 0u};
#define SC_ISSUE(n) do { const size_t _t = (size_t)(n) * SC_STEPS * 2048; r0 = *(const GAS u32x4*)(ws + o0 + _t); r1 = *(const GAS u32x4*)(ws + o1 + _t); if (has2) r2 = *(const GAS u32x4*)(ws + o2 + _t); } while (0)
#define SC_PUT(bufo, d, r) do { float _f[8]; unpack8(r, _f); *(LAS f32x4*)(lds + (bufo) + (d)) = (f32x4){_f[0], _f[1], _f[2], _f[3]}; *(LAS f32x4*)(lds + (bufo) + (d) + 16) = (f32x4){_f[4], _f[5], _f[6], _f[7]}; } while (0)
#define SC_WRITE(bufo) do { SC_PUT(bufo, d0, r0); SC_PUT(bufo, d1, r1); if (has2) SC_PUT(bufo, d2, r2); } while (0)
    __syncthreads();
    SC_ISSUE(0); SC_WRITE(0);
    __syncthreads();
    float S0 = 0.f, S1 = 0.f, S2 = 0.f, S3 = 0.f;
    const int yl = (4 * wave + ri) * 4;
#pragma unroll 1
    for (int n = 0; n < SEQ / SC_STEPS; ++n) {
        const int bufo = (n & 1) * SC_BUF;
        if (n + 1 < SEQ / SC_STEPS) SC_ISSUE(n + 1);
        {
        const LAS unsigned char* bp = lds + bufo + c * 16; const LAS unsigned char* vp = lds + bufo + 1280 + yl;
        LAS unsigned char* yp = lds + SC_YOFF + (n & 1) * SC_YBUF + yl;
#define SC_LD(X, s) do { X##kk = *(const LAS f32x4*)(bp + (s) * SC_STEPB); X##bb = *(const LAS f32x4*)(bp + (s) * SC_STEPB + 256); X##kp = *(const LAS f32x4*)(bp + (s) * SC_STEPB + 512); \
            X##rr = *(const LAS f32x4*)(bp + (s) * SC_STEPB + 768); X##om = *(const LAS f32x4*)(bp + (s) * SC_STEPB + 1024); X##vv = *(const LAS float*)(vp + (s) * SC_STEPB); } while (0)
#define SC_STEP(X, s) do { \
            float p = fmaf(S3, X##kk[3], fmaf(S2, X##kk[2], fmaf(S1, X##kk[1], S0 * X##kk[0]))); \
            const float u0 = fmaf(X##vv, X##kp[0], fmaf(-X##om[0], S0, S0)), u1 = fmaf(X##vv, X##kp[1], fmaf(-X##om[1], S1, S1)); \
            const float u2 = fmaf(X##vv, X##kp[2], fmaf(-X##om[2], S2, S2)), u3 = fmaf(X##vv, X##kp[3], fmaf(-X##om[3], S3, S3)); \
            dpp_sum16x2(p, yq); \
            if ((s) > 0) { if (c == 0) *(LAS float*)(yp + ((s) - 1) * 128) = yq; } \
            S0 = fmaf(-p, X##bb[0], u0); S1 = fmaf(-p, X##bb[1], u1); S2 = fmaf(-p, X##bb[2], u2); S3 = fmaf(-p, X##bb[3], u3); \
            yq = fmaf(S3, X##rr[3], fmaf(S2, X##rr[2], fmaf(S1, X##rr[1], S0 * X##rr[0]))); } while (0)
        f32x4 Akk, Abb, Akp, Arr, Aom, Bkk, Bbb, Bkp, Brr, Bom; float Avv, Bvv, yq = 0.f;
        SC_LD(A, 0);
#pragma unroll
        for (int s = 0; s < SC_STEPS; s += 2) {
            SC_LD(B, s + 1);
            SC_STEP(A, s);
            if (s + 2 < SC_STEPS) SC_LD(A, s + 2);
            SC_STEP(B, s + 1);
        }
        { float dummy = 0.f; dpp_sum16x2(yq, dummy); if (c == 0) *(LAS float*)(yp + (SC_STEPS - 1) * 128) = yq; }
#undef SC_LD
#undef SC_STEP
        }
        if (n + 1 < SEQ / SC_STEPS) SC_WRITE(bufo ^ SC_BUF);
        __syncthreads();
        if (tid < 128) {
            const LAS f32x4* yl4 = (const LAS f32x4*)(lds + SC_YOFF + (n & 1) * SC_YBUF + (tid >> 2) * 128 + (tid & 3) * 32);
            *(u32x4*)(Y + row0 + (size_t)(n * SC_STEPS + (tid >> 2)) * 1024 + 32 * half + (tid & 3) * 8) = pack8(yl4[0], yl4[1]);
        }
    }
    __syncthreads();
#undef SC_ISSUE
#undef SC_PUT
#undef SC_WRITE
}

constexpr int REC_BYTES = 29696, RO_KK = 0, RO_Q = 4096, RO_NT = 8192, RO_AK = 10240, RO_KQ = 12288, RO_BQ = 14336, RO_BT = 16384, RO_KT = 20480, RO_V = 24576, RO_PC = 28672;
constexpr int PRE_LDS = 13824;
__device__ __forceinline__ unsigned char* rec_ptr(unsigned char* ws, unsigned char* dout, int bh, int n) {
    return bh < 17 ? dout + (size_t)(bh * 256 + n) * REC_BYTES : ws + WS_RECB + (size_t)((bh - 17) * 256 + n) * REC_BYTES;
}
__device__ __forceinline__ void chunk_pre(LAS unsigned char* wl, const GAS unsigned char* ws, unsigned char* rec, int bh, int n, int lane, const float* mu, const float* pk_k, const float* pk_a, const float* pr_k) {
    asm volatile("" : "+v"(lane));
    const int b = bh >> 4, h = bh & 15, j = lane;
    const size_t e0 = ((size_t)(b * SEQ + 32 * n)) * 1024 + h * 64;
    const size_t r0 = ((size_t)(b * SEQ + 32 * n)) * 3072 + h * 64;
    const GAS bf16_t* pOM = (const GAS bf16_t*)(ws + WS_OM) + e0; const GAS bf16_t* pAA = (const GAS bf16_t*)(ws + WS_AA) + e0;
    const GAS bf16_t* pRAW = (const GAS bf16_t*)(ws + WS_RKV) + r0;
    GAS bf16_t* pVB = (GAS bf16_t*)(ws + WS_VB) + e0; GAS float* pBON = (GAS float*)(ws + WS_BONUS) + (size_t)(b * SEQ + 32 * n) * 16 + h;
    const float mur = mu[h * 64 + j], muk = mu[1024 + h * 64 + j], muv = mu[2048 + h * 64 + j], ckk = pk_k[h * 64 + j], cka = pk_a[h * 64 + j], crk = pr_k[h * 64 + j];
    float pr = 0.f, pk = 0.f, pv = 0.f;
    if (n > 0) { pr = bf2f(pRAW[(long)j - 3072]); pk = bf2f(pRAW[(long)j - 3072 + 1024]); pv = bf2f(pRAW[(long)j - 3072 + 2048]); }
    unsigned btp[16], ktp[16], vvp[16];
    float L = 0.f;
    unsigned short rom[2][8], raa[2][8], rr_[2][8], rk_[2][8], rv_[2][8];
#define PRE_LOAD(bf, tg_) do { _Pragma("unroll") for (int q = 0; q < 8; ++q) { const unsigned o = (unsigned)((8 * (tg_) + q) * 1024 + j), o3 = (unsigned)((8 * (tg_) + q) * 3072 + j); \
        rom[bf][q] = pOM[o]; raa[bf][q] = pAA[o]; rr_[bf][q] = pRAW[o3]; rk_[bf][q] = pRAW[o3 + 1024]; rv_[bf][q] = pRAW[o3 + 2048]; } } while (0)
    PRE_LOAD(0, 0);
#pragma unroll
    for (int tg = 0; tg < 4; ++tg) {
        const int bf = tg & 1;
        if (tg + 1 < 4) PRE_LOAD(bf ^ 1, tg + 1);
        __builtin_amdgcn_sched_barrier(0);
#pragma unroll
        for (int q = 0; q < 8; ++q) { const int t = 8 * tg + q;
            const float cr = bf2f(rr_[bf][q]), ck = bf2f(rk_[bf][q]), cv = bf2f(rv_[bf][q]), aa = bf2f(raa[bf][q]), om = bf2f(rom[bf][q]);
            const float rr = cr + (pr - cr) * mur, kx = ck + (pk - ck) * muk, vx = cv + (pv - cv) * muv;
            pr = cr; pk = ck; pv = cv;
            const float kk0 = kx * ckk, kp = kx * (1.0f + (aa - 1.0f) * cka);
            float nrm = kk0 * kk0, bon = rr * kp * crk;
            dpp_sum16x2(nrm, bon);
            const float nt_ = (__builtin_bit_cast(float, __builtin_amdgcn_readlane(fbits(nrm), 0)) + __builtin_bit_cast(float, __builtin_amdgcn_readlane(fbits(nrm), 16))) + (__builtin_bit_cast(float, __builtin_amdgcn_readlane(fbits(nrm), 32)) + __builtin_bit_cast(float, __builtin_amdgcn_readlane(fbits(nrm), 48)));
            const float bt_ = (__builtin_bit_cast(float, __builtin_amdgcn_readlane(fbits(bon), 0)) + __builtin_bit_cast(float, __builtin_amdgcn_readlane(fbits(bon), 16))) + (__builtin_bit_cast(float, __builtin_amdgcn_readlane(fbits(bon), 32)) + __builtin_bit_cast(float, __builtin_amdgcn_readlane(fbits(bon), 48)));
            const float kk = kk0 * (1.0f / fmaxf(sqrtf(nt_), 1e-12f)), bb = kk * aa;
            const unsigned vb16 = f2bf(vx);
            pVB[(unsigned)(t * 1024 + j)] = (bf16_t)vb16;
            if (j == 0) pBON[t * 16] = bt_;
            const float w = 1.0f - om, ekm = __expf(L);
            L += __logf(w);
            const float el = ekm * w, eil = __builtin_amdgcn_rcpf(el);
            *(LAS unsigned short*)(wl + 0 + t * 144 + j * 2) = (unsigned short)f2bf(kk * ekm);
            *(LAS unsigned short*)(wl + 4608 + t * 144 + j * 2) = (unsigned short)f2bf(rr * el);
            const unsigned bt = f2bf(bb * eil), kt = f2bf(kp * eil);
            *(LAS unsigned short*)(wl + 9216 + t * 144 + j * 2) = (unsigned short)bt;
            if (q & 1) { btp[t >> 1] |= bt << 16; ktp[t >> 1] |= kt << 16; vvp[t >> 1] |= vb16 << 16; } else { btp[t >> 1] = bt; ktp[t >> 1] = kt; vvp[t >> 1] = vb16; }
        }
        __builtin_amdgcn_sched_barrier(0);
    }
#undef PRE_LOAD
    *(float*)(rec + RO_PC + j * 4) = __expf(L);
    {
        const int jb = j >> 5, jr = j & 31;
#pragma unroll
        for (int s2 = 0; s2 < 2; ++s2)
#pragma unroll
            for (int hh = 0; hh < 2; ++hh) {
                const int tp = (16 * s2 + 4 * hh) >> 1, tn = (16 * s2 + 8 * hh) >> 1;
                *(u32x4*)(rec + RO_BT + ((jb * 2 + s2) * 64 + hh * 32 + jr) * 16) = (u32x4){btp[tp], btp[tp + 1], btp[tp + 4], btp[tp + 5]};
                *(u32x4*)(rec + RO_KT + ((jb * 2 + s2) * 64 + hh * 32 + jr) * 16) = (u32x4){ktp[tn], ktp[tn + 1], ktp[tn + 2], ktp[tn + 3]};
                *(u32x4*)(rec + RO_V + jb * 2048 + (s2 * 64 + hh * 32 + jr) * 16) = (u32x4){vvp[tn], vvp[tn + 1], vvp[tn + 2], vvp[tn + 3]};
            }
    }
    LDS_WAIT(); asm volatile("" ::: "memory");
    const int r = lane & 31, hh = lane >> 5;
#pragma unroll
    for (int m = 0; m < 2; ++m)
#pragma unroll
        for (int blk = 0; blk < 4; ++blk) { const int j0 = 16 * blk + 4 * hh;
            const u32x2 lo = *(const LAS u32x2*)(wl + m * 4608 + r * 144 + j0 * 2), hi = *(const LAS u32x2*)(wl + m * 4608 + r * 144 + (j0 + 8) * 2);
            *(u32x4*)(rec + (m ? RO_Q : RO_KK) + (blk * 64 + lane) * 16) = (u32x4){lo.x, lo.y, hi.x, hi.y}; }
    bf16x8 ak[4], aq[4], bx[4];
#pragma unroll
    for (int ks = 0; ks < 4; ++ks) { ak[ks] = *(const LAS bf16x8*)(wl + r * 144 + (16 * ks + 8 * hh) * 2); aq[ks] = *(const LAS bf16x8*)(wl + 4608 + r * 144 + (16 * ks + 8 * hh) * 2); bx[ks] = *(const LAS bf16x8*)(wl + 9216 + r * 144 + (16 * ks + 8 * hh) * 2); }
    f32x16 Ab, Bq, Ak, Kq;
#pragma unroll
    for (int e = 0; e < 16; ++e) { Ab[e] = 0.f; Bq[e] = 0.f; Ak[e] = 0.f; Kq[e] = 0.f; }
    asm volatile("" : "+v"(Ab), "+v"(Bq), "+v"(Ak), "+v"(Kq));
#pragma unroll
    for (int ks = 0; ks < 4; ++ks) { Ab = __builtin_amdgcn_mfma_f32_32x32x16_bf16(ak[ks], bx[ks], Ab, 0, 0, 0); Bq = __builtin_amdgcn_mfma_f32_32x32x16_bf16(aq[ks], bx[ks], Bq, 0, 0, 0); }
    LDS_WAIT(); asm volatile("" ::: "memory");
#pragma unroll
    for (int t = 0; t < 32; ++t) *(LAS unsigned short*)(wl + 9216 + t * 144 + j * 2) = (unsigned short)((t & 1) ? (ktp[t >> 1] >> 16) : (ktp[t >> 1] & 0xffffu));
    LDS_WAIT(); asm volatile("" ::: "memory");
#pragma unroll
    for (int ks = 0; ks < 4; ++ks) bx[ks] = *(const LAS bf16x8*)(wl + 9216 + r * 144 + (16 * ks + 8 * hh) * 2);
#pragma unroll
    for (int ks = 0; ks < 4; ++ks) { Ak = __builtin_amdgcn_mfma_f32_32x32x16_bf16(ak[ks], bx[ks], Ak, 0, 0, 0); Kq = __builtin_amdgcn_mfma_f32_32x32x16_bf16(aq[ks], bx[ks], Kq, 0, 0, 0); }
#pragma unroll
    for (int g = 0; g < 16; ++g) { const int t = (g & 3) + 8 * (g >> 2) + 4 * hh;
        const int ms = (r - t) >> 31, mi = (r - t - 1) >> 31;
        const float xab = Ab[g], xak = Ak[g], xbq = Bq[g], xkq = Kq[g];
        Ab[g] = __builtin_bit_cast(float, fbits(xab) & ms); Ak[g] = __builtin_bit_cast(float, fbits(xak) & ms);
        Bq[g] = __builtin_bit_cast(float, fbits(xbq) & mi); Kq[g] = __builtin_bit_cast(float, fbits(xkq) & mi); }
    float Tr[32];
#pragma unroll
    for (int t = 0; t < 32; ++t) {
        float acc = __builtin_bit_cast(float, 0x3f800000 & ~(((r - t) | (t - r)) >> 31));
        const float abt = Ab[(t & 3) + 4 * (t >> 3)];
#pragma unroll
        for (int s = 0; s < t; ++s) { const float a = __builtin_bit_cast(float, __builtin_amdgcn_readlane(fbits(abt), s + 32 * ((t >> 2) & 1))); acc = fmaf(-a, Tr[s], acc); }
        Tr[t] = acc;
        __builtin_amdgcn_sched_barrier(0);
    }
    LDS_WAIT(); asm volatile("" ::: "memory");
    {
        const int c = r, s2 = c >> 4;
        const int lp = ((c >> 2) & 1) * 32, ep = 4 * ((c >> 3) & 1) + (c & 3);
        const int ln = ((c >> 3) & 1) * 32, en = c & 7;
#pragma unroll
        for (int tt = 0; tt < 16; ++tt) { const int t = 16 * hh + tt;
            *(LAS unsigned short*)(wl + 0 + (s2 * 64 + lp + t) * 16 + ep * 2) = (unsigned short)f2bf(-Tr[t]); }
#pragma unroll
        for (int g = 0; g < 16; ++g) { const int t = (g & 3) + 8 * (g >> 2) + 4 * hh;
            *(LAS unsigned short*)(wl + 2048 + (s2 * 64 + ln + t) * 16 + en * 2) = (unsigned short)f2bf(Ak[g]);
            *(LAS unsigned short*)(wl + 4096 + (s2 * 64 + ln + t) * 16 + en * 2) = (unsigned short)f2bf(Kq[g]);
            *(LAS unsigned short*)(wl + 6144 + (s2 * 64 + lp + t) * 16 + ep * 2) = (unsigned short)f2bf(Bq[g]); }
    }
    LDS_WAIT(); asm volatile("" ::: "memory");
#pragma unroll
    for (int p = 0; p < 8; ++p) *(u32x4*)(rec + RO_NT + (p * 64 + lane) * 16) = *(const LAS u32x4*)(wl + (p * 64 + lane) * 16);
    LDS_WAIT(); asm volatile("" ::: "memory");
}
constexpr int SEQ_SLOT = 27 * 1024;
constexpr int CV_HSHARE = 1024, CV_HSTOP = 236;
__device__ __forceinline__ void chunk_seq(LAS unsigned char* lds, unsigned char* ws, unsigned char* dout, bf16_t* Y, int bh, int vb, int lane, volatile LAS int* prog) {
    const int c = lane & 31, hi = lane >> 5, b = bh >> 4, h = bh & 15;
    f32x16 St0, St1;
#pragma unroll
    for (int e = 0; e < 16; ++e) { St0[e] = 0.f; St1[e] = 0.f; }
#define SQ_ISSUE(n, slot) do { const unsigned char* _r = rec_ptr(ws, dout, bh, (n)) + lane * 16; \
        _Pragma("unroll") for (int _p = 0; _p < 24; ++_p) __builtin_amdgcn_global_load_lds((const unsigned*)(_r + _p * 1024), (LAS unsigned*)(lds + (slot) * SEQ_SLOT + _p * 1024), 16, 0, 0); \
        _Pragma("unroll") for (int _p = 0; _p < 2; ++_p) __builtin_amdgcn_global_load_lds((const unsigned*)(_r + RO_V + vb * 2048 + _p * 1024), (LAS unsigned*)(lds + (slot) * SEQ_SLOT + (24 + _p) * 1024), 16, 0, 0); \
        __builtin_amdgcn_global_load_lds((const unsigned*)(_r + RO_PC), (LAS unsigned*)(lds + (slot) * SEQ_SLOT + 26 * 1024), 16, 0, 0); } while (0)
#define SQ_FRAG(slot, p) (*(const LAS bf16x8*)(lds + (slot) * SEQ_SLOT + (p) * 1024 + lane * 16))
#define SQ_PACK(X, s2) __builtin_bit_cast(bf16x8, (u32x4){cvt_pk_bf16(X[8 * (s2) + 0], X[8 * (s2) + 1]), cvt_pk_bf16(X[8 * (s2) + 2], X[8 * (s2) + 3]), cvt_pk_bf16(X[8 * (s2) + 4], X[8 * (s2) + 5]), cvt_pk_bf16(X[8 * (s2) + 6], X[8 * (s2) + 7])})
    SQ_ISSUE(0, 0);
#pragma unroll 1
    for (int n = 0; n < 256; ++n) {
        const int slot = n & 1;
        prog[0] = n;
        SQ_ISSUE(n + 1 < 256 ? n + 1 : n, slot ^ 1);
        if (n == 0) asm volatile("s_waitcnt vmcnt(27)" ::: "memory");
        else asm volatile("s_waitcnt vmcnt(43)" ::: "memory");
        const bf16x8 S00 = SQ_PACK(St0, 0), S01 = SQ_PACK(St0, 1), S10 = SQ_PACK(St1, 0), S11 = SQ_PACK(St1, 1);
        const bf16x8 V0 = SQ_FRAG(slot, 24), V1 = SQ_FRAG(slot, 25);
        f32x16 ZA;
#pragma unroll
        for (int e = 0; e < 16; ++e) ZA[e] = 0.f;
        asm volatile("" : "+v"(ZA));
        ZA = __builtin_amdgcn_mfma_f32_32x32x16_bf16(SQ_FRAG(slot, 0), S00, ZA, 0, 0, 0); ZA = __builtin_amdgcn_mfma_f32_32x32x16_bf16(SQ_FRAG(slot, 1), S01, ZA, 0, 0, 0);
        ZA = __builtin_amdgcn_mfma_f32_32x32x16_bf16(SQ_FRAG(slot, 2), S10, ZA, 0, 0, 0); ZA = __builtin_amdgcn_mfma_f32_32x32x16_bf16(SQ_FRAG(slot, 3), S11, ZA, 0, 0, 0);
        ZA = __builtin_amdgcn_mfma_f32_32x32x16_bf16(SQ_FRAG(slot, 10), V0, ZA, 0, 0, 0); ZA = __builtin_amdgcn_mfma_f32_32x32x16_bf16(SQ_FRAG(slot, 11), V1, ZA, 0, 0, 0);
        f32x16 Yt;
#pragma unroll
        for (int e = 0; e < 16; ++e) Yt[e] = 0.f;
        asm volatile("" : "+v"(Yt));
        Yt = __builtin_amdgcn_mfma_f32_32x32x16_bf16(SQ_FRAG(slot, 4), S00, Yt, 0, 0, 0); Yt = __builtin_amdgcn_mfma_f32_32x32x16_bf16(SQ_FRAG(slot, 5), S01, Yt, 0, 0, 0);
        Yt = __builtin_amdgcn_mfma_f32_32x32x16_bf16(SQ_FRAG(slot, 6), S10, Yt, 0, 0, 0); Yt = __builtin_amdgcn_mfma_f32_32x32x16_bf16(SQ_FRAG(slot, 7), S11, Yt, 0, 0, 0);
        Yt = __builtin_amdgcn_mfma_f32_32x32x16_bf16(SQ_FRAG(slot, 12), V0, Yt, 0, 0, 0); Yt = __builtin_amdgcn_mfma_f32_32x32x16_bf16(SQ_FRAG(slot, 13), V1, Yt, 0, 0, 0);
        asm volatile("s_nop 7\n\ts_nop 7" : "+v"(ZA));
        const bf16x8 Z0 = SQ_PACK(ZA, 0), Z1 = SQ_PACK(ZA, 1);
        f32x16 U;
#pragma unroll
        for (int e = 0; e < 16; ++e) U[e] = 0.f;
        asm volatile("" : "+v"(U));
        U = __builtin_amdgcn_mfma_f32_32x32x16_bf16(SQ_FRAG(slot, 8), Z0, U, 0, 0, 0); U = __builtin_amdgcn_mfma_f32_32x32x16_bf16(SQ_FRAG(slot, 9), Z1, U, 0, 0, 0);
        asm volatile("s_nop 7\n\ts_nop 7" : "+v"(U));
        const bf16x8 U0 = SQ_PACK(U, 0), U1 = SQ_PACK(U, 1);
        Yt = __builtin_amdgcn_mfma_f32_32x32x16_bf16(SQ_FRAG(slot, 14), U0, Yt, 0, 0, 0); Yt = __builtin_amdgcn_mfma_f32_32x32x16_bf16(SQ_FRAG(slot, 15), U1, Yt, 0, 0, 0);
        St0 = __builtin_amdgcn_mfma_f32_32x32x16_bf16(SQ_FRAG(slot, 16), U0, St0, 0, 0, 0); St0 = __builtin_amdgcn_mfma_f32_32x32x16_bf16(SQ_FRAG(slot, 17), U1, St0, 0, 0, 0);
        St0 = __builtin_amdgcn_mfma_f32_32x32x16_bf16(SQ_FRAG(slot, 20), V0, St0, 0, 0, 0); St0 = __builtin_amdgcn_mfma_f32_32x32x16_bf16(SQ_FRAG(slot, 21), V1, St0, 0, 0, 0);
        St1 = __builtin_amdgcn_mfma_f32_32x32x16_bf16(SQ_FRAG(slot, 18), U0, St1, 0, 0, 0); St1 = __builtin_amdgcn_mfma_f32_32x32x16_bf16(SQ_FRAG(slot, 19), U1, St1, 0, 0, 0);
        St1 = __builtin_amdgcn_mfma_f32_32x32x16_bf16(SQ_FRAG(slot, 22), V0, St1, 0, 0, 0); St1 = __builtin_amdgcn_mfma_f32_32x32x16_bf16(SQ_FRAG(slot, 23), V1, St1, 0, 0, 0);
#pragma unroll
        for (int gq = 0; gq < 4; ++gq) { const f32x4 p0 = *(const LAS f32x4*)(lds + slot * SEQ_SLOT + 26 * 1024 + (8 * gq + 4 * hi) * 4), p1 = *(const LAS f32x4*)(lds + slot * SEQ_SLOT + 26 * 1024 + (32 + 8 * gq + 4 * hi) * 4);
#pragma unroll
            for (int e = 0; e < 4; ++e) { St0[4 * gq + e] *= p0[e]; St1[4 * gq + e] *= p1[e]; } }
        bf16_t* yrow = Y + ((size_t)(b * SEQ + 32 * n)) * 1024 + h * 64 + 32 * vb + c;
#pragma unroll
        for (int g = 0; g < 16; ++g) yrow[(size_t)((g & 3) + 8 * (g >> 2) + 4 * hi) * 1024] = (bf16_t)f2bf(Yt[g]);
    }
    asm volatile("s_waitcnt vmcnt(0)" ::: "memory");
#undef SQ_ISSUE
#undef SQ_FRAG
#undef SQ_PACK
}

#define WIN ((bf16_t*)(ws + WS_WIN))
#define WL ((bf16_t*)(ws + WS_WL))
#define WR ((bf16_t*)(ws + WS_WR))
#define WUQ ((bf16_t*)(ws + WS_WUQ))
#define WUKV ((bf16_t*)(ws + WS_WUKV))
#define WA ((bf16_t*)(ws + WS_WA))
#define WB ((bf16_t*)(ws + WS_WB))
#define WO ((bf16_t*)(ws + WS_WO))
#define WSHGU ((bf16_t*)(ws + WS_WSHGU))
#define WSHD ((bf16_t*)(ws + WS_WSHD))
#define WPLE ((bf16_t*)(ws + WS_WPLE))
#define WPG ((bf16_t*)(ws + WS_WPG))
#define PBF ((bf16_t*)(ws + WS_PBF))
#define WEG ((bf16_t*)(ws + WS_WEG))
#define WED ((bf16_t*)(ws + WS_WED))
#define RSTDQ ((float*)(ws + WS_RSTDQ))
#define RSTDKV ((float*)(ws + WS_RSTDKV))
#define RSTDP ((float*)(ws + WS_RSTDP))
#define BONUS ((float*)(ws + WS_BONUS))
#define EIDX ((int*)(ws + WS_EIDX))
#define WTS ((float*)(ws + WS_WTS))
#define POS ((int*)(ws + WS_POS))
#define SLOT ((int*)(ws + WS_SLOT))
#define ROWTOK ((int*)(ws + WS_ROWTOK))
#define ROWW ((float*)(ws + WS_ROWW))
#define TILEE ((int*)(ws + WS_TILEE))
#define HB ((bf16_t*)(ws + WS_H))
#define RKV ((bf16_t*)(ws + WS_RKV))
#define MISC ((bf16_t*)(ws + WS_MISC))
#define CQKV ((bf16_t*)(ws + WS_CQKV))
#define GATES ((bf16_t*)(ws + WS_GATES))
#define LIN ((bf16_t*)(ws + WS_L))
#define OMB ((bf16_t*)(ws + WS_OM))
#define AA ((bf16_t*)(ws + WS_AA))
#define GG ((bf16_t*)(ws + WS_GG))
#define QRAW ((bf16_t*)(ws + WS_QRAW))
#define KVRAW ((bf16_t*)(ws + WS_KVRAW))
#define RB ((bf16_t*)(ws + WS_R))
#define KPB ((bf16_t*)(ws + WS_KP))
#define KKB ((bf16_t*)(ws + WS_KK))
#define BBB ((bf16_t*)(ws + WS_BB))
#define VBB ((bf16_t*)(ws + WS_VB))
#define QF ((bf16_t*)(ws + WS_QF))
#define KF ((bf16_t*)(ws + WS_KF))
#define VTF ((bf16_t*)(ws + WS_VTF))
#define YS ((bf16_t*)(ws + WS_Y))
#define OB ((bf16_t*)(ws + WS_OB))
#define OA ((bf16_t*)(ws + WS_OA))
#define MERGED ((bf16_t*)(ws + WS_MERGED))
#define Y2 ((bf16_t*)(ws + WS_Y2))
#define H2 ((bf16_t*)(ws + WS_H2))
#define LOGIT ((float*)(ws + WS_LOGIT))
#define ACTSH ((bf16_t*)(ws + WS_ACTSH))
#define PLERAW ((bf16_t*)(ws + WS_PLERAW))
#define XN3 ((bf16_t*)(ws + WS_XN3))
#define ACT ((bf16_t*)(ws + WS_ACT))
__global__ void __launch_bounds__(512, 2) hybrid_fwd(Args args) {
    extern __shared__ __attribute__((aligned(16))) unsigned char lds_raw[];
    GAS unsigned char* ws = (GAS unsigned char*)args.ws;
    for (int u = threadIdx.x; u < (LDS_BYTES - LDSCTL_OFF) / 4; u += 512) ((LAS unsigned*)((LAS unsigned char*)lds_raw + LDSCTL_OFF))[u] = 0u;
    __syncthreads();
    const int lo = args.ph_lo, hi = args.ph_hi;
    if ((hi - lo) > 1) (void)xcd_barrier_post((unsigned*)(ws + WS_CTL) + CW_BAR, (volatile LAS unsigned*)((LAS unsigned char*)lds_raw + LDSCTL_OFF) + 8);
#ifndef GSEL
#define GSEL 7
#endif
#ifndef PHASE_MASK
#define PHASE_MASK 0x7ffffu
#endif
#define IN(k) (((PHASE_MASK >> (k)) & 1u) && lo <= (k) && (k) < hi)
#define SEAM(k) do { if (IN(k) && IN((k) + 1)) { XcdBarrier _b; _b.bar = (unsigned*)(ws + WS_CTL) + CW_BAR; _b.x = xb_xcc_id(); _b.st = (volatile LAS unsigned*)((LAS unsigned char*)lds_raw + LDSCTL_OFF) + 8; xcd_barrier(_b); } } while (0)
    typedef __attribute__((address_space(4))) const Args CArgs;
    CArgs* ap = (CArgs*)__builtin_amdgcn_kernarg_segment_ptr();
#define PHASE_BEGIN() asm volatile("" : "+s"(ap), "+s"(ws)); int tid = threadIdx.x; asm volatile("" : "+v"(tid)); \
    const int lane = tid & 63, wave = __builtin_amdgcn_readfirstlane(tid >> 6); Frame F; F.lds = (LAS unsigned char*)lds_raw; F.tid = tid; F.lane = lane; F.wave = wave; \
    F.G = gridDim.x; { const int bx = blockIdx.x; F.vcu = (F.G % 8 == 0) ? (bx % 8) * (F.G / 8) + bx / 8 : bx; } F.gw = F.vcu * 8 + wave; F.NGW = F.G * 8; F.ws = (unsigned char*)ws; F.ctl = (unsigned*)(ws + WS_CTL); \
    LAS float* const scr = (LAS float*)(F.lds + wave * 8448); (void)scr; (void)lane
#ifndef REPEAT_MASK
#define REPEAT_MASK 0u
#endif
#define REP(k) for (int _rep = 0; _rep < (int)((REPEAT_MASK >> (k)) & 1u) + 1; ++_rep)
#define OUT ((float*)(GAS float*)ap->out)
#define INP(k) ((const float*)(const GAS float*)ap->in[k])

    REP(0) {
    if (IN(0)) { PHASE_BEGIN();
        const float* w_in = INP(4);
        constexpr int P0_ITEMS = 32 * (96 + 9 + 2 + 32 + 128) + 32 + 32 + 96 + 8 * 48 + 8 * 64;
#pragma unroll 1
        for (int it = F.gw; it < P0_ITEMS; it += F.NGW) { int r = it;
            CONV_JOB(w_in, 8544, 0, 3072, 2048, (const float*)nullptr, 0, WIN, 2048, 0, 0)
            CONV_JOB(w_in, 8544, 3072, 288, 2048, (const float*)nullptr, 0, WIN, 2048, 3072, 0)
            CONV_JOB(w_in, 8544, 4384, 64, 2048, (const float*)nullptr, 0, WIN, 2048, 3360, 0)
            CONV_JOB(w_in, 8544, 3360, 1024, 2048, (const float*)nullptr, 0, WIN, 2048, 3584, 0)
            CONV_JOB8X(w_in, 8544, 4448, 4096, 2048, ws + WS_WIN8G, 2048, 0, 8)
            CONV_JOB(INP(7), 1024, 0, 1024, 64, (const float*)nullptr, 0, WL, 384, 0, 0)
            CONV_JOB(INP(9), 1024, 0, 1024, 64, (const float*)nullptr, 0, WL, 384, 1024, 64)
            CONV_JOB(INP(10), 1024, 0, 1024, 160, (const float*)nullptr, 0, WL, 384, 2048, 128)
            CONV_JOB(INP(19), 1536, 0, 1536, 512, INP(17), 0, WUQ, 512, 0, 0)
            CONV_JOB(INP(20), 2048, 0, 2048, 512, INP(18), 0, WUKV, 512, 0, 0)
        }
        for (int i = F.gw * 64 + lane; i < 160 * 2048 / 8; i += F.NGW * 64) *((u32x4*)(WIN + (size_t)3424 * 2048) + i) = (u32x4){0u, 0u, 0u, 0u};
        for (int m = F.gw; m < T; m += F.NGW) rms_row_bf16(INP(0) + (size_t)m * D, INP(3), HB + (size_t)m * D, nullptr, lane, (unsigned char*)(ws + WS_HB8) + (size_t)m * D);
        for (int i = F.gw * 64 + lane; i < T * 256 / 4; i += F.NGW * 64) { const f32x4 v = *((const f32x4*)INP(1) + i); u32x2 w; w.x = pk2(v[0], v[1]); w.y = pk2(v[2], v[3]); *((u32x2*)PBF + i) = w; }
    }
    SEAM(0);
    }
    REP(1) {
    if (IN(1)) { PHASE_BEGIN();
        { pg8::Gemm g{HB, WIN, 2048, 2048, 2048}; pg8::DenseOrder S; S.init(64, 18, F.G, (int)blockIdx.x);
          pg8::EpiProj E{RKV, MISC, CQKV, GATES};
          pg8::gemm_phase<pg8::EpiProj, pg8::DenseOrder, false>(F.lds, g, S, E, tid); }
        { pg8::Gemm g{(const bf16_t*)(ws + WS_HB8), (const bf16_t*)(ws + WS_WIN8G), 1024, 1024, 1024, 0x7f7f7f7f, 0x79797979};
          pg8::DenseOrderTail S; S.d.init(64, 16, F.G, (int)blockIdx.x); S.lo = F.G == 256 ? 3 : (1 << 20); S.hi = 2; pg8::EpiGates E{GATES};
          pg8::gemm_phase<pg8::EpiGates, pg8::DenseOrderTail, false, true>(F.lds, g, S, E, tid); }
    }
    SEAM(1);
    }
    REP(2) {
    if (IN(2)) { PHASE_BEGIN();
        const float* mu = INP(5);
        float mul_[6];
#pragma unroll
        for (int j = 0; j < 6; ++j) mul_[j] = (lane + 64 * j) < 288 ? mu[3072 + lane + 64 * j] : 0.f;
        for (int t = F.gw; t < T; t += F.NGW) {
            const bool first = (t % SEQ) == 0;
#pragma unroll
            for (int j = 0; j < 6; ++j) { const int cidx = lane + 64 * j; float o = 0.f;
                if (cidx < 288) { const float uu = bf2f(MISC[(size_t)t * 512 + cidx]), pv = first ? 0.f : bf2f(MISC[(size_t)(t - 1) * 512 + cidx]);
                    const float x = uu + (pv - uu) * mul_[j];
                    o = cidx < 64 ? tanhf(x) : (cidx < 128 ? x : sigmoidf_(x)); }
                LIN[(size_t)t * 384 + cidx] = (bf16_t)f2bf(o); }
            float v8[8]; unpack8(*((const u32x4*)(CQKV + (size_t)t * 1024) + lane), v8);
            float sq = 0.f;
#pragma unroll
            for (int e = 0; e < 8; ++e) sq += v8[e] * v8[e];
            unpack8(*((const u32x4*)(CQKV + (size_t)t * 1024 + 512) + lane), v8);
            float sk = 0.f;
#pragma unroll
            for (int e = 0; e < 8; ++e) sk += v8[e] * v8[e];
            sq = wave_sum(sq); sk = wave_sum(sk);
            if (lane == 0) { RSTDQ[t] = 1.0f / sqrtf(sq * (1.f / 512.f) + NORM_EPS); RSTDKV[t] = 1.0f / sqrtf(sk * (1.f / 512.f) + NORM_EPS); }
        }
    }
    SEAM(2);
    }
    REP(3) {
    if (IN(3)) { PHASE_BEGIN();
        if (GSEL & 1) { pg8::Gemm g{LIN, WL, 384, 384, 384}; pg8::DenseOrder S; S.init(64, 12, F.G, (int)blockIdx.x); pg8::EpiLora E{OMB, AA, GG, INP(6), INP(8)};
          pg8::gemm_phase<pg8::EpiLora, pg8::DenseOrder, false>(F.lds, g, S, E, tid); }
        if (GSEL & 2) { pg8::Gemm g{CQKV, WUQ, 1024, 512, 512}; pg8::DenseOrder S; S.init(64, 6, F.G, (int)blockIdx.x); pg8::EpiRowScale E{QRAW, 1536, RSTDQ};
          pg8::gemm_phase<pg8::EpiRowScale, pg8::DenseOrder, false>(F.lds, g, S, E, tid); }
        if (GSEL & 4) { pg8::Gemm g{CQKV + 512, WUKV, 1024, 512, 512}; pg8::DenseOrder S; S.init(64, 8, F.G, (int)blockIdx.x); pg8::EpiRowScale E{KVRAW, 2048, RSTDKV};
          pg8::gemm_phase<pg8::EpiRowScale, pg8::DenseOrder, false>(F.lds, g, S, E, tid); }
    }
    SEAM(3);
    }
    REP(4) {
    if (IN(4)) { PHASE_BEGIN();
        {
            const int tk = lane & 7, j8 = lane >> 3;
            float gq_[16], gq1_[4], gq2_[4], gk_[16], gk1_[4], gk2_[4];
#pragma unroll
            for (int e = 0; e < 16; ++e) { gq_[e] = INP(21)[16 * j8 + e]; gk_[e] = INP(22)[16 * j8 + e]; }
#pragma unroll
            for (int e = 0; e < 4; ++e) { gq1_[e] = INP(21)[128 + 4 * j8 + e]; gq2_[e] = INP(21)[160 + 4 * j8 + e]; gk1_[e] = INP(22)[128 + 4 * j8 + e]; gk2_[e] = INP(22)[160 + 4 * j8 + e]; }
            double fr[4];
#pragma unroll
            for (int e = 0; e < 4; ++e) fr[e] = exp2(-(double)(4 * j8 + e) * (13.287712379549449 / 32.0)) * 0.15915494309189535;
            const float QSCALE = 0.10411754627697264f;
            struct MlaRaw { u32x4 q0, q1, k0, k1; u32x2 qa, qb; };
#define MLA_LOAD(d, hh_) do { const bf16_t* _q = QRAW + (size_t)t * 1536 + (hh_) * 192; d.q0 = *(const u32x4*)(_q + 16 * j8); d.q1 = *(const u32x4*)(_q + 16 * j8 + 8); d.qa = *(const u32x2*)(_q + 128 + 4 * j8); d.qb = *(const u32x2*)(_q + 160 + 4 * j8); \
                const bf16_t* _k = KVRAW + (size_t)t * 2048 + (hh_) * 256; d.k0 = *(const u32x4*)(_k + 16 * j8); d.k1 = *(const u32x4*)(_k + 16 * j8 + 8); } while (0)
            for (int g8 = F.gw; g8 < T / 8; g8 += F.NGW) {
                const int t = g8 * 8 + tk, bidx = t / SEQ, s = t % SEQ;
                MlaRaw cur, nxt;
                MLA_LOAD(cur, 0);
                nxt = cur;
                u32x2 ka, kb; { const bf16_t* _r = MISC + (size_t)t * 512 + 288; ka = *(const u32x2*)(_r + 4 * j8); kb = *(const u32x2*)(_r + 32 + 4 * j8); }
                float cs[4], sn[4];
                { const double pp = (double)((const GAS int*)ap->pos)[t];
#pragma unroll
                  for (int e = 0; e < 4; ++e) { double rv = pp * fr[e]; rv -= floor(rv); const float rf = (float)rv; sn[e] = __builtin_amdgcn_sinf(rf); cs[e] = __builtin_amdgcn_cosf(rf); } }
#pragma unroll 1
                for (int hd = 0; hd < 8; ++hd) {
                if (hd + 1 < 8) MLA_LOAD(nxt, hd + 1);
                { float x[16], r1[4], r2[4];
                  unpack8(cur.q0, *(float(*)[8])&x[0]); unpack8(cur.q1, *(float(*)[8])&x[8]);
                  { const u32x2 w1 = cur.qa, w2 = cur.qb;
                    r1[0] = bflo(w1.x); r1[1] = bfhi(w1.x); r1[2] = bflo(w1.y); r1[3] = bfhi(w1.y); r2[0] = bflo(w2.x); r2[1] = bfhi(w2.x); r2[2] = bflo(w2.y); r2[3] = bfhi(w2.y); }
                  float ss = 0.f;
#pragma unroll
                  for (int e = 0; e < 16; ++e) ss += x[e] * x[e];
#pragma unroll
                  for (int e = 0; e < 4; ++e) ss += r1[e] * r1[e] + r2[e] * r2[e];
                  ss += __shfl_xor(ss, 8); ss += __shfl_xor(ss, 16); ss += __shfl_xor(ss, 32);
                  const float rs = QSCALE / sqrtf(ss * (1.f / 192.f) + NORM_EPS);
#pragma unroll
                  for (int e = 0; e < 16; ++e) x[e] *= rs * gq_[e];
                  float o1[4], o2[4];
#pragma unroll
                  for (int e = 0; e < 4; ++e) { const float t1 = r1[e] * rs * gq1_[e], t2 = r2[e] * rs * gq2_[e]; o1[e] = t1 * cs[e] - t2 * sn[e]; o2[e] = t1 * sn[e] + t2 * cs[e]; }
                  bf16_t* blk = QF + ((size_t)((bidx * 8 + hd) * 256 + (s >> 5)) * 12) * 512; const int rr = s & 31;
                  u32x4 w; w.x = pk2(x[0], x[1]); w.y = pk2(x[2], x[3]); w.z = pk2(x[4], x[5]); w.w = pk2(x[6], x[7]); *(u32x4*)(blk + (j8 * 64 + rr) * 8) = w;
                  w.x = pk2(x[8], x[9]); w.y = pk2(x[10], x[11]); w.z = pk2(x[12], x[13]); w.w = pk2(x[14], x[15]); *(u32x4*)(blk + (j8 * 64 + 32 + rr) * 8) = w;
                  const int hh = (j8 & 3) >> 1, jo = 4 * (j8 & 1);
                  u32x2 w2; w2.x = pk2(o1[0], o1[1]); w2.y = pk2(o1[2], o1[3]); *(u32x2*)(blk + ((8 + (j8 >> 2)) * 64 + hh * 32 + rr) * 8 + jo) = w2;
                  w2.x = pk2(o2[0], o2[1]); w2.y = pk2(o2[2], o2[3]); *(u32x2*)(blk + ((10 + (j8 >> 2)) * 64 + hh * 32 + rr) * 8 + jo) = w2; }
                { float x[16], r1[4], r2[4];
                  unpack8(cur.k0, *(float(*)[8])&x[0]); unpack8(cur.k1, *(float(*)[8])&x[8]);
                  { const u32x2 w1 = ka, w2 = kb;
                    r1[0] = bflo(w1.x); r1[1] = bfhi(w1.x); r1[2] = bflo(w1.y); r1[3] = bfhi(w1.y); r2[0] = bflo(w2.x); r2[1] = bfhi(w2.x); r2[2] = bflo(w2.y); r2[3] = bfhi(w2.y); }
                  float ss = 0.f;
#pragma unroll
                  for (int e = 0; e < 16; ++e) ss += x[e] * x[e];
#pragma unroll
                  for (int e = 0; e < 4; ++e) ss += r1[e] * r1[e] + r2[e] * r2[e];
                  ss += __shfl_xor(ss, 8); ss += __shfl_xor(ss, 16); ss += __shfl_xor(ss, 32);
                  const float rs = 1.0f / sqrtf(ss * (1.f / 192.f) + NORM_EPS);
#pragma unroll
                  for (int e = 0; e < 16; ++e) x[e] *= rs * gk_[e];
                  float o1[4], o2[4];
#pragma unroll
                  for (int e = 0; e < 4; ++e) { const float t1 = r1[e] * rs * gk1_[e], t2 = r2[e] * rs * gk2_[e]; o1[e] = t1 * cs[e] - t2 * sn[e]; o2[e] = t1 * sn[e] + t2 * cs[e]; }
                  bf16_t* blk = KF + ((size_t)((bidx * 8 + hd) * 256 + (s >> 5)) * 12) * 512; const int rr = s & 31;
                  u32x4 w; w.x = pk2(x[0], x[1]); w.y = pk2(x[2], x[3]); w.z = pk2(x[4], x[5]); w.w = pk2(x[6], x[7]); *(u32x4*)(blk + (j8 * 64 + rr) * 8) = w;
                  w.x = pk2(x[8], x[9]); w.y = pk2(x[10], x[11]); w.z = pk2(x[12], x[13]); w.w = pk2(x[14], x[15]); *(u32x4*)(blk + (j8 * 64 + 32 + rr) * 8) = w;
                  const int hh = (j8 & 3) >> 1, jo = 4 * (j8 & 1);
                  u32x2 w2; w2.x = pk2(o1[0], o1[1]); w2.y = pk2(o1[2], o1[3]); *(u32x2*)(blk + ((8 + (j8 >> 2)) * 64 + hh * 32 + rr) * 8 + jo) = w2;
                  w2.x = pk2(o2[0], o2[1]); w2.y = pk2(o2[2], o2[3]); *(u32x2*)(blk + ((10 + (j8 >> 2)) * 64 + hh * 32 + rr) * 8 + jo) = w2;
                  }
                cur = nxt;
                }
            }
#undef MLA_LOAD
        }
        {
            LAS unsigned char* vl = F.lds + wave * 8704;
            for (int it = F.gw; it < 16 * 256; it += F.NGW) {
                const int bh = it >> 8, kb = it & 255, bidx = bh >> 3, hd = bh & 7;
                const int key = lane & 31, dh = lane >> 5;
                const bf16_t* vsrc = KVRAW + (size_t)(bidx * SEQ + kb * 32 + key) * 2048 + hd * 256 + 128 + dh * 64;
#pragma unroll
                for (int i = 0; i < 8; ++i) *(LAS u32x4*)(vl + key * 272 + (dh * 64 + i * 8) * 2) = *(const u32x4*)(vsrc + i * 8);
                LDS_WAIT(); asm volatile("" ::: "memory");
                const int r = lane & 31, hv = lane >> 5;
#pragma unroll
                for (int blk = 0; blk < 8; ++blk) { const int s2 = blk >> 2, db = blk & 3; unsigned w[4];
#pragma unroll
                    for (int jp = 0; jp < 4; ++jp) { const int j0 = 2 * jp, k0 = 16 * s2 + 8 * (j0 >> 2) + 4 * hv + (j0 & 3);
                        const unsigned lo = *(const LAS unsigned short*)(vl + k0 * 272 + (32 * db + r) * 2), hi = *(const LAS unsigned short*)(vl + (k0 + 1) * 272 + (32 * db + r) * 2); w[jp] = lo | (hi << 16); }
                    *(u32x4*)(VTF + ((size_t)(bh * 256 + kb) * 8 + blk) * 512 + lane * 8) = (u32x4){w[0], w[1], w[2], w[3]}; }
                LDS_WAIT(); asm volatile("" ::: "memory");
            }
        }
        __syncthreads();
        for (int it = F.gw; it < 8192; it += F.NGW) chunk_pre(F.lds + wave * PRE_LDS, ws, rec_ptr((unsigned char*)ws, (unsigned char*)OUT, it >> 8, it & 255), it >> 8, it & 255, lane, INP(5), INP(11), INP(12), INP(13));
    }
    SEAM(4);
    }
    REP(5) {
    if (IN(5)) { PHASE_BEGIN();
        const int bx = blockIdx.x;
#if CHUNKED
#if CHUNK_DEBUG
        if (bx < 32) { if (wave == 0) chunk_seq(F.lds, (unsigned char*)ws, (unsigned char*)OUT, YS, bx >> 1, bx & 1, lane, (volatile LAS int*)(F.lds + LDSCTL_OFF + 128)); __syncthreads(); }
        if (bx >= 96 && bx < 128) scan_block(F.lds, ws, YS, (bx - 64) >> 1, bx & 1, tid, wave, lane);
#else
#define EXP_ITEM(it0_, srcp, lds_, dstp, ldd_) do { const int _i = (it0_); if (_i < 65536) { const int nb = _i & 3, kb = (_i >> 2) & 31, j = (_i >> 7) & 3, gu = (_i >> 9) & 1, e = _i >> 10; \
                        srcp = (gu ? INP(29) : INP(28)) + (size_t)e * 2048 * 512 + (size_t)kb * 64 * 512 + j * 128 + nb * 32; lds_ = 512; dstp = (unsigned char*)WEG + (size_t)(e * 1024 + j * 256 + nb * 64 + gu * 32) * 2048 + kb * 64; ldd_ = 2048; } \
                    else { const int _q = _i - 65536; const int nb = _q & 63, kb = (_q >> 6) & 7, e = _q >> 9; srcp = INP(30) + (size_t)e * 512 * 2048 + (size_t)kb * 64 * 2048 + nb * 32; lds_ = 2048; dstp = (unsigned char*)WED + (size_t)(e * 2048 + nb * 32) * 512 + kb * 64; ldd_ = 512; } } while (0)
        if (bx < 64) {
            volatile LAS int* prog = (volatile LAS int*)(F.lds + LDSCTL_OFF + 128);
            if (wave == 0) chunk_seq(F.lds, (unsigned char*)ws, (unsigned char*)OUT, YS, bx >> 1, bx & 1, lane, prog);
            else if (wave < 4) {
                LAS float* scr2 = (LAS float*)(F.lds + 2 * SEQ_SLOT + (wave - 1) * 8448);
#pragma unroll 1
                for (;;) {
                    if (prog[0] >= CV_HSTOP) break;
                    int c = 0; if (lane == 0) c = (int)atomicAdd(&F.ctl[CW_CVH], 1u);
                    c = __builtin_amdgcn_readfirstlane(c);
                    if (c >= CV_HSHARE) break;
                    f32x4 va_[8], vb_[8]; const float* sp; unsigned char* dpa; unsigned char* dpb; int l1, l2a, l2b;
#pragma unroll 1
                    for (int q = 0; q < 64; q += 2) {
                        EXP_ITEM(c * 64 + q, sp, l1, dpa, l2a); conv_load(sp, l1, lane, va_);
                        EXP_ITEM(c * 64 + q + 1, sp, l1, dpb, l2b); conv_load(sp, l1, lane, vb_);
                        conv_store8(va_, dpa, l2a, scr2, lane, W8_SCALE); conv_store8(vb_, dpb, l2b, scr2, lane, W8_SCALE);
                    }
                }
            }
            __syncthreads();
        }
#endif
#if CHUNK_DEBUG
        if (bx >= 64 && bx < 96) scan_block(F.lds, ws, (bf16_t*)(ws + WS_YDBG), (bx - 64) >> 1, bx & 1, tid, wave, lane);
        { XcdBarrier _b; _b.bar = (unsigned*)(ws + WS_CTL) + CW_BAR; _b.x = xb_xcc_id(); _b.st = (volatile LAS unsigned*)((LAS unsigned char*)lds_raw + LDSCTL_OFF) + 8; xcd_barrier(_b); }
#endif
#else
        REP(21) if (bx < 64) scan_block(F.lds, ws, YS, bx >> 1, bx & 1, tid, wave, lane);
#endif
        REP(20) {
            volatile LAS int* qw = (volatile LAS int*)(F.lds + LDSCTL_OFF + 64);
#pragma unroll 1
            for (;;) {
                if (tid == 0) qw[0] = (int)atomicAdd(&F.ctl[CW_ATTQ + 64 * _rep], 1u);
                __syncthreads();
                const int uix = qw[0];
                if (uix >= 512) break;
                attn_unit(F.lds, QF, KF, VTF, OB, uix & 15, 31 - (uix >> 4), tid, wave, lane);
            }
            __syncthreads();
        }
        {
            volatile LAS int* qw = (volatile LAS int*)(F.lds + LDSCTL_OFF + 64);
#pragma unroll 1
            for (;;) {
                __syncthreads();
                constexpr int CV_MISC = 1024 + 1024 + 2048 + 3 * 64 + 8 * 128 + 512 + 256 + 2048;
                if (tid == 0) { int c = CV_HSHARE + (int)atomicAdd(&F.ctl[CW_CVQ], 1u);
                    if (c >= (98304 + CV_MISC + 63) / 64) { c = (int)atomicAdd(&F.ctl[CW_CVH], 1u); if (c >= CV_HSHARE) c = 1 << 30; }
                    qw[0] = c; }
                __syncthreads();
                const int cix = qw[0];
                if (cix >= (98304 + CV_MISC + 63) / 64) break;
                if (cix < 1536) {
                    f32x4 va_[8], vb_[8]; const float* sp; unsigned char* dpa; unsigned char* dpb; int l1, l2a, l2b;
                    EXP_ITEM(cix * 64 + wave, sp, l1, dpa, l2a); conv_load(sp, l1, lane, va_);
#pragma unroll
                    for (int k8 = 0; k8 < 8; k8 += 2) {
                        EXP_ITEM(cix * 64 + (k8 + 1) * 8 + wave, sp, l1, dpb, l2b); conv_load(sp, l1, lane, vb_);
                        conv_store8(va_, dpa, l2a, scr, lane, W8_SCALE);
                        if (k8 + 2 < 8) { EXP_ITEM(cix * 64 + (k8 + 2) * 8 + wave, sp, l1, dpa, l2a); conv_load(sp, l1, lane, va_); }
                        conv_store8(vb_, dpb, l2b, scr, lane, W8_SCALE);
                    }
                } else
#pragma unroll 1
                for (int k8 = 0; k8 < 8; ++k8) {
                    const int it0 = cix * 64 + k8 * 8 + wave;
                    if (it0 >= 98304 && it0 < 98304 + CV_MISC) {
                        int r = it0 - 98304;
                        CONV_JOB8X(INP(16), 2048, 0, 2048, 1024, WA, 1024, 0, 8)
                        CONV_JOB8X(INP(23), 2048, 0, 2048, 1024, WB, 1024, 0, 8)
                        CONV_JOB8X(INP(24), 2048, 0, 2048, 2048, WO, 2048, 0, 8)
                        CONV_JOB(INP(26), 64, 0, 64, 2048, (const float*)nullptr, 0, WR, 4096, 0, 0)
                        CONV_JOB(INP(26), 64, 0, 64, 2048, (const float*)nullptr, 0, WR, 4096, 0, 2048)
                        CONV_JOB(INP(26), 64, 0, 64, 2048, (const float*)nullptr, 1, WR, 4096, 64, 0)
                        CONV_JOB8X(INP(31), 512, 0, 128, 2048, WSHGU, 2048, 0, 16)
                        CONV_JOB8X(INP(32), 512, 0, 128, 2048, WSHGU, 2048, 32, 16)
                        CONV_JOB8X(INP(31), 512, 128, 128, 2048, WSHGU, 2048, 256, 16)
                        CONV_JOB8X(INP(32), 512, 128, 128, 2048, WSHGU, 2048, 288, 16)
                        CONV_JOB8X(INP(31), 512, 256, 128, 2048, WSHGU, 2048, 512, 16)
                        CONV_JOB8X(INP(32), 512, 256, 128, 2048, WSHGU, 2048, 544, 16)
                        CONV_JOB8X(INP(31), 512, 384, 128, 2048, WSHGU, 2048, 768, 16)
                        CONV_JOB8X(INP(32), 512, 384, 128, 2048, WSHGU, 2048, 800, 16)
                        CONV_JOB8X(INP(33), 2048, 0, 2048, 512, WSHD, 512, 0, 8)
                        CONV_JOB(INP(34), 2048, 0, 2048, 256, (const float*)nullptr, 0, WPLE, 256, 0, 0)
                        CONV_JOB8X(INP(37), 2048, 0, 2048, 2048, WPG, 2048, 0, 8)
                    }
                }
            }
            __syncthreads();
        }
    }
    SEAM(5);
    }
    REP(6) {
    if (IN(6)) { PHASE_BEGIN();
        const int ch = 16 * lane;
        float gw_[16], gb_[16];
#pragma unroll
        for (int e = 0; e < 16; ++e) { gw_[e] = INP(14)[ch + e]; gb_[e] = INP(15)[ch + e]; }
        for (int t = F.gw; t < T; t += F.NGW) {
            float y[16], vv[16], gg[16];
            unpack8(*(const u32x4*)(YS + (size_t)t * 1024 + ch), *(float(*)[8])&y[0]); unpack8(*(const u32x4*)(YS + (size_t)t * 1024 + ch + 8), *(float(*)[8])&y[8]);
#if CHUNK_DEBUG
            if (t < SEQ) { float yo[16]; unpack8(*(const u32x4*)((const bf16_t*)(ws + WS_YDBG) + (size_t)t * 1024 + ch), *(float(*)[8])&yo[0]); unpack8(*(const u32x4*)((const bf16_t*)(ws + WS_YDBG) + (size_t)t * 1024 + ch + 8), *(float(*)[8])&yo[8]);
              float dn = 0.f, dd = 0.f;
#pragma unroll
              for (int e = 0; e < 16; ++e) { dn += (y[e] - yo[e]) * (y[e] - yo[e]); dd += yo[e] * yo[e]; }
              dn = wave_sum(dn); dd = wave_sum(dd);
              if (!(dn < 1e12f)) dn = 1e12f;
              if (lane == 0 && t < DBG_TMAX) { atomicAdd((unsigned long long*)&F.ctl[CW_DBG], (unsigned long long)(dn * 4096.f)); atomicAdd((unsigned long long*)&F.ctl[CW_DBG + 2], (unsigned long long)(dd * 4096.f)); }
#pragma unroll
              for (int e = 0; e < 16; ++e) y[e] = yo[e]; }

#endif
            unpack8(*(const u32x4*)(VBB + (size_t)t * 1024 + ch), *(float(*)[8])&vv[0]); unpack8(*(const u32x4*)(VBB + (size_t)t * 1024 + ch + 8), *(float(*)[8])&vv[8]);
            unpack8(*(const u32x4*)(GG + (size_t)t * 1024 + ch), *(float(*)[8])&gg[0]); unpack8(*(const u32x4*)(GG + (size_t)t * 1024 + ch + 8), *(float(*)[8])&gg[8]);
            float sm = 0.f;
#pragma unroll
            for (int e = 0; e < 16; ++e) sm += y[e];
            sm += __shfl_xor(sm, 1); sm += __shfl_xor(sm, 2);
            const float mean = sm * (1.f / 64.f); float vs = 0.f;
#pragma unroll
            for (int e = 0; e < 16; ++e) { const float d = y[e] - mean; vs += d * d; }
            vs += __shfl_xor(vs, 1); vs += __shfl_xor(vs, 2);
            const float rstd = 1.0f / sqrtf(vs * (1.f / 64.f) + GN_EPS), bon = BONUS[(size_t)t * 16 + (lane >> 2)];
            float o[16];
#pragma unroll
            for (int e = 0; e < 16; ++e) o[e] = ((y[e] - mean) * rstd * gw_[e] + gb_[e] + bon * vv[e]) * gg[e];
            u32x4 w0; w0.x = pk4_fp8((f32x4){o[0], o[1], o[2], o[3]} * O8_SCALE); w0.y = pk4_fp8((f32x4){o[4], o[5], o[6], o[7]} * O8_SCALE); w0.z = pk4_fp8((f32x4){o[8], o[9], o[10], o[11]} * O8_SCALE); w0.w = pk4_fp8((f32x4){o[12], o[13], o[14], o[15]} * O8_SCALE);
            *(u32x4*)((unsigned char*)OA + (size_t)t * 1024 + ch) = w0;
        }
    }
    SEAM(6);
    }
    REP(7) {
    if (IN(7)) { PHASE_BEGIN();
        { pg8::Gemm g{OA, WA, 512, 512, 512, 0x7d7d7d7d, 0x79797979}; pg8::DenseOrder S; S.init(64, 8, F.G, (int)blockIdx.x); pg8::EpiMerge<0> E{MERGED, GATES, 0, nullptr};
          pg8::gemm_phase<pg8::EpiMerge<0>, pg8::DenseOrder, false, true>(F.lds, g, S, E, tid); }
        { pg8::Gemm g{OB, WB, 512, 512, 512, 0x7d7d7d7d, 0x79797979}; pg8::DenseOrder S; S.init(64, 8, F.G, (int)blockIdx.x); pg8::EpiMerge<1> E{MERGED, GATES, 2048, (unsigned char*)(ws + WS_MERGED8)};
          pg8::gemm_phase<pg8::EpiMerge<1>, pg8::DenseOrder, false, true>(F.lds, g, S, E, tid); }
    }
    SEAM(7);
    }
    REP(8) {
    if (IN(8)) { PHASE_BEGIN();
        pg8::Gemm g{(const bf16_t*)(ws + WS_MERGED8), WO, 1024, 1024, 1024, 0x7d7d7d7d, 0x79797979}; pg8::DenseOrder S; S.init(64, 8, F.G, (int)blockIdx.x); pg8::EpiResid E{INP(0), OUT};
        pg8::gemm_phase<pg8::EpiResid, pg8::DenseOrder, false, true>(F.lds, g, S, E, tid);
    }
    SEAM(8);
    }
    REP(9) {
    if (IN(9)) { PHASE_BEGIN();
        for (int m = F.gw; m < T; m += F.NGW) rms_row_bf16(OUT + (size_t)m * D, INP(25), H2 + (size_t)m * 4096, H2 + (size_t)m * 4096 + 2048, lane, (unsigned char*)(ws + WS_H2F8) + (size_t)m * D);
    }
    SEAM(9);
    }
    REP(10) {
    if (IN(10)) { PHASE_BEGIN();
        if (GSEL & 1) { pg8::Gemm g{H2, WR, 4096, 1024, 4096}; pg8::RouterOrder S{F.G, (int)blockIdx.x}; pg8::EpiLogit E{LOGIT};
          pg8::gemm_phase<pg8::EpiLogit, pg8::RouterOrder, false>(F.lds, g, S, E, tid); }
        if (GSEL & 2) { pg8::Gemm g{(const bf16_t*)(ws + WS_H2F8), WSHGU, 1024, 1024, 1024, 0x7f7f7f7f, 0x79797979}; pg8::DenseOrder S; S.init(64, 4, F.G, (int)blockIdx.x); pg8::EpiSwiglu8 E{(unsigned char*)ACTSH};
          pg8::gemm_phase<pg8::EpiSwiglu8, pg8::DenseOrder, false, true>(F.lds, g, S, E, tid); }
        if (GSEL & 4) { pg8::Gemm g{PBF, WPLE, 256, 256, 256}; pg8::DenseOrder S; S.init(64, 8, F.G, (int)blockIdx.x); pg8::EpiRowScale E{PLERAW, 2048, nullptr};
          pg8::gemm_phase<pg8::EpiRowScale, pg8::DenseOrder, false>(F.lds, g, S, E, tid); }
    }
    SEAM(10);
    }
    REP(11) {
    if (IN(11)) { PHASE_BEGIN();
        const float bias = INP(27)[lane];
        LAS int* lcnt = (LAS int*)(F.lds);
        LAS int* lbase = lcnt + 64;
        if (tid < 64) lcnt[tid] = 0;
        __syncthreads();
        const int tpw = T / F.G, t0 = F.vcu * tpw;
        for (int tt = wave; tt < tpw; tt += 8) {
            const int t = t0 + tt;
            float lg = 0.f;
#pragma unroll
            for (int kc = 0; kc < 4; ++kc) lg += LOGIT[(size_t)kc * T * 128 + (size_t)t * 128 + lane] + LOGIT[(size_t)kc * T * 128 + (size_t)t * 128 + 64 + lane];
            lg = (fabsf(lg) < 1e30f) ? lg : 0.f;
            const float score = 1.0f / (1.0f + expf(-lg)), choice = score + bias;
            float m1 = choice; m1 = fmaxf(m1, __shfl_xor(m1, 1)); m1 = fmaxf(m1, __shfl_xor(m1, 2)); m1 = fmaxf(m1, __shfl_xor(m1, 4));
            const unsigned long long eq = __ballot(choice == m1);
            const int grp = lane >> 3; const unsigned geq = (unsigned)(eq >> (8 * grp)) & 0xffu; const int firstl = __builtin_ctz(geq);
            float c2 = ((lane & 7) == firstl) ? -__builtin_inff() : choice;
            float m2 = c2; m2 = fmaxf(m2, __shfl_xor(m2, 1)); m2 = fmaxf(m2, __shfl_xor(m2, 2)); m2 = fmaxf(m2, __shfl_xor(m2, 4));
            const float gs = m1 + m2;
            int grank = 0;
#pragma unroll
            for (int g2 = 0; g2 < 8; ++g2) { const float og = __shfl(gs, 8 * g2); grank += (og > gs || (og == gs && g2 < grp)) ? 1 : 0; }
            const bool cand = grank < 4;
            const float cv = cand ? choice : -__builtin_inff();
            int rank = 0;
#pragma unroll 8
            for (int j = 0; j < 64; ++j) { const float ov = __shfl(cv, j); rank += (ov > cv || (ov == cv && j < lane)) ? 1 : 0; }
            const bool sel = cand && rank < 8;
            const float wsum = wave_sum(sel ? score : 0.f);
            const unsigned long long sm = __ballot(sel);
            if (sel) {
                const int kslot = __popcll(sm & ((1ull << lane) - 1ull));
                const int ls = atomicAdd((int*)&lcnt[lane], 1);
                EIDX[(size_t)t * 8 + kslot] = lane; WTS[(size_t)t * 8 + kslot] = score / (wsum + 1e-20f) * 2.5f; SLOT[(size_t)t * 8 + kslot] = ls;
            }
            { float sq = 0.f;
#pragma unroll
              for (int j = 0; j < 4; ++j) { float v8[8]; unpack8(*((const u32x4*)(PLERAW + (size_t)t * 2048) + lane + 64 * j), v8);
#pragma unroll
                  for (int e = 0; e < 8; ++e) sq += v8[e] * v8[e]; }
              sq = wave_sum(sq); if (lane == 0) RSTDP[t] = 1.0f / sqrtf(sq * (1.f / 2048.f) + NORM_EPS); }
        }
        __syncthreads();
        if (tid < 64) lbase[tid] = (int)atomicAdd(&F.ctl[CW_CNT + tid], (unsigned)lcnt[tid]);
        __syncthreads();
        for (int i = tid; i < tpw * 8; i += 512) { const size_t o = (size_t)t0 * 8 + i; SLOT[o] += lbase[EIDX[o]]; }
        __syncthreads();
    }
    SEAM(11);
    }
    REP(12) {
    if (IN(12)) { PHASE_BEGIN();
        LAS int* pst = (LAS int*)(F.lds);
        if (wave == 0) {
            const int cn = (int)__hip_atomic_load(&F.ctl[CW_CNT + lane], __ATOMIC_RELAXED, __HIP_MEMORY_SCOPE_AGENT); const int nt = (cn + 255) >> 8;
            int rank = 0;
#pragma unroll 8
            for (int j = 0; j < 64; ++j) { const int ov = __shfl(nt, j); rank += (ov > nt || (ov == nt && j < lane)) ? 1 : 0; }
            const int rr = rank >> 3, rc = rank & 7, grp = (rr & 1) ? 7 - rc : rc, q = grp * 8 + rr;
            pst[160 + q] = nt;
            LDS_WAIT(); asm volatile("" ::: "memory");
            const int v = pst[160 + lane]; int incl = v;
#pragma unroll
            for (int d = 1; d < 64; d <<= 1) { const int o = __shfl_up(incl, d); if (lane >= d) incl += o; }
            pst[240 + lane] = incl - v;
            LDS_WAIT(); asm volatile("" ::: "memory");
            const int st = pst[240 + q], total = __shfl(incl, 63);
            pst[lane] = st * 256; pst[80 + lane] = (st + nt) * 256;
            if (lane == 0) pst[64] = total * 256;
            if (lane < 8) pst[320 + lane] = pst[240 + 8 * lane];
            if (lane == 8) pst[328] = total;
        }
        __syncthreads();
        const int tpw = T / F.G, t0 = F.vcu * tpw;
        for (int i = tid; i < tpw * 8; i += 512) { const size_t o = (size_t)t0 * 8 + i; const int e = EIDX[o], dest = pst[e] + SLOT[o]; POS[o] = dest; ROWTOK[dest] = (int)(o >> 3); ROWW[dest] = WTS[o]; }
        for (int e = F.vcu; e < 64; e += F.G) {
            const int cn = (int)__hip_atomic_load(&F.ctl[CW_CNT + e], __ATOMIC_RELAXED, __HIP_MEMORY_SCOPE_AGENT);
            for (int r = pst[e] + cn + tid; r < pst[80 + e]; r += 512) { ROWTOK[r] = 0; ROWW[r] = 0.f; }
            for (int tl = pst[e] / 256 + tid; tl < pst[80 + e] / 256; tl += 512) TILEE[tl] = e;
        }
        if (F.vcu == 0 && tid == 0) TILEE[1023] = pst[64] / 256;
        if (F.vcu == 0 && tid < 9) TILEE[1008 + tid] = pst[320 + tid];
        __syncthreads();
    }
    SEAM(12);
    }
    REP(13) {
    if (IN(13)) { PHASE_BEGIN();
        const int gx = (int)blockIdx.x & 7, gt0 = TILEE[1008 + gx], gnt = TILEE[1009 + gx] - gt0;
        if (GSEL & 1) { pg8::Gemm g{(const bf16_t*)(ws + WS_H2F8), WEG, 1024, 1024, 1024, 0x7f7f7f7f, 0x79797979}; pg8::MoeOrder S{gt0, gnt, 4, F.G >> 3, (int)blockIdx.x >> 3, TILEE, ROWTOK}; pg8::EpiSwiglu8 E{(unsigned char*)ACT};
          pg8::gemm_phase<pg8::EpiSwiglu8, pg8::MoeOrder, true, true>(F.lds, g, S, E, tid); }
        {
          pg8::Gemm g{ACTSH, WSHD, 256, 256, 256, 0x7c7c7c7c, 0x79797979}; pg8::DenseOrder S; S.init(64, 8, F.G, (int)blockIdx.x); pg8::EpiRowScale E{(bf16_t*)(ws + WS_YSH), 2048, nullptr};
          pg8::gemm_phase<pg8::EpiRowScale, pg8::DenseOrder, false, true>(F.lds, g, S, E, tid); }
    }
    SEAM(13);
    }
    REP(14) {
    if (IN(14)) { PHASE_BEGIN();
        const int gx = (int)blockIdx.x & 7, gt0 = TILEE[1008 + gx], gnt = TILEE[1009 + gx] - gt0;
        pg8::Gemm g{ACT, WED, 256, 256, 256, 0x7c7c7c7c, 0x79797979}; pg8::MoeOrder S{gt0, gnt, 8, F.G >> 3, (int)blockIdx.x >> 3, TILEE, ROWTOK}; pg8::EpiDown E{(unsigned char*)(ws + WS_Y2B), ROWW};
        pg8::gemm_phase<pg8::EpiDown, pg8::MoeOrder, false, true>(F.lds, g, S, E, tid);
    }
    SEAM(14);
    }
    if (IN(15)) { PHASE_BEGIN();
        for (int t = F.gw; t < T; t += F.NGW) {
            f32x4 x[8];
#pragma unroll
            for (int j = 0; j < 8; ++j) x[j] = *((const f32x4*)(OUT + (size_t)t * D) + lane + 64 * j);
            int pk[8]; float wk[8]; unsigned yw[8][8];
#pragma unroll
            for (int j = 0; j < 8; ++j) { const u32x2 w = *((const u32x2*)((const bf16_t*)(ws + WS_YSH) + (size_t)t * D) + lane + 64 * j); x[j][0] += bflo(w.x); x[j][1] += bfhi(w.x); x[j][2] += bflo(w.y); x[j][3] += bfhi(w.y); }
#pragma unroll
            for (int k = 0; k < 8; ++k) pk[k] = POS[(size_t)t * 8 + k];
#pragma unroll
            for (int k = 0; k < 8; ++k) wk[k] = ROWW[pk[k]] * (1.f / Y8_SCALE);
#pragma unroll
            for (int k = 0; k < 8; ++k) { const unsigned* yr = (const unsigned*)(ws + WS_Y2B + (size_t)pk[k] * 2048) + lane;
#pragma unroll
                for (int j = 0; j < 8; ++j) yw[k][j] = yr[64 * j]; }
#pragma unroll
            for (int k = 0; k < 8; ++k)
#pragma unroll
                for (int j = 0; j < 8; ++j) { const unsigned w = yw[k][j]; const auto lo = __builtin_amdgcn_cvt_pk_f32_fp8((int)w, false), hi = __builtin_amdgcn_cvt_pk_f32_fp8((int)w, true);
                    x[j][0] += lo[0] * wk[k]; x[j][1] += lo[1] * wk[k]; x[j][2] += hi[0] * wk[k]; x[j][3] += hi[1] * wk[k]; }
#pragma unroll
            for (int j = 0; j < 8; ++j) *((f32x4*)(OUT + (size_t)t * D) + lane + 64 * j) = x[j];
            float s = 0.f;
#pragma unroll
            for (int j = 0; j < 8; ++j) s += (x[j][0] * x[j][0] + x[j][1] * x[j][1]) + (x[j][2] * x[j][2] + x[j][3] * x[j][3]);
            const float rstd = 1.0f / sqrtf(wave_sum(s) * (1.f / 2048.f) + NORM_EPS);
#pragma unroll
            for (int j = 0; j < 8; ++j) { const f32x4 gq = *((const f32x4*)INP(36) + lane + 64 * j); const f32x4 y = x[j] * rstd * gq; ((unsigned*)((unsigned char*)XN3 + (size_t)t * D))[lane + 64 * j] = pk4_fp8(y); }
        }
    }
    SEAM(15);
    REP(18) {
    if (IN(18)) { PHASE_BEGIN();
        pg8::Gemm g{XN3, WPG, 1024, 1024, 1024, 0x7f7f7f7f, 0x79797979}; pg8::DenseOrder S; S.init(64, 8, F.G, (int)blockIdx.x); float dsc = 1.0f;
#if CHUNK_DEBUG
        { const float dn = (float)*(const unsigned long long*)&F.ctl[CW_DBG], dd = (float)*(const unsigned long long*)&F.ctl[CW_DBG + 2]; dsc = 1.0f + DBG_GAIN * sqrtf(dn / fmaxf(dd, 1.f)); }
#endif
        pg8::EpiFinal E{OUT, PLERAW, RSTDP, INP(35), dsc};
        pg8::gemm_phase<pg8::EpiFinal, pg8::DenseOrder, false, true>(F.lds, g, S, E, tid);
    }
    SEAM(18);
    }
#undef IN
#undef SEAM
#undef OUT
#undef INP
#undef PHASE_BEGIN
}

#ifndef N_LAUNCH_PER_PHASE
#define N_LAUNCH_PER_PHASE 0
#endif
extern "C" void kernel_launch(void* const* d_in, const int* in_sizes, int n_in, void* d_out, int out_size, void* d_ws, size_t ws_size, hipStream_t stream) {
    static int grid = 0;
    if (grid == 0) {
        if (n_in != 38 || out_size != T * D || ws_size < WS_END) { fprintf(stderr, "kernel_launch: unexpected shapes (n_in %d out %d ws %zu)\n", n_in, out_size, ws_size); grid = -1; return; }
        int dev = 0, cus = 0, per_cu = 0;
        if (hipGetDevice(&dev) != hipSuccess || hipDeviceGetAttribute(&cus, hipDeviceAttributeMultiprocessorCount, dev) != hipSuccess) { grid = -1; return; }
        if (hipFuncSetAttribute((const void*)hybrid_fwd, hipFuncAttributeMaxDynamicSharedMemorySize, LDS_BYTES) != hipSuccess) { fprintf(stderr, "kernel_launch: hipFuncSetAttribute failed\n"); grid = -1; return; }
        if (hipOccupancyMaxActiveBlocksPerMultiprocessor(&per_cu, (const void*)hybrid_fwd, 512, LDS_BYTES) != hipSuccess || per_cu < 1) fprintf(stderr, "kernel_launch: occupancy query reports %d\n", per_cu);
        (void)hipGetLastError();
        grid = cus;
    }
    if (grid < 0) return;
    (void)hipMemsetAsync((char*)d_ws + WS_CTL, 0, ZERO_BYTES, stream);
    Args a{};
    for (int i = 0; i < 38; ++i) a.in[i] = (const float*)d_in[i];
    a.pos = (const int*)d_in[2]; a.out = (float*)d_out; a.ws = (unsigned char*)d_ws;
#if N_LAUNCH_PER_PHASE
    for (int ph = 0; ph < NPH; ++ph) { a.ph_lo = ph; a.ph_hi = ph + 1; hipLaunchKernelGGL(hybrid_fwd, dim3(grid), dim3(512), LDS_BYTES, stream, a); }
#else
    a.ph_lo = 0; a.ph_hi = NPH; hipLaunchKernelGGL(hybrid_fwd, dim3(grid), dim3(512), LDS_BYTES, stream, a);
#endif
}
```

```cpp
#include <hip/hip_runtime.h>
#include <cstdio>
#include <cstdint>

#define GAS __attribute__((address_space(1)))
#define LAS __attribute__((address_space(3)))
typedef unsigned short bf16_t;
typedef short bf16x8 __attribute__((ext_vector_type(8)));
typedef float f32x4 __attribute__((ext_vector_type(4)));
typedef float f32x16 __attribute__((ext_vector_type(16)));
typedef unsigned u32x4 __attribute__((ext_vector_type(4)));
typedef unsigned u32x2 __attribute__((ext_vector_type(2)));

constexpr int T = 16384, SEQ = 8192, NB = 2, D = 2048;
constexpr int NPH = 19;
constexpr float NORM_EPS = 1e-6f, GN_EPS = 64e-5f;
constexpr int NTH = 288;
constexpr int PMAX = 147456;

constexpr size_t MiB = 1u << 20;
constexpr size_t WS_CTL = 0, ZERO_BYTES = 8 * MiB;
constexpr size_t WS_WL = 1 * MiB;
constexpr size_t WS_WR = 4 * MiB;
constexpr size_t WS_WIN8G = 26 * MiB  , WS_HB8 = 316 * MiB  ;
constexpr size_t WS_WIN = 8 * MiB;
constexpr size_t WS_WUQ = 42 * MiB, WS_WUKV = 44 * MiB, WS_WA = 46 * MiB, WS_WB = 50 * MiB, WS_WO = 54 * MiB;
constexpr size_t WS_WSHGU = 62 * MiB, WS_WSHD = 66 * MiB, WS_WPLE = 68 * MiB, WS_WPG = 70 * MiB, WS_PBF = 78 * MiB;
constexpr size_t WS_SMALL = 86 * MiB;
constexpr size_t WS_RSTDQ = WS_SMALL, WS_RSTDKV = WS_SMALL + 65536, WS_RSTDP = WS_SMALL + 2 * 65536, WS_BONUS = WS_SMALL + 3 * 65536;
constexpr size_t WS_EIDX = WS_SMALL + 2 * MiB, WS_WTS = WS_EIDX + 512 * 1024, WS_POS = WS_WTS + 512 * 1024, WS_SLOT = WS_POS + 512 * 1024;
constexpr size_t WS_ROWTOK = WS_SMALL + 4 * MiB, WS_ROWW = WS_ROWTOK + 640 * 1024, WS_TILEE = WS_ROWW + 640 * 1024;
constexpr size_t WS_GATES = 92 * MiB, WS_OM = 220 * MiB, WS_AA = 252 * MiB, WS_GG = 284 * MiB;
constexpr size_t WS_R = 636 * MiB, WS_KP = 668 * MiB, WS_KK = 812 * MiB, WS_BB = 968 * MiB, WS_VB = 444 * MiB, WS_RECB = 316 * MiB  , WS_YDBG = 1020 * MiB  , WS_QF = 476 * MiB, WS_KF = 524 * MiB, WS_VTF = 572 * MiB;
constexpr size_t WS_Y = 604 * MiB, WS_OB = 252 * MiB  , WS_OA = 316 * MiB  , WS_MERGED = 476 * MiB  , WS_MERGED8 = 540 * MiB  ;
constexpr size_t WS_WEG = 636 * MiB, WS_WED = 892 * MiB, WS_H2F8 = 764 * MiB;
constexpr size_t WS_H = 636 * MiB, WS_RKV = 700 * MiB, WS_MISC = 796 * MiB, WS_CQKV = 812 * MiB, WS_L = 844 * MiB, WS_QRAW = 856 * MiB, WS_KVRAW = 904 * MiB;
constexpr size_t WS_H2 = 92 * MiB, WS_LOGIT = 220 * MiB  , WS_ACTSH = 252 * MiB, WS_ACT = 268 * MiB, WS_PLERAW = 412 * MiB;
constexpr size_t WS_YSH = 92 * MiB  ;
constexpr size_t WS_Y2 = 92 * MiB, WS_Y2B = 476 * MiB, WS_XN3 = 268 * MiB;
constexpr int Y2A_TILES = 176;
constexpr float ACT8_SCALE = 8.f, W8_SCALE = 64.f;
constexpr float O8_SCALE = 4.f;
constexpr float Y8_SCALE = 8.f;
constexpr size_t WS_END = 1020 * MiB;
static_assert(WS_AA == WS_OM + 32 * MiB && WS_GG == WS_AA + 32 * MiB && WS_ACT + (size_t)PMAX * 512 * 2 <= WS_PLERAW && WS_Y2 + (size_t)Y2A_TILES * MiB <= WS_ACT && WS_Y2B + (size_t)(PMAX / 256 - Y2A_TILES) * MiB <= WS_WED
              && WS_PLERAW + 64 * MiB <= WS_Y2B && WS_KVRAW + 64 * MiB <= WS_END, "ws map");
constexpr int CW_BAR = 4096, CW_CNT = 65536, CW_ATTQ = 66560, CW_CVQ = 67072, CW_CVH = 67136, CW_DBG = 67200;
#ifndef CHUNKED
#define CHUNKED 1
#endif
#ifndef CHUNK_DEBUG
#define CHUNK_DEBUG 0
#endif
#ifndef DBG_GAIN
#define DBG_GAIN 30.0f
#endif
#ifndef DBG_TMAX
#define DBG_TMAX 8192
#endif

constexpr int RING_BYTES = 131072, LDSCTL_OFF = RING_BYTES, LDS_BYTES = 147456;

#define LDS_WAIT() asm volatile("s_waitcnt lgkmcnt(0)" ::: "memory")
#define VM_WAIT() asm volatile("s_waitcnt vmcnt(0)" ::: "memory")
__device__ __forceinline__ unsigned f2bf(float f) { unsigned u = __builtin_bit_cast(unsigned, f); return (u + 0x7fffu + ((u >> 16) & 1u)) >> 16; }
__device__ __forceinline__ unsigned pk2(float lo, float hi) { return f2bf(lo) | (f2bf(hi) << 16); }
__device__ __forceinline__ int fbits(float x) { return __builtin_bit_cast(int, x); }
__device__ __forceinline__ float bf2f(unsigned b) { return __builtin_bit_cast(float, b << 16); }
__device__ __forceinline__ float bflo(unsigned w) { return __builtin_bit_cast(float, w << 16); }
__device__ __forceinline__ float bfhi(unsigned w) { return __builtin_bit_cast(float, w & 0xffff0000u); }
__device__ __forceinline__ unsigned cvt_pk_bf16(float lo, float hi) { unsigned r; asm volatile("v_cvt_pk_bf16_f32 %0, %1, %2" : "=v"(r) : "v"(lo), "v"(hi)); return r; }
__device__ __forceinline__ u32x4 pack8(f32x4 a, f32x4 b) { unsigned x, y, z, w;
    asm volatile("s_nop 0\n\tv_cvt_pk_bf16_f32 %0, %4, %5\n\tv_cvt_pk_bf16_f32 %1, %6, %7\n\tv_cvt_pk_bf16_f32 %2, %8, %9\n\tv_cvt_pk_bf16_f32 %3, %10, %11"
                 : "=&v"(x), "=&v"(y), "=&v"(z), "=&v"(w) : "v"(a[0]), "v"(a[1]), "v"(a[2]), "v"(a[3]), "v"(b[0]), "v"(b[1]), "v"(b[2]), "v"(b[3]));
    return (u32x4){x, y, z, w}; }
__device__ __forceinline__ void unpack8(u32x4 w, float (&v)[8]) { v[0] = bflo(w.x); v[1] = bfhi(w.x); v[2] = bflo(w.y); v[3] = bfhi(w.y); v[4] = bflo(w.z); v[5] = bfhi(w.z); v[6] = bflo(w.w); v[7] = bfhi(w.w); }
__device__ __forceinline__ unsigned pk4_fp8(f32x4 v) {
    const float a = __builtin_amdgcn_fmed3f(v[0], -448.f, 448.f), b = __builtin_amdgcn_fmed3f(v[1], -448.f, 448.f), c = __builtin_amdgcn_fmed3f(v[2], -448.f, 448.f), d = __builtin_amdgcn_fmed3f(v[3], -448.f, 448.f);
    int r = 0; r = __builtin_amdgcn_cvt_pk_fp8_f32(a, b, r, false); r = __builtin_amdgcn_cvt_pk_fp8_f32(c, d, r, true); return (unsigned)r; }
__device__ __forceinline__ float sigmoidf_(float x) { return __builtin_amdgcn_rcpf(1.0f + __expf(-x)); }
__device__ __forceinline__ float wave_sum(float v) {
#pragma unroll
    for (int o = 1; o < 64; o <<= 1) v += __shfl_xor(v, o);
    return v;
}

#define XB_TMO      128
#define XB_XCNT(j)  (256  + 64 * (j))
#define XB_XSUB(j)  (1280 + 64 * (j))
#define XB_XGEN(j)  (2304 + 64 * (j))
#define XB_TOP      3328
#define XB_TOPGEN   3392
#define XCD_BAR_WORDS 3456
#define XB_SPIN_CAP (1u << 22)
__device__ __forceinline__ unsigned xb_ld(unsigned* p)              { return __hip_atomic_load(p, __ATOMIC_RELAXED, __HIP_MEMORY_SCOPE_AGENT); }
__device__ __forceinline__ unsigned xb_add(unsigned* p, unsigned v) { return __hip_atomic_fetch_add(p, v, __ATOMIC_RELAXED, __HIP_MEMORY_SCOPE_AGENT); }
__device__ __forceinline__ unsigned xb_xcc_id() { return (unsigned)__builtin_amdgcn_s_getreg((3 << 11) | 20) & 0xFu; }
#define XB_SPIN(cond, bar) do { unsigned _sp = 0; while (cond) { __builtin_amdgcn_s_sleep(1); \
    if ((++_sp & 255u) == 0u) { if (xb_ld(&(bar)[XB_TMO])) break; if (_sp > XB_SPIN_CAP) { atomicAdd(&(bar)[XB_TMO], 1u); break; } } } } while (0)
struct XcdBarrier { unsigned* bar; unsigned x; volatile LAS unsigned* st; };
__device__ __forceinline__ XcdBarrier xcd_barrier_post(unsigned* bar, volatile LAS unsigned* st) {
    XcdBarrier b; b.bar = bar; b.x = xb_xcc_id(); b.st = st;
    if (threadIdx.x == 0) (void)xb_add(&bar[XB_XCNT(b.x)], 1u);
    return b;
}
__device__ __forceinline__ void xcd_barrier_complete(unsigned* bar, unsigned x, unsigned& nloc, unsigned& nx) {
    const unsigned G = gridDim.x * gridDim.y * gridDim.z;
    unsigned sum, cnt, mine, sp = 0u;
    for (;;) {
        sum = 0u; cnt = 0u; mine = 0u;
#pragma unroll
        for (unsigned j = 0; j < 16; ++j) { const unsigned c = xb_ld(&bar[XB_XCNT(j)]); sum += c; cnt += (c > 0u) ? 1u : 0u; mine = (j == x) ? c : mine; }
        if (sum == G) break;
        __builtin_amdgcn_s_sleep(1);
        if ((++sp & 255u) == 0u) { if (xb_ld(&bar[XB_TMO])) break; if (sp > XB_SPIN_CAP) { atomicAdd(&bar[XB_TMO], 1u); break; } }
    }
    nloc = mine > 0u ? mine : 1u; nx = cnt > 0u ? cnt : 1u;
}
__device__ __forceinline__ void xcd_barrier(const XcdBarrier& b) {
    asm volatile("s_waitcnt vmcnt(0)" ::: "memory");
    __syncthreads();
    if (threadIdx.x == 0) {
        unsigned* bar = b.bar;
        __builtin_amdgcn_s_waitcnt(0);
        unsigned nloc = b.st[0], nx = b.st[1];
        if (nloc == 0u) { xcd_barrier_complete(bar, b.x, nloc, nx); b.st[0] = nloc; b.st[1] = nx; }
        const unsigned old = xb_add(&bar[XB_XSUB(b.x)], 1u);
        const unsigned gen = old / nloc;
        if (old + 1u == (gen + 1u) * nloc) {
            __builtin_amdgcn_fence(__ATOMIC_RELEASE, "agent");
            asm volatile("s_waitcnt vmcnt(0)" ::: "memory");
            const unsigned og = xb_add(&bar[XB_TOP], 1u);
            const unsigned tg = og / nx;
            if (og + 1u == (tg + 1u) * nx) xb_add(&bar[XB_TOPGEN], 1u);
            else XB_SPIN(xb_ld(&bar[XB_TOPGEN]) == tg, bar);
            __builtin_amdgcn_fence(__ATOMIC_ACQUIRE, "agent");
            xb_add(&bar[XB_XGEN(b.x)], 1u);
            asm volatile("s_waitcnt vmcnt(0)" ::: "memory");
        } else {
            XB_SPIN(xb_ld(&bar[XB_XGEN(b.x)]) == gen, bar);
            __builtin_amdgcn_fence(__ATOMIC_ACQUIRE, "agent");
            asm volatile("s_waitcnt vmcnt(0)" ::: "memory");
        }
    }
    __syncthreads();
}

namespace pg8 {
constexpr int BM = 256, BK = 64, HALF = 128, HTB = HALF * BK * 2, STAGE_BYTES = 8 * HTB, NXCD = 8, WGM = 8;
__host__ __device__ __forceinline__ int lds_byte(int r, int c) { const int st = (r >> 4) * 2 + (c >> 5), rr = r & 15, cc = c & 31, ob = rr * 64 + cc * 2; return st * 1024 + (ob ^ (((ob >> 9) & 1) << 5)); }
__host__ __device__ __forceinline__ void stage_rc(int b, int& R, int& C) { const int st = b / 1024, sb = b % 1024, swz = sb ^ (((sb >> 9) & 1) << 5); R = (st >> 1) * 16 + swz / 64; C = (st & 1) * 32 + (swz % 64) / 2; }
__host__ __device__ __forceinline__ int perm32(int rho) { const int n = rho >> 4, i = rho & 15; return 8 * (i >> 2) + 4 * n + (i & 3); }

struct Unit { int pm, pn, pb, ko; };
struct Gemm { const bf16_t* A; const bf16_t* Bt; int lda, K, ldb; int sa, sb; };

struct DenseOrder {
    int nM, nN, nwg, G, c;
    __device__ void init(int nM_, int nN_, int G_, int c_) { nM = nM_; nN = nN_; nwg = nM * nN; G = G_; c = c_; }
    __device__ bool next(int i, Unit& u) const { return map((long)i * G + c, u); }
    __device__ bool map(long L, Unit& u) const {
        if (L >= nwg) return false;
        int wgid = (int)L; { const int q = nwg / NXCD, r = nwg % NXCD, xcd = wgid % NXCD, off = wgid / NXCD; wgid = (xcd < r ? xcd * (q + 1) : r * (q + 1) + (xcd - r) * q) + off; }
        const int nig = WGM * nN, gid = wgid / nig, fm = gid * WGM, gsz = (nM - fm) < WGM ? (nM - fm) : WGM;
        u.pm = fm + ((wgid % nig) % gsz); u.pn = (wgid % nig) / gsz; u.pb = u.pn; u.ko = 0; return true;
    }
    __device__ const int* rows(const Unit&) const { return nullptr; }
};
struct DenseOrderTail {
    DenseOrder d; int lo, hi;
    __device__ bool next(int i, Unit& u) const { const int h = d.G >> 1;
        if (i < lo) return d.map((long)i * d.G + d.c, u);
        if (d.c >= h && i < lo + hi) return d.map((long)lo * d.G + (long)(i - lo) * h + (d.c - h), u);
        return false; }
    __device__ const int* rows(const Unit&) const { return nullptr; }
};
struct RouterOrder {
    int G, c;
    __device__ bool next(int i, Unit& u) const { const int L = i * G + c; if (L >= 256) return false; u.pm = L >> 2; u.pn = L & 3; u.pb = 0; u.ko = (L & 3) * 1024; return true; }
    __device__ const int* rows(const Unit&) const { return nullptr; }
};
struct MoeOrder {
    int tile0, ntiles, npn, G, c; const int* tile_e; const int* row_tok;
    __device__ bool next(int i, Unit& u) const {
        const long L = (long)i * G + c; if (L >= (long)ntiles * npn) return false;
        const int tl = (int)L / npn, pn = (int)L % npn; u.pm = tile0 + tl; u.pn = pn; u.pb = tile_e[tile0 + tl] * npn + pn; u.ko = 0; return true;
    }
    __device__ const int* rows(const Unit& u) const { return row_tok + (size_t)u.pm * 256; }
};

#define PG8_EPI_ARGS const f32x4 (&acc)[2][2][4][2], const Unit& u, int wr, int wc, int fr, int fq

typedef int i32x4_ __attribute__((ext_vector_type(4))); typedef int i32x8_ __attribute__((ext_vector_type(8)));
template <class Epi, class Sched, bool GATHER, bool FP8 = false>
__device__ __forceinline__ void gemm_phase(LAS unsigned char* lds, const Gemm g, const Sched& S, const Epi& E, const int tid) {
    const int wid = __builtin_amdgcn_readfirstlane(tid >> 6), lane = tid & 63, wr = wid >> 2, wc = wid & 3, fr = lane & 15, fq = lane >> 4;
    const int K = g.K, nt = K / BK, lda = g.lda;
    unsigned voffB[2], va[2][2], vn[2][2]; int RA[2], CA[2];
#pragma unroll
    for (int i = 0; i < 2; ++i) { int R, C; stage_rc(tid * 16 + i * 8192, R, C); const int Rb = 64 * (R >> 5) + (Epi::PERM == 1 ? (R & 31) : Epi::PERM == 2 ? 16 * ((R & 15) >> 2) + 4 * ((R >> 4) & 1) + (R & 3) : perm32(R & 31)); RA[i] = R; CA[i] = C; voffB[i] = (unsigned)(Rb * g.ldb + C) * 2u; }
    const size_t kstep = (size_t)(BK * 2);
    const size_t hstepB = (size_t)(Epi::PERM == 2 ? 8 : 32) * g.ldb * 2, tstepB = (size_t)BM * g.ldb * 2, tstepA = (size_t)BM * lda * 2;
    const unsigned ldsw = (unsigned)wid * 1024u;
    const int aoff = lds_byte(wr * 64 + fr, fq * 8), boff = lds_byte(wc * 32 + fr, fq * 8);
#define PG8_SA(b, h) (((b) * 2 + (h)) * HTB)
#define PG8_SB(b, h) ((4 + (b) * 2 + (h)) * HTB)
#define PG8_STAGEB(bufoff, gbase) do { _Pragma("unroll") for (int _i = 0; _i < 2; ++_i) \
        __builtin_amdgcn_global_load_lds((const unsigned*)((const char*)(gbase) + voffB[_i]), (LAS unsigned*)(lds + (bufoff) + ldsw + _i * 8192), 16, 0, 0); } while (0)
#define PG8_STAGEA(bufoff, gbase, offs, h) do { _Pragma("unroll") for (int _i = 0; _i < 2; ++_i) \
        __builtin_amdgcn_global_load_lds((const unsigned*)((const char*)(gbase) + (offs)[h][_i]), (LAS unsigned*)(lds + (bufoff) + ldsw + _i * 8192), 16, 0, 0); } while (0)
#define PG8_LDA(dst, b, h) do { if constexpr (FP8) { _Pragma("unroll") for (int m = 0; m < 4; ++m) { const i32x4_ _lo = *(const LAS i32x4_*)(lds + PG8_SA(b, h) + aoff + m * 2048), _hi = *(const LAS i32x4_*)(lds + PG8_SA(b, h) + aoff + m * 2048 + 1024); \
            dst##8[m] = __builtin_shufflevector(_lo, _hi, 0, 1, 2, 3, 4, 5, 6, 7); } } \
        else { _Pragma("unroll") for (int m = 0; m < 4; ++m) _Pragma("unroll") for (int k = 0; k < 2; ++k) dst[m][k] = *(const LAS bf16x8*)(lds + PG8_SA(b, h) + aoff + m * 2048 + k * 1024); } } while (0)
#define PG8_LDB(dst, b, h) do { if constexpr (FP8) { _Pragma("unroll") for (int n = 0; n < 2; ++n) { const i32x4_ _lo = *(const LAS i32x4_*)(lds + PG8_SB(b, h) + boff + n * 2048), _hi = *(const LAS i32x4_*)(lds + PG8_SB(b, h) + boff + n * 2048 + 1024); \
            dst##8[n] = __builtin_shufflevector(_lo, _hi, 0, 1, 2, 3, 4, 5, 6, 7); } } \
        else { _Pragma("unroll") for (int n = 0; n < 2; ++n) _Pragma("unroll") for (int k = 0; k < 2; ++k) dst[n][k] = *(const LAS bf16x8*)(lds + PG8_SB(b, h) + boff + n * 2048 + k * 1024); } } while (0)
#define PG8_MMA(ai, bj, At, Bt) do { __builtin_amdgcn_s_setprio(1); \
        if constexpr (FP8) { _Pragma("unroll") for (int m = 0; m < 4; ++m) _Pragma("unroll") for (int n = 0; n < 2; ++n) \
            asm volatile("v_mfma_scale_f32_16x16x128_f8f6f4 %0, %1, %2, %0, %3, %4 op_sel_hi:[0,0,0]" : "+v"(acc[ai][bj][m][n]) : "v"(Bt##8[n]), "v"(At##8[m]), "v"(sbv), "v"(sav)); } \
        else { _Pragma("unroll") for (int m = 0; m < 4; ++m) _Pragma("unroll") for (int n = 0; n < 2; ++n) _Pragma("unroll") for (int k = 0; k < 2; ++k) \
            acc[ai][bj][m][n] = __builtin_amdgcn_mfma_f32_16x16x32_bf16(Bt[n][k], At[m][k], acc[ai][bj][m][n], 0, 0, 0); } \
        __builtin_amdgcn_s_setprio(0); } while (0)
#define PG8_WAIT_V(n) asm volatile("s_waitcnt vmcnt(" #n ")" ::: "memory")
#define PG8_WAIT_L(n) asm volatile("s_waitcnt lgkmcnt(" #n ")" ::: "memory")
#define PG8_BAR __builtin_amdgcn_s_barrier()
#define PG8_SCHED __builtin_amdgcn_sched_barrier(0)
    Unit cur, nxt, nx2; int ui = 0; bool hn = false, hn2 = false; unsigned xq[2][2] = {{0u, 0u}, {0u, 0u}}, xq2[2][2] = {{0u, 0u}, {0u, 0u}}; (void)nx2; (void)hn; (void)hn2; (void)xq; (void)xq2;
    if (!S.next(0, cur)) return;
    f32x4 acc[2][2][4][2];
#pragma unroll
    for (int a = 0; a < 2; ++a)
#pragma unroll
        for (int b = 0; b < 2; ++b)
#pragma unroll
            for (int m = 0; m < 4; ++m)
#pragma unroll
                for (int n = 0; n < 2; ++n) acc[a][b][m][n] = (f32x4){0.f, 0.f, 0.f, 0.f};
    const int sav = g.sa, sbv = g.sb; (void)sav; (void)sbv;
    bf16x8 At[4][2], B0[2][2], B1[2][2]; i32x8_ At8[4], B08[2], B18[2]; (void)At; (void)B0; (void)B1; (void)At8; (void)B08; (void)B18;
    const char* cA; const char* cB = (const char*)g.Bt + (size_t)cur.pb * tstepB + (size_t)cur.ko * 2;
    if constexpr (GATHER) {
        const int* rw = S.rows(cur); cA = (const char*)g.A;
#pragma unroll
        for (int h = 0; h < 2; ++h)
#pragma unroll
            for (int i = 0; i < 2; ++i) { unsigned x = (unsigned)rw[h * HALF + RA[i]]; asm volatile("s_waitcnt vmcnt(0)" : "+v"(x) :: "memory"); va[h][i] = (x * (unsigned)lda + (unsigned)CA[i]) * 2u; }
    } else {
        cA = (const char*)g.A + (size_t)cur.pm * tstepA + (size_t)cur.ko * 2;
#pragma unroll
        for (int h = 0; h < 2; ++h)
#pragma unroll
            for (int i = 0; i < 2; ++i) va[h][i] = (unsigned)((h * HALF + RA[i]) * lda + CA[i]) * 2u;
    }
#pragma unroll
    for (int h = 0; h < 2; ++h)
#pragma unroll
        for (int i = 0; i < 2; ++i) vn[h][i] = va[h][i];
    if constexpr (GATHER) {
        hn = S.next(1, nxt);
        if (hn) { const int* rw = S.rows(nxt);
#pragma unroll
            for (int h = 0; h < 2; ++h)
#pragma unroll
                for (int i = 0; i < 2; ++i) xq[h][i] = (unsigned)rw[h * HALF + RA[i]]; }
    }
    PG8_STAGEB(PG8_SB(0, 0), cB); PG8_STAGEB(PG8_SB(0, 1), cB + hstepB); PG8_STAGEA(PG8_SA(0, 0), cA, va, 0); PG8_STAGEA(PG8_SA(0, 1), cA, va, 1);
    if (wr == 1) PG8_BAR;
    PG8_WAIT_V(2); PG8_BAR;
    PG8_STAGEB(PG8_SB(1, 0), cB + kstep); PG8_STAGEA(PG8_SA(1, 0), cA + kstep, va, 0); PG8_STAGEB(PG8_SB(1, 1), cB + hstepB + kstep);
    PG8_WAIT_V(6); PG8_BAR;
    for (;;) {
        bool has_next;
        if constexpr (GATHER) has_next = hn; else has_next = S.next(ui + 1, nxt);
        const char* nA; const char* nB = has_next ? (const char*)g.Bt + (size_t)nxt.pb * tstepB + (size_t)nxt.ko * 2 : cB;
        if constexpr (GATHER) {
            nA = cA;
            if (has_next) {
#pragma unroll
                for (int h = 0; h < 2; ++h)
#pragma unroll
                    for (int i = 0; i < 2; ++i) vn[h][i] = (xq[h][i] * (unsigned)lda + (unsigned)CA[i]) * 2u; }
            hn2 = has_next && S.next(ui + 2, nx2);
            if (hn2) { const int* rw = S.rows(nx2);
#pragma unroll
                for (int h = 0; h < 2; ++h)
#pragma unroll
                    for (int i = 0; i < 2; ++i) xq2[h][i] = (unsigned)rw[h * HALF + RA[i]]; }
        } else {
            nA = has_next ? (const char*)g.A + (size_t)nxt.pm * tstepA + (size_t)nxt.ko * 2 : cA;
        }
#pragma unroll 1
        for (int t = 0; t < nt; t += 2) {
            const bool last = (t == nt - 2);
            const char* a1 = cA + (size_t)(t + 1) * kstep;
            const char* a2 = last ? nA : cA + (size_t)(t + 2) * kstep; const char* b2 = last ? nB : cB + (size_t)(t + 2) * kstep;
            const char* a3 = a2 + kstep; const char* b3 = b2 + kstep;
            unsigned v2[2][2];
#pragma unroll
            for (int h = 0; h < 2; ++h)
#pragma unroll
                for (int i = 0; i < 2; ++i) v2[h][i] = GATHER ? (last ? vn[h][i] : va[h][i]) : va[h][i];
            PG8_LDB(B0, 0, 0); PG8_LDB(B1, 0, 1); PG8_SCHED; PG8_LDA(At, 0, 0); PG8_STAGEA(PG8_SA(1, 1), a1, va, 1);
            PG8_WAIT_V(8); PG8_WAIT_L(0); PG8_BAR; PG8_MMA(0, 0, At, B0); PG8_MMA(0, 1, At, B1); PG8_BAR; PG8_SCHED;
            PG8_LDA(At, 0, 1); PG8_STAGEB(PG8_SB(0, 0), b2); PG8_STAGEB(PG8_SB(0, 1), b2 + hstepB); PG8_STAGEA(PG8_SA(0, 0), a2, v2, 0);
            PG8_WAIT_V(8); PG8_WAIT_L(0); PG8_BAR; PG8_MMA(1, 0, At, B0); PG8_MMA(1, 1, At, B1); PG8_BAR; PG8_SCHED;
            PG8_LDB(B0, 1, 0); PG8_LDB(B1, 1, 1); PG8_SCHED; PG8_LDA(At, 1, 0); PG8_STAGEA(PG8_SA(0, 1), a2, v2, 1);
            PG8_WAIT_V(8); PG8_WAIT_L(0); PG8_BAR; PG8_MMA(0, 0, At, B0); PG8_MMA(0, 1, At, B1); PG8_BAR; PG8_SCHED;
            PG8_LDA(At, 1, 1); PG8_STAGEB(PG8_SB(1, 0), b3); PG8_STAGEB(PG8_SB(1, 1), b3 + hstepB); PG8_STAGEA(PG8_SA(1, 0), a3, v2, 0);
            PG8_WAIT_V(8); PG8_WAIT_L(0); PG8_BAR; PG8_MMA(1, 0, At, B0); PG8_MMA(1, 1, At, B1); PG8_BAR; PG8_SCHED;
        }
        if constexpr (FP8) {
            asm volatile("s_nop 7\n\ts_nop 7" : "+v"(acc[0][0][0][0]), "+v"(acc[0][0][0][1]), "+v"(acc[0][0][1][0]), "+v"(acc[0][0][1][1]), "+v"(acc[0][0][2][0]), "+v"(acc[0][0][2][1]), "+v"(acc[0][0][3][0]), "+v"(acc[0][0][3][1]), "+v"(acc[0][1][0][0]), "+v"(acc[0][1][0][1]), "+v"(acc[0][1][1][0]), "+v"(acc[0][1][1][1]), "+v"(acc[0][1][2][0]), "+v"(acc[0][1][2][1]), "+v"(acc[0][1][3][0]), "+v"(acc[0][1][3][1]));
            asm volatile("" : "+v"(acc[1][0][0][0]), "+v"(acc[1][0][0][1]), "+v"(acc[1][0][1][0]), "+v"(acc[1][0][1][1]), "+v"(acc[1][0][2][0]), "+v"(acc[1][0][2][1]), "+v"(acc[1][0][3][0]), "+v"(acc[1][0][3][1]), "+v"(acc[1][1][0][0]), "+v"(acc[1][1][0][1]), "+v"(acc[1][1][1][0]), "+v"(acc[1][1][1][1]), "+v"(acc[1][1][2][0]), "+v"(acc[1][1][2][1]), "+v"(acc[1][1][3][0]), "+v"(acc[1][1][3][1])); }
        if (wr == 0) PG8_BAR;
        E(acc, cur, wr, wc, fr, fq);
        if (!has_next) break;
#pragma unroll
        for (int a = 0; a < 2; ++a)
#pragma unroll
            for (int b = 0; b < 2; ++b)
#pragma unroll
                for (int m = 0; m < 4; ++m)
#pragma unroll
                    for (int n = 0; n < 2; ++n) acc[a][b][m][n] = (f32x4){0.f, 0.f, 0.f, 0.f};
        cur = nxt; cA = nA; cB = nB; ++ui;
        if constexpr (GATHER) {
#pragma unroll
            for (int h = 0; h < 2; ++h)
#pragma unroll
                for (int i = 0; i < 2; ++i) { va[h][i] = vn[h][i]; xq[h][i] = xq2[h][i]; }
            nxt = nx2; hn = hn2;
        }
        if (wr == 1) PG8_BAR;
    }
    PG8_WAIT_V(0);
    PG8_BAR;
#undef PG8_SA
#undef PG8_SB
#undef PG8_STAGEA
#undef PG8_STAGEB
#undef PG8_LDA
#undef PG8_LDB
#undef PG8_MMA
#undef PG8_WAIT_V
#undef PG8_WAIT_L
#undef PG8_BAR
#undef PG8_SCHED
}

#define EPI_COLF(bj, n) (wc * 64 + (bj) * 32 + (n) * 16 + 4 * fq)
#define EPI_ROW(ai, m) (u.pm * 256 + (ai) * 128 + wr * 64 + (m) * 16 + fr)
#define EPI_COLT(bj) (wc * 64 + (bj) * 32 + 8 * fq)
struct EpiProj {
    static constexpr int PERM = 0;
    bf16_t *rkv, *misc, *cqkv, *gates;
    __device__ __forceinline__ void operator()(PG8_EPI_ARGS) const {
        const int pn = u.pn; bf16_t* dst; int ldc, ct; bool sig = false;
        if (pn < 12) { dst = rkv; ldc = 3072; ct = pn; } else if (pn < 14) { dst = misc; ldc = 512; ct = pn - 12; } else if (pn < 18) { dst = cqkv; ldc = 1024; ct = pn - 14; } else { dst = gates; ldc = 4096; ct = pn - 18; sig = true; }
#pragma unroll
        for (int ai = 0; ai < 2; ++ai)
#pragma unroll
            for (int m = 0; m < 4; ++m) { bf16_t* rowp = dst + (size_t)EPI_ROW(ai, m) * ldc + ct * 256;
#pragma unroll
                for (int bj = 0; bj < 2; ++bj) { f32x4 v0 = acc[ai][bj][m][0], v1 = acc[ai][bj][m][1];
                    if (sig) {
#pragma unroll
                        for (int e = 0; e < 4; ++e) { v0[e] = sigmoidf_(v0[e]); v1[e] = sigmoidf_(v1[e]); } }
                    *(u32x4*)(rowp + EPI_COLT(bj)) = pack8(v0, v1); } }
    }
};
struct EpiGates {
    static constexpr int PERM = 0;
    bf16_t* gates;
    __device__ __forceinline__ void operator()(PG8_EPI_ARGS) const {
#pragma unroll
        for (int ai = 0; ai < 2; ++ai)
#pragma unroll
            for (int m = 0; m < 4; ++m) { bf16_t* rowp = gates + (size_t)EPI_ROW(ai, m) * 4096 + u.pn * 256;
#pragma unroll
                for (int bj = 0; bj < 2; ++bj) { f32x4 v0 = acc[ai][bj][m][0], v1 = acc[ai][bj][m][1];
#pragma unroll
                    for (int e = 0; e < 4; ++e) { v0[e] = sigmoidf_(v0[e]); v1[e] = sigmoidf_(v1[e]); }
                    *(u32x4*)(rowp + EPI_COLT(bj)) = pack8(v0, v1); } }
    }
};
struct EpiLora {
    static constexpr int PERM = 0;
    bf16_t *om, *aa, *gg; const float *w0, *a0;
    __device__ __forceinline__ void operator()(PG8_EPI_ARGS) const {
        const int pn = u.pn; const int kind = pn >> 2, ct = pn & 3; bf16_t* dst = om + (size_t)kind * ((size_t)T * 1024);
#pragma unroll
        for (int bj = 0; bj < 2; ++bj) {
            const f32x4 bw0 = *(const f32x4*)(w0 + ct * 256 + EPI_COLT(bj)), bw1 = *(const f32x4*)(w0 + ct * 256 + EPI_COLT(bj) + 4);
            const f32x4 ba0 = *(const f32x4*)(a0 + ct * 256 + EPI_COLT(bj)), ba1 = *(const f32x4*)(a0 + ct * 256 + EPI_COLT(bj) + 4);
            const float sw = kind == 0 ? 1.f : 0.f, sa = kind == 1 ? 1.f : 0.f;
            const f32x4 b0 = bw0 * sw + ba0 * sa, b1 = bw1 * sw + ba1 * sa;
#pragma unroll
            for (int ai = 0; ai < 2; ++ai)
#pragma unroll
                for (int m = 0; m < 4; ++m) {
                    f32x4 v0 = acc[ai][bj][m][0] + b0, v1 = acc[ai][bj][m][1] + b1;
                    if (kind == 0) {
#pragma unroll
                        for (int e = 0; e < 4; ++e) {
                            { const float y = -v0[e]; const float sp = fmaxf(y, 0.f) + __logf(1.0f + __expf(-fabsf(y))); const float ew = __expf(-sp - 0.5f); v0[e] = 1.0f - __expf(-ew); }
                            { const float y = -v1[e]; const float sp = fmaxf(y, 0.f) + __logf(1.0f + __expf(-fabsf(y))); const float ew = __expf(-sp - 0.5f); v1[e] = 1.0f - __expf(-ew); } }
                    } else if (kind == 1) {
#pragma unroll
                        for (int e = 0; e < 4; ++e) { v0[e] = sigmoidf_(v0[e]); v1[e] = sigmoidf_(v1[e]); }
                    }
                    *(u32x4*)(dst + (size_t)EPI_ROW(ai, m) * 1024 + ct * 256 + EPI_COLT(bj)) = pack8(v0, v1);
                    __builtin_amdgcn_sched_barrier(0);
                }
        }
    }
};
struct EpiRowScale {
    static constexpr int PERM = 0;
    bf16_t* dst; int ldc; const float* rs;
    __device__ __forceinline__ void operator()(PG8_EPI_ARGS) const {
#pragma unroll
        for (int ai = 0; ai < 2; ++ai)
#pragma unroll
            for (int m = 0; m < 4; ++m) { const int row = EPI_ROW(ai, m); const float s = rs ? rs[row] : 1.0f; bf16_t* rowp = dst + (size_t)row * ldc + u.pn * 256;
#pragma unroll
                for (int bj = 0; bj < 2; ++bj) *(u32x4*)(rowp + EPI_COLT(bj)) = pack8(acc[ai][bj][m][0] * s, acc[ai][bj][m][1] * s); }
    }
};
template <int ACCUM> struct EpiMerge {
    static constexpr int PERM = 0;
    bf16_t* merged; const bf16_t* gates; int goff; unsigned char* merged8;
    __device__ __forceinline__ void operator()(PG8_EPI_ARGS) const {
#pragma unroll
        for (int ai = 0; ai < 2; ++ai)
#pragma unroll
            for (int m = 0; m < 4; ++m) { const int row = EPI_ROW(ai, m);
#pragma unroll
                for (int bj = 0; bj < 2; ++bj) { const int col = u.pn * 256 + EPI_COLT(bj);
                    float gv[8]; unpack8(*(const u32x4*)(gates + (size_t)row * 4096 + goff + col), gv);
                    f32x4 v0 = acc[ai][bj][m][0], v1 = acc[ai][bj][m][1];
                    bf16_t* p = merged + (size_t)row * 2048 + col;
                    float ov[8];
                    if (ACCUM) unpack8(*(const u32x4*)p, ov);
#pragma unroll
                    for (int e = 0; e < 4; ++e) { v0[e] = v0[e] * gv[e] + (ACCUM ? ov[e] : 0.f); v1[e] = v1[e] * gv[4 + e] + (ACCUM ? ov[4 + e] : 0.f); }
                    if (ACCUM) { u32x2 w8; w8.x = pk4_fp8(v0 * O8_SCALE); w8.y = pk4_fp8(v1 * O8_SCALE); *(u32x2*)(merged8 + (size_t)row * 2048 + col) = w8; }
                    else *(u32x4*)p = pack8(v0, v1); } }
    }
};
struct EpiResid {
    static constexpr int PERM = 1;
    const float* base; float* out;
    __device__ __forceinline__ void operator()(PG8_EPI_ARGS) const {
#pragma unroll
        for (int ai = 0; ai < 2; ++ai)
#pragma unroll
            for (int m = 0; m < 4; ++m) { const size_t ro = (size_t)EPI_ROW(ai, m) * 2048 + u.pn * 256;
#pragma unroll
                for (int bj = 0; bj < 2; ++bj)
#pragma unroll
                    for (int n = 0; n < 2; ++n) { const size_t o = ro + EPI_COLF(bj, n); *(f32x4*)(out + o) = *(const f32x4*)(base + o) + acc[ai][bj][m][n]; } }
    }
};
struct EpiLogit {
    static constexpr int PERM = 0;
    float* logit;
    __device__ __forceinline__ void operator()(PG8_EPI_ARGS) const {
#pragma unroll
        for (int ai = 0; ai < 2; ++ai)
#pragma unroll
            for (int m = 0; m < 4; ++m) { float* rowp = logit + (size_t)u.pn * ((size_t)T * 128) + (size_t)EPI_ROW(ai, m) * 128;
                if (wc < 2) {
#pragma unroll
                    for (int bj = 0; bj < 2; ++bj)
#pragma unroll
                        for (int n = 0; n < 2; ++n) *(f32x4*)(rowp + EPI_COLT(bj) + 4 * n) = acc[ai][bj][m][n]; } }
    }
};
struct EpiSwiglu {
    static constexpr int PERM = 0;
    bf16_t* act;
    __device__ __forceinline__ void operator()(PG8_EPI_ARGS) const {
#pragma unroll
        for (int ai = 0; ai < 2; ++ai)
#pragma unroll
            for (int m = 0; m < 4; ++m) { f32x4 v[2];
#pragma unroll
                for (int n = 0; n < 2; ++n)
#pragma unroll
                    for (int e = 0; e < 4; ++e) { const float gx = acc[ai][0][m][n][e]; v[n][e] = gx * sigmoidf_(gx) * acc[ai][1][m][n][e]; }
                *(u32x4*)(act + (size_t)EPI_ROW(ai, m) * 512 + u.pn * 128 + wc * 32 + 8 * fq) = pack8(v[0], v[1]); }
    }
};
struct EpiSwiglu8 {
    static constexpr int PERM = 0;
    unsigned char* act8;
    __device__ __forceinline__ void operator()(PG8_EPI_ARGS) const {
#pragma unroll
        for (int ai = 0; ai < 2; ++ai)
#pragma unroll
            for (int m = 0; m < 4; ++m) { f32x4 v[2];
#pragma unroll
                for (int n = 0; n < 2; ++n)
#pragma unroll
                    for (int e = 0; e < 4; ++e) { const float gx = acc[ai][0][m][n][e]; v[n][e] = gx * sigmoidf_(gx) * acc[ai][1][m][n][e] * ACT8_SCALE; }
                u32x2 w; w.x = pk4_fp8(v[0]); w.y = pk4_fp8(v[1]);
                *(u32x2*)(act8 + (size_t)EPI_ROW(ai, m) * 512 + u.pn * 128 + wc * 32 + 8 * fq) = w; }
    }
};
struct EpiDown {
    static constexpr int PERM = 2;
    unsigned char* y8; const float* roww;
    __device__ __forceinline__ void operator()(PG8_EPI_ARGS) const {
#pragma unroll
        for (int ai = 0; ai < 2; ++ai)
#pragma unroll
            for (int m = 0; m < 4; ++m) { const int row = EPI_ROW(ai, m); const float s = Y8_SCALE;
                u32x4 w; w.x = pk4_fp8(acc[ai][0][m][0] * s); w.y = pk4_fp8(acc[ai][0][m][1] * s); w.z = pk4_fp8(acc[ai][1][m][0] * s); w.w = pk4_fp8(acc[ai][1][m][1] * s);
                *(u32x4*)(y8 + (size_t)row * 2048 + u.pn * 256 + wc * 64 + 16 * fq) = w; }
    }
};
struct EpiFinal {
    static constexpr int PERM = 1;
    float* out; const bf16_t* pleraw; const float* rstdp; const float* gpost; float dsc;
    __device__ __forceinline__ void operator()(PG8_EPI_ARGS) const {
        f32x4 gv[2][2];
#pragma unroll
        for (int bj = 0; bj < 2; ++bj)
#pragma unroll
            for (int n = 0; n < 2; ++n) gv[bj][n] = *(const f32x4*)(gpost + u.pn * 256 + EPI_COLF(bj, n));
#pragma unroll
        for (int ai = 0; ai < 2; ++ai)
#pragma unroll
            for (int m = 0; m < 4; ++m) { const int row = EPI_ROW(ai, m); const float rs = rstdp[row];
#pragma unroll
                for (int bj = 0; bj < 2; ++bj)
#pragma unroll
                    for (int n = 0; n < 2; ++n) { const size_t o = (size_t)row * 2048 + u.pn * 256 + EPI_COLF(bj, n);
                        const uint2 pw = *(const uint2*)(pleraw + o); const f32x4 pv = {__builtin_bit_cast(float, pw.x << 16), __builtin_bit_cast(float, pw.x & 0xffff0000u), __builtin_bit_cast(float, pw.y << 16), __builtin_bit_cast(float, pw.y & 0xffff0000u)};
                        f32x4 x = *(const f32x4*)(out + o), a = acc[ai][bj][m][n];
#pragma unroll
                        for (int e = 0; e < 4; ++e) x[e] += sigmoidf_(a[e]) * (pv[e] * rs * gv[bj][n][e]);
                        *(f32x4*)(out + o) = x * dsc; } }
    }
};
}

struct Args { const float* in[38]; const int* pos; float* out; unsigned char* ws; int ph_lo, ph_hi; };

struct Frame {
    LAS unsigned char* lds; unsigned* ctl; unsigned char* ws;
    int tid, lane, wave, vcu, G, gw, NGW;
};

__device__ __forceinline__ void conv_item(const float* src, int ld_src, int kvalid, const float* kscale, int mode, bf16_t* dst, int ld_dst, LAS float* scr, int lane, int jstep = 8) {
    const int rr = lane >> 3, c4 = (lane & 7) * 4;
    f32x4 v[8];
#pragma unroll
    for (int i = 0; i < 8; ++i) { const int kk = 8 * i + rr; v[i] = (f32x4){0.f, 0.f, 0.f, 0.f};
        if (kk < kvalid) { v[i] = *(const f32x4*)(src + (size_t)kk * ld_src + c4); if (kscale) v[i] = v[i] * kscale[kk]; } }
#pragma unroll
    for (int i = 0; i < 8; ++i) { LAS float* s = scr + (8 * i + rr) * 33 + c4; s[0] = v[i][0]; s[1] = v[i][1]; s[2] = v[i][2]; s[3] = v[i][3]; }
    LDS_WAIT(); asm volatile("" ::: "memory");
    const int c = lane & 7;
    if (8 * c < kvalid) {
#pragma unroll
        for (int j = 0; j < 4; ++j) { const int n = (lane >> 3) + 8 * j; const LAS float* s = scr + (8 * c) * 33 + n;
            float x[8];
#pragma unroll
            for (int e = 0; e < 8; ++e) { x[e] = s[e * 33]; if (mode == 1) x[e] = x[e] - bf2f(f2bf(x[e])); }
            u32x4 o; o.x = pk2(x[0], x[1]); o.y = pk2(x[2], x[3]); o.z = pk2(x[4], x[5]); o.w = pk2(x[6], x[7]);
            *(u32x4*)(dst + (size_t)((lane >> 3) + jstep * j) * ld_dst + 8 * c) = o; }
    }
    LDS_WAIT(); asm volatile("" ::: "memory");
}
__device__ __forceinline__ void conv_load(const float* src, int ld_src, int lane, f32x4 (&v)[8]) {
    const int rr = lane >> 3, c4 = (lane & 7) * 4;
#pragma unroll
    for (int i = 0; i < 8; ++i) v[i] = *(const f32x4*)(src + (size_t)(8 * i + rr) * ld_src + c4);
}
__device__ __forceinline__ void conv_store(const f32x4 (&v)[8], bf16_t* dst, int ld_dst, LAS float* scr, int lane, int jstep = 8) {
    const int rr = lane >> 3, c4 = (lane & 7) * 4;
#pragma unroll
    for (int i = 0; i < 8; ++i) { LAS float* s = scr + (8 * i + rr) * 33 + c4; s[0] = v[i][0]; s[1] = v[i][1]; s[2] = v[i][2]; s[3] = v[i][3]; }
    LDS_WAIT(); asm volatile("" ::: "memory");
    const int c = lane & 7;
#pragma unroll
    for (int j = 0; j < 4; ++j) { const int n = (lane >> 3) + 8 * j; const LAS float* s = scr + (8 * c) * 33 + n;
        u32x4 o; o.x = pk2(s[0], s[33]); o.y = pk2(s[66], s[99]); o.z = pk2(s[132], s[165]); o.w = pk2(s[198], s[231]);
        *(u32x4*)(dst + (size_t)((lane >> 3) + jstep * j) * ld_dst + 8 * c) = o; }
    LDS_WAIT(); asm volatile("" ::: "memory");
}
__device__ __forceinline__ void conv_store8(const f32x4 (&v)[8], unsigned char* dst8, int ld_dst, LAS float* scr, int lane, float scale) {
    const int rr = lane >> 3, c4 = (lane & 7) * 4;
#pragma unroll
    for (int i = 0; i < 8; ++i) { LAS float* s = scr + (8 * i + rr) * 33 + c4; s[0] = v[i][0]; s[1] = v[i][1]; s[2] = v[i][2]; s[3] = v[i][3]; }
    LDS_WAIT(); asm volatile("" ::: "memory");
    const int c = lane & 7;
#pragma unroll
    for (int j = 0; j < 4; ++j) { const int n = (lane >> 3) + 8 * j; const LAS float* s = scr + (8 * c) * 33 + n;
        u32x2 o; o.x = pk4_fp8((f32x4){s[0], s[33], s[66], s[99]} * scale); o.y = pk4_fp8((f32x4){s[132], s[165], s[198], s[231]} * scale);
        *(u32x2*)(dst8 + (size_t)n * ld_dst + 8 * c) = o; }
    LDS_WAIT(); asm volatile("" ::: "memory");
}
__device__ __forceinline__ void conv_item8(const float* src, int ld_src, unsigned char* dst8, int ld_dst, LAS float* scr, int lane, float scale) { f32x4 v[8]; conv_load(src, ld_src, lane, v); conv_store8(v, dst8, ld_dst, scr, lane, scale); }
#define CONV_JOB8X(src_, ld_src_, c0_, ncols_, K_, dst8_, ld_dst_, r0_, js_) { const int nnb_ = (ncols_) / 32, n_ = nnb_ * ((K_) / 64); \
    if (r < n_) { const int kb = r / nnb_, nb = r % nnb_; \
        conv_item8((src_) + (size_t)kb * 64 * (ld_src_) + (c0_) + nb * 32, (ld_src_), (unsigned char*)(dst8_) + (size_t)((r0_) + nb * 4 * (js_)) * (ld_dst_) + kb * 64, (ld_dst_), scr, lane, W8_SCALE); continue; } \
    r -= n_; }
#define CONV_JOB(src_, ld_src_, c0_, ncols_, K_, kscale_, mode_, dst_, ld_dst_, r0_, k0_) CONV_JOBX(src_, ld_src_, c0_, ncols_, K_, kscale_, mode_, dst_, ld_dst_, r0_, k0_, 8)
#define CONV_JOBX(src_, ld_src_, c0_, ncols_, K_, kscale_, mode_, dst_, ld_dst_, r0_, k0_, js_) { const int nnb_ = (ncols_) / 32, n_ = nnb_ * (((K_) + 63) / 64); \
    if (r < n_) { const int kb = r / nnb_, nb = r % nnb_; const int kv = ((K_) - kb * 64) < 64 ? ((K_) - kb * 64) : 64; const float* ks_ = (kscale_); \
        conv_item((src_) + (size_t)kb * 64 * (ld_src_) + (c0_) + nb * 32, (ld_src_), kv, ks_ ? ks_ + kb * 64 : nullptr, (mode_), (dst_) + (size_t)((r0_) + nb * 4 * (js_)) * (ld_dst_) + (k0_) + kb * 64, (ld_dst_), scr, lane); continue; } \
    r -= n_; }
__device__ __forceinline__ void conv_job(const Frame& F, LAS float* scr, const float* src, int ld_src, int c0, int ncols, int K, const float* kscale, int mode, bf16_t* dst, int ld_dst, int r0, int k0) {
    const int nkb = (K + 63) / 64, nnb = ncols / 32, items = nkb * nnb;
    for (int it = F.gw; it < items; it += F.NGW) { const int kb = it / nnb, nb = it % nnb; const int kv = (K - kb * 64) < 64 ? (K - kb * 64) : 64;
        conv_item(src + (size_t)kb * 64 * ld_src + c0 + nb * 32, ld_src, kv, kscale ? kscale + kb * 64 : nullptr, mode, dst + (size_t)(r0 + nb * 32) * ld_dst + k0 + kb * 64, ld_dst, scr, F.lane); }
}

__device__ __forceinline__ void rms_row_bf16(const float* xrow, const float* gain, bf16_t* ohi, bf16_t* olo, int lane, unsigned char* o8 = nullptr) {
    const f32x4* xr = (const f32x4*)xrow + lane; const f32x4* gr = (const f32x4*)gain + lane;
    f32x4 v[8]; float s = 0.f;
#pragma unroll
    for (int j = 0; j < 8; ++j) { v[j] = xr[64 * j]; s += (v[j][0] * v[j][0] + v[j][1] * v[j][1]) + (v[j][2] * v[j][2] + v[j][3] * v[j][3]); }
    const float rstd = 1.0f / sqrtf(wave_sum(s) * (1.f / 2048.f) + NORM_EPS);
#pragma unroll
    for (int j = 0; j < 8; ++j) { const f32x4 gq = gr[64 * j]; const f32x4 y = v[j] * rstd * gq;
        u32x2 h; h.x = pk2(y[0], y[1]); h.y = pk2(y[2], y[3]);
        *((u32x2*)ohi + lane + 64 * j) = h;
        if (o8) ((unsigned*)o8)[lane + 64 * j] = pk4_fp8(y);
        if (olo) { u32x2 l; l.x = pk2(y[0] - bflo(h.x), y[1] - bfhi(h.x)); l.y = pk2(y[2] - bflo(h.y), y[3] - bfhi(h.y)); *((u32x2*)olo + lane + 64 * j) = l; } }
}

__device__ __forceinline__ void attn_unit(LAS unsigned char* lds, const bf16_t* Qf, const bf16_t* Kf, const bf16_t* Vtf, bf16_t* OB, int bh, int qb, int tid, int wid, int lane) {
    const int c = lane & 31, hi = lane >> 5;
    bf16x8 q[12];
    { const bf16x8* qp = (const bf16x8*)(Qf + ((size_t)(bh * 256 + qb * 8 + wid) * 12) * 512) + lane;
#pragma unroll
      for (int ks = 0; ks < 12; ++ks) q[ks] = qp[ks * 64]; }
    f32x16 o[4];
#pragma unroll
    for (int db = 0; db < 4; ++db)
#pragma unroll
        for (int e = 0; e < 16; ++e) o[db][e] = 0.f;
    float mrun = -1e30f, lrun = 0.f;
    const int ntiles = 4 * (qb + 1);
    const char* kbase = (const char*)(Kf + (size_t)bh * 256 * 12 * 512);
    const char* vbase = (const char*)(Vtf + (size_t)bh * 256 * 8 * 512);
#define ATT_LOAD(kt, buf) do { const char* _k = kbase + (size_t)(kt) * 24576 + tid * 16; const char* _v = vbase + (size_t)(kt) * 16384 + tid * 16; \
        _Pragma("unroll") for (int _j = 0; _j < 3; ++_j) __builtin_amdgcn_global_load_lds((const unsigned*)(_k + _j * 8192), (LAS unsigned*)(lds + (buf) * 40960 + _j * 8192 + wid * 1024), 16, 0, 0); \
        _Pragma("unroll") for (int _j = 0; _j < 2; ++_j) __builtin_amdgcn_global_load_lds((const unsigned*)(_v + _j * 8192), (LAS unsigned*)(lds + (buf) * 40960 + 24576 + _j * 8192 + wid * 1024), 16, 0, 0); } while (0)
    __builtin_amdgcn_s_barrier();
    ATT_LOAD(0, 0);
#pragma unroll 1
    for (int kt = 0; kt < ntiles; ++kt) {
        asm volatile("s_waitcnt vmcnt(0)" ::: "memory");
        __builtin_amdgcn_s_barrier();
        if (kt + 1 < ntiles) ATT_LOAD(kt + 1, (kt + 1) & 1);
        const int rel = kt - 4 * qb;
        if (rel <= (wid >> 1)) {
            const LAS unsigned char* tb = lds + (kt & 1) * 40960 + lane * 16;
            f32x16 s0, s1;
#pragma unroll
            for (int e = 0; e < 16; ++e) { s0[e] = 0.f; s1[e] = 0.f; }
#pragma unroll
            for (int g4 = 0; g4 < 3; ++g4) {
                bf16x8 ka[4], kc[4];
#pragma unroll
                for (int i = 0; i < 4; ++i) { ka[i] = *(const LAS bf16x8*)(tb + (4 * g4 + i) * 1024); kc[i] = *(const LAS bf16x8*)(tb + (12 + 4 * g4 + i) * 1024); }
                __builtin_amdgcn_sched_barrier(0);
#pragma unroll
                for (int i = 0; i < 4; ++i) { s0 = __builtin_amdgcn_mfma_f32_32x32x16_bf16(ka[i], q[4 * g4 + i], s0, 0, 0, 0); s1 = __builtin_amdgcn_mfma_f32_32x32x16_bf16(kc[i], q[4 * g4 + i], s1, 0, 0, 0); }
                __builtin_amdgcn_sched_barrier(0);
            }
            if (rel == (wid >> 1)) {
                const int qi = 32 * wid + c - 64 * rel - 4 * hi;
#pragma unroll
                for (int e = 0; e < 16; ++e) { const int kr = (e & 3) + 8 * (e >> 2);
                    s0[e] += __builtin_bit_cast(float, ((qi - kr) >> 31) & (int)0xff800000); s1[e] += __builtin_bit_cast(float, ((qi - 32 - kr) >> 31) & (int)0xff800000); }
            }
            float mt = fmaxf(s0[0], s1[0]);
#pragma unroll
            for (int e = 1; e < 16; ++e) mt = fmaxf(mt, fmaxf(s0[e], s1[e]));
            mt = fmaxf(mt, __shfl_xor(mt, 32));
            const float mnew = fmaxf(mrun, mt), alpha = __builtin_amdgcn_exp2f(mrun - mnew);
            mrun = mnew;
            float ls = 0.f;
#pragma unroll
            for (int e = 0; e < 16; ++e) { s0[e] = __builtin_amdgcn_exp2f(s0[e] - mnew); s1[e] = __builtin_amdgcn_exp2f(s1[e] - mnew); ls += s0[e] + s1[e]; }
            lrun = lrun * alpha + ls;
#pragma unroll
            for (int db = 0; db < 4; ++db)
#pragma unroll
                for (int e = 0; e < 16; ++e) o[db][e] *= alpha;
            bf16x8 p[2][2];
#pragma unroll
            for (int s = 0; s < 2; ++s) {
                u32x4 w0, w1;
                w0.x = cvt_pk_bf16(s0[8 * s + 0], s0[8 * s + 1]); w0.y = cvt_pk_bf16(s0[8 * s + 2], s0[8 * s + 3]); w0.z = cvt_pk_bf16(s0[8 * s + 4], s0[8 * s + 5]); w0.w = cvt_pk_bf16(s0[8 * s + 6], s0[8 * s + 7]);
                w1.x = cvt_pk_bf16(s1[8 * s + 0], s1[8 * s + 1]); w1.y = cvt_pk_bf16(s1[8 * s + 2], s1[8 * s + 3]); w1.z = cvt_pk_bf16(s1[8 * s + 4], s1[8 * s + 5]); w1.w = cvt_pk_bf16(s1[8 * s + 6], s1[8 * s + 7]);
                p[0][s] = __builtin_bit_cast(bf16x8, w0); p[1][s] = __builtin_bit_cast(bf16x8, w1);
            }
            const LAS unsigned char* vb = tb + 24576;
#pragma unroll
            for (int kb = 0; kb < 2; ++kb)
#pragma unroll
                for (int s = 0; s < 2; ++s) {
                    bf16x8 vf[4];
#pragma unroll
                    for (int db = 0; db < 4; ++db) vf[db] = *(const LAS bf16x8*)(vb + ((kb * 2 + s) * 4 + db) * 1024);
                    __builtin_amdgcn_sched_barrier(0);
#pragma unroll
                    for (int db = 0; db < 4; ++db) o[db] = __builtin_amdgcn_mfma_f32_32x32x16_bf16(vf[db], p[kb][s], o[db], 0, 0, 0);
                    __builtin_amdgcn_sched_barrier(0);
                }
        }
    }
#undef ATT_LOAD
    lrun += __shfl_xor(lrun, 32);
    const float inv = 1.0f / lrun;
    const int b = bh >> 3, h = bh & 7;
    unsigned char* orow = (unsigned char*)OB + ((size_t)(b * SEQ + qb * 256 + wid * 32 + c)) * 1024 + h * 128;
    const float inv4 = inv * O8_SCALE;
#pragma unroll
    for (int db = 0; db < 4; ++db)
#pragma unroll
        for (int gq = 0; gq < 4; ++gq) *(unsigned*)(orow + 32 * db + 8 * gq + 4 * hi) = pk4_fp8((f32x4){o[db][4 * gq], o[db][4 * gq + 1], o[db][4 * gq + 2], o[db][4 * gq + 3]} * inv4);
}

__device__ __forceinline__ float dpp_sum16(float v) {
    int x;
    x = __builtin_amdgcn_update_dpp(0, __builtin_bit_cast(int, v), 0xB1, 0xF, 0xF, false); v += __builtin_bit_cast(float, x);
    x = __builtin_amdgcn_update_dpp(0, __builtin_bit_cast(int, v), 0x4E, 0xF, 0xF, false); v += __builtin_bit_cast(float, x);
    x = __builtin_amdgcn_update_dpp(0, __builtin_bit_cast(int, v), 0x141, 0xF, 0xF, false); v += __builtin_bit_cast(float, x);
    x = __builtin_amdgcn_update_dpp(0, __builtin_bit_cast(int, v), 0x140, 0xF, 0xF, false); v += __builtin_bit_cast(float, x);
    return v;
}
__device__ __forceinline__ void dpp_sum16x2(float& a, float& b) {
    asm volatile(
        "s_nop 1\n\t"
        "v_add_f32_dpp %0, %0, %0 quad_perm:[1,0,3,2] row_mask:0xf bank_mask:0xf\n\t"
        "v_add_f32_dpp %1, %1, %1 quad_perm:[1,0,3,2] row_mask:0xf bank_mask:0xf\n\t"
        "s_nop 0\n\t"
        "v_add_f32_dpp %0, %0, %0 quad_perm:[2,3,0,1] row_mask:0xf bank_mask:0xf\n\t"
        "v_add_f32_dpp %1, %1, %1 quad_perm:[2,3,0,1] row_mask:0xf bank_mask:0xf\n\t"
        "s_nop 0\n\t"
        "v_add_f32_dpp %0, %0, %0 row_half_mirror row_mask:0xf bank_mask:0xf\n\t"
        "v_add_f32_dpp %1, %1, %1 row_half_mirror row_mask:0xf bank_mask:0xf\n\t"
        "s_nop 0\n\t"
        "v_add_f32_dpp %0, %0, %0 row_mirror row_mask:0xf bank_mask:0xf\n\t"
        "v_add_f32_dpp %1, %1, %1 row_mirror row_mask:0xf bank_mask:0xf\n\t"
        "s_nop 0"
        : "+v"(a), "+v"(b));
}
constexpr int SC_STEPS = 32, SC_STEPB = 1408, SC_BUF = SC_STEPS * SC_STEPB, SC_YOFF = 2 * SC_BUF, SC_YBUF = SC_STEPS * 128;
__device__ __forceinline__ void scan_block(LAS unsigned char* lds, const GAS unsigned char* ws, bf16_t* Y, int bh, int half, int tid, int wave, int lane) {
    const int ri = lane >> 4, c = lane & 15, b = bh >> 4, h = bh & 15;
    const size_t row0 = (size_t)b * SEQ * 1024 + h * 64;
    const int hi8 = tid >> 8, rem = tid & 255, sst = rem >> 3, seg = rem & 7;
    const size_t e01 = row0 + (size_t)sst * 1024 + seg * 8;
    const size_t o0 = (hi8 ? WS_BB : WS_KK) + e01 * 2, o1 = (hi8 ? WS_R : WS_KP) + e01 * 2;
    const int d0 = sst * SC_STEPB + hi8 * 256 + seg * 32, d1 = sst * SC_STEPB + (2 + hi8) * 256 + seg * 32;
    const int q = tid - 256, sv = (q >> 2) & 31, segv = q & 3;
    const bool has2 = tid < 384;
    const size_t o2 = hi8 ? (WS_VB + (row0 + (size_t)sv * 1024 + 32 * half + segv * 8) * 2) : (WS_OM + e01 * 2);
    const int d2 = hi8 ? (sv * SC_STEPB + 1280 + segv * 32) : (sst * SC_STEPB + 4 * 256 + seg * 32);
    u32x4 r0, r1, r2 = (u32x4){0u, 0u, 0u, 0u};
#define SC_ISSUE(n) do { const size_t _t = (size_t)(n) * SC_STEPS * 2048; r0 = *(const GAS u32x4*)(ws + o0 + _t); r1 = *(const GAS u32x4*)(ws + o1 + _t); if (has2) r2 = *(const GAS u32x4*)(ws + o2 + _t); } while (0)
#define SC_PUT(bufo, d, r) do { float _f[8]; unpack8(r, _f); *(LAS f32x4*)(lds + (bufo) + (d)) = (f32x4){_f[0], _f[1], _f[2], _f[3]}; *(LAS f32x4*)(lds + (bufo) + (d) + 16) = (f32x4){_f[4], _f[5], _f[6], _f[7]}; } while (0)
#define SC_WRITE(bufo) do { SC_PUT(bufo, d0, r0); SC_PUT(bufo, d1, r1); if (has2) SC_PUT(bufo, d2, r2); } while (0)
    __syncthreads();
    SC_ISSUE(0); SC_WRITE(0);
    __syncthreads();
    float S0 = 0.f, S1 = 0.f, S2 = 0.f, S3 = 0.f;
    const int yl = (4 * wave + ri) * 4;
#pragma unroll 1
    for (int n = 0; n < SEQ / SC_STEPS; ++n) {
        const int bufo = (n & 1) * SC_BUF;
        if (n + 1 < SEQ / SC_STEPS) SC_ISSUE(n + 1);
        {
        const LAS unsigned char* bp = lds + bufo + c * 16; const LAS unsigned char* vp = lds + bufo + 1280 + yl;
        LAS unsigned char* yp = lds + SC_YOFF + (n & 1) * SC_YBUF + yl;
#define SC_LD(X, s) do { X##kk = *(const LAS f32x4*)(bp + (s) * SC_STEPB); X##bb = *(const LAS f32x4*)(bp + (s) * SC_STEPB + 256); X##kp = *(const LAS f32x4*)(bp + (s) * SC_STEPB + 512); \
            X##rr = *(const LAS f32x4*)(bp + (s) * SC_STEPB + 768); X##om = *(const LAS f32x4*)(bp + (s) * SC_STEPB + 1024); X##vv = *(const LAS float*)(vp + (s) * SC_STEPB); } while (0)
#define SC_STEP(X, s) do { \
            float p = fmaf(S3, X##kk[3], fmaf(S2, X##kk[2], fmaf(S1, X##kk[1], S0 * X##kk[0]))); \
            const float u0 = fmaf(X##vv, X##kp[0], fmaf(-X##om[0], S0, S0)), u1 = fmaf(X##vv, X##kp[1], fmaf(-X##om[1], S1, S1)); \
            const float u2 = fmaf(X##vv, X##kp[2], fmaf(-X##om[2], S2, S2)), u3 = fmaf(X##vv, X##kp[3], fmaf(-X##om[3], S3, S3)); \
            dpp_sum16x2(p, yq); \
            if ((s) > 0) { if (c == 0) *(LAS float*)(yp + ((s) - 1) * 128) = yq; } \
            S0 = fmaf(-p, X##bb[0], u0); S1 = fmaf(-p, X##bb[1], u1); S2 = fmaf(-p, X##bb[2], u2); S3 = fmaf(-p, X##bb[3], u3); \
            yq = fmaf(S3, X##rr[3], fmaf(S2, X##rr[2], fmaf(S1, X##rr[1], S0 * X##rr[0]))); } while (0)
        f32x4 Akk, Abb, Akp, Arr, Aom, Bkk, Bbb, Bkp, Brr, Bom; float Avv, Bvv, yq = 0.f;
        SC_LD(A, 0);
#pragma unroll
        for (int s = 0; s < SC_STEPS; s += 2) {
            SC_LD(B, s + 1);
            SC_STEP(A, s);
            if (s + 2 < SC_STEPS) SC_LD(A, s + 2);
            SC_STEP(B, s + 1);
        }
        { float dummy = 0.f; dpp_sum16x2(yq, dummy); if (c == 0) *(LAS float*)(yp + (SC_STEPS - 1) * 128) = yq; }
#undef SC_LD
#undef SC_STEP
        }
        if (n + 1 < SEQ / SC_STEPS) SC_WRITE(bufo ^ SC_BUF);
        __syncthreads();
        if (tid < 128) {
            const LAS f32x4* yl4 = (const LAS f32x4*)(lds + SC_YOFF + (n & 1) * SC_YBUF + (tid >> 2) * 128 + (tid & 3) * 32);
            *(u32x4*)(Y + row0 + (size_t)(n * SC_STEPS + (tid >> 2)) * 1024 + 32 * half + (tid & 3) * 8) = pack8(yl4[0], yl4[1]);
        }
    }
    __syncthreads();
#undef SC_ISSUE
#undef SC_PUT
#undef SC_WRITE
}

constexpr int REC_BYTES = 29696, RO_KK = 0, RO_Q = 4096, RO_NT = 8192, RO_AK = 10240, RO_KQ = 12288, RO_BQ = 14336, RO_BT = 16384, RO_KT = 20480, RO_V = 24576, RO_PC = 28672;
constexpr int PRE_LDS = 13824;
__device__ __forceinline__ unsigned char* rec_ptr(unsigned char* ws, unsigned char* dout, int bh, int n) {
    return bh < 17 ? dout + (size_t)(bh * 256 + n) * REC_BYTES : ws + WS_RECB + (size_t)((bh - 17) * 256 + n) * REC_BYTES;
}
__device__ __forceinline__ void chunk_pre(LAS unsigned char* wl, const GAS unsigned char* ws, unsigned char* rec, int bh, int n, int lane, const float* mu, const float* pk_k, const float* pk_a, const float* pr_k) {
    asm volatile("" : "+v"(lane));
    const int b = bh >> 4, h = bh & 15, j = lane;
    const size_t e0 = ((size_t)(b * SEQ + 32 * n)) * 1024 + h * 64;
    const size_t r0 = ((size_t)(b * SEQ + 32 * n)) * 3072 + h * 64;
    const GAS bf16_t* pOM = (const GAS bf16_t*)(ws + WS_OM) + e0; const GAS bf16_t* pAA = (const GAS bf16_t*)(ws + WS_AA) + e0;
    const GAS bf16_t* pRAW = (const GAS bf16_t*)(ws + WS_RKV) + r0;
    GAS bf16_t* pVB = (GAS bf16_t*)(ws + WS_VB) + e0; GAS float* pBON = (GAS float*)(ws + WS_BONUS) + (size_t)(b * SEQ + 32 * n) * 16 + h;
    const float mur = mu[h * 64 + j], muk = mu[1024 + h * 64 + j], muv = mu[2048 + h * 64 + j], ckk = pk_k[h * 64 + j], cka = pk_a[h * 64 + j], crk = pr_k[h * 64 + j];
    float pr = 0.f, pk = 0.f, pv = 0.f;
    if (n > 0) { pr = bf2f(pRAW[(long)j - 3072]); pk = bf2f(pRAW[(long)j - 3072 + 1024]); pv = bf2f(pRAW[(long)j - 3072 + 2048]); }
    unsigned btp[16], ktp[16], vvp[16];
    float L = 0.f;
    unsigned short rom[2][8], raa[2][8], rr_[2][8], rk_[2][8], rv_[2][8];
#define PRE_LOAD(bf, tg_) do { _Pragma("unroll") for (int q = 0; q < 8; ++q) { const unsigned o = (unsigned)((8 * (tg_) + q) * 1024 + j), o3 = (unsigned)((8 * (tg_) + q) * 3072 + j); \
        rom[bf][q] = pOM[o]; raa[bf][q] = pAA[o]; rr_[bf][q] = pRAW[o3]; rk_[bf][q] = pRAW[o3 + 1024]; rv_[bf][q] = pRAW[o3 + 2048]; } } while (0)
    PRE_LOAD(0, 0);
#pragma unroll
    for (int tg = 0; tg < 4; ++tg) {
        const int bf = tg & 1;
        if (tg + 1 < 4) PRE_LOAD(bf ^ 1, tg + 1);
        __builtin_amdgcn_sched_barrier(0);
#pragma unroll
        for (int q = 0; q < 8; ++q) { const int t = 8 * tg + q;
            const float cr = bf2f(rr_[bf][q]), ck = bf2f(rk_[bf][q]), cv = bf2f(rv_[bf][q]), aa = bf2f(raa[bf][q]), om = bf2f(rom[bf][q]);
            const float rr = cr + (pr - cr) * mur, kx = ck + (pk - ck) * muk, vx = cv + (pv - cv) * muv;
            pr = cr; pk = ck; pv = cv;
            const float kk0 = kx * ckk, kp = kx * (1.0f + (aa - 1.0f) * cka);
            float nrm = kk0 * kk0, bon = rr * kp * crk;
            dpp_sum16x2(nrm, bon);
            const float nt_ = (__builtin_bit_cast(float, __builtin_amdgcn_readlane(fbits(nrm), 0)) + __builtin_bit_cast(float, __builtin_amdgcn_readlane(fbits(nrm), 16))) + (__builtin_bit_cast(float, __builtin_amdgcn_readlane(fbits(nrm), 32)) + __builtin_bit_cast(float, __builtin_amdgcn_readlane(fbits(nrm), 48)));
            const float bt_ = (__builtin_bit_cast(float, __builtin_amdgcn_readlane(fbits(bon), 0)) + __builtin_bit_cast(float, __builtin_amdgcn_readlane(fbits(bon), 16))) + (__builtin_bit_cast(float, __builtin_amdgcn_readlane(fbits(bon), 32)) + __builtin_bit_cast(float, __builtin_amdgcn_readlane(fbits(bon), 48)));
            const float kk = kk0 * (1.0f / fmaxf(sqrtf(nt_), 1e-12f)), bb = kk * aa;
            const unsigned vb16 = f2bf(vx);
            pVB[(unsigned)(t * 1024 + j)] = (bf16_t)vb16;
            if (j == 0) pBON[t * 16] = bt_;
            const float w = 1.0f - om, ekm = __expf(L);
            L += __logf(w);
            const float el = ekm * w, eil = __builtin_amdgcn_rcpf(el);
            *(LAS unsigned short*)(wl + 0 + t * 144 + j * 2) = (unsigned short)f2bf(kk * ekm);
            *(LAS unsigned short*)(wl + 4608 + t * 144 + j * 2) = (unsigned short)f2bf(rr * el);
            const unsigned bt = f2bf(bb * eil), kt = f2bf(kp * eil);
            *(LAS unsigned short*)(wl + 9216 + t * 144 + j * 2) = (unsigned short)bt;
            if (q & 1) { btp[t >> 1] |= bt << 16; ktp[t >> 1] |= kt << 16; vvp[t >> 1] |= vb16 << 16; } else { btp[t >> 1] = bt; ktp[t >> 1] = kt; vvp[t >> 1] = vb16; }
        }
        __builtin_amdgcn_sched_barrier(0);
    }
#undef PRE_LOAD
    *(float*)(rec + RO_PC + j * 4) = __expf(L);
    {
        const int jb = j >> 5, jr = j & 31;
#pragma unroll
        for (int s2 = 0; s2 < 2; ++s2)
#pragma unroll
            for (int hh = 0; hh < 2; ++hh) {
                const int tp = (16 * s2 + 4 * hh) >> 1, tn = (16 * s2 + 8 * hh) >> 1;
                *(u32x4*)(rec + RO_BT + ((jb * 2 + s2) * 64 + hh * 32 + jr) * 16) = (u32x4){btp[tp], btp[tp + 1], btp[tp + 4], btp[tp + 5]};
                *(u32x4*)(rec + RO_KT + ((jb * 2 + s2) * 64 + hh * 32 + jr) * 16) = (u32x4){ktp[tn], ktp[tn + 1], ktp[tn + 2], ktp[tn + 3]};
                *(u32x4*)(rec + RO_V + jb * 2048 + (s2 * 64 + hh * 32 + jr) * 16) = (u32x4){vvp[tn], vvp[tn + 1], vvp[tn + 2], vvp[tn + 3]};
            }
    }
    LDS_WAIT(); asm volatile("" ::: "memory");
    const int r = lane & 31, hh = lane >> 5;
#pragma unroll
    for (int m = 0; m < 2; ++m)
#pragma unroll
        for (int blk = 0; blk < 4; ++blk) { const int j0 = 16 * blk + 4 * hh;
            const u32x2 lo = *(const LAS u32x2*)(wl + m * 4608 + r * 144 + j0 * 2), hi = *(const LAS u32x2*)(wl + m * 4608 + r * 144 + (j0 + 8) * 2);
            *(u32x4*)(rec + (m ? RO_Q : RO_KK) + (blk * 64 + lane) * 16) = (u32x4){lo.x, lo.y, hi.x, hi.y}; }
    bf16x8 ak[4], aq[4], bx[4];
#pragma unroll
    for (int ks = 0; ks < 4; ++ks) { ak[ks] = *(const LAS bf16x8*)(wl + r * 144 + (16 * ks + 8 * hh) * 2); aq[ks] = *(const LAS bf16x8*)(wl + 4608 + r * 144 + (16 * ks + 8 * hh) * 2); bx[ks] = *(const LAS bf16x8*)(wl + 9216 + r * 144 + (16 * ks + 8 * hh) * 2); }
    f32x16 Ab, Bq, Ak, Kq;
#pragma unroll
    for (int e = 0; e < 16; ++e) { Ab[e] = 0.f; Bq[e] = 0.f; Ak[e] = 0.f; Kq[e] = 0.f; }
    asm volatile("" : "+v"(Ab), "+v"(Bq), "+v"(Ak), "+v"(Kq));
#pragma unroll
    for (int ks = 0; ks < 4; ++ks) { Ab = __builtin_amdgcn_mfma_f32_32x32x16_bf16(ak[ks], bx[ks], Ab, 0, 0, 0); Bq = __builtin_amdgcn_mfma_f32_32x32x16_bf16(aq[ks], bx[ks], Bq, 0, 0, 0); }
    LDS_WAIT(); asm volatile("" ::: "memory");
#pragma unroll
    for (int t = 0; t < 32; ++t) *(LAS unsigned short*)(wl + 9216 + t * 144 + j * 2) = (unsigned short)((t & 1) ? (ktp[t >> 1] >> 16) : (ktp[t >> 1] & 0xffffu));
    LDS_WAIT(); asm volatile("" ::: "memory");
#pragma unroll
    for (int ks = 0; ks < 4; ++ks) bx[ks] = *(const LAS bf16x8*)(wl + 9216 + r * 144 + (16 * ks + 8 * hh) * 2);
#pragma unroll
    for (int ks = 0; ks < 4; ++ks) { Ak = __builtin_amdgcn_mfma_f32_32x32x16_bf16(ak[ks], bx[ks], Ak, 0, 0, 0); Kq = __builtin_amdgcn_mfma_f32_32x32x16_bf16(aq[ks], bx[ks], Kq, 0, 0, 0); }
#pragma unroll
    for (int g = 0; g < 16; ++g) { const int t = (g & 3) + 8 * (g >> 2) + 4 * hh;
        const int ms = (r - t) >> 31, mi = (r - t - 1) >> 31;
        const float xab = Ab[g], xak = Ak[g], xbq = Bq[g], xkq = Kq[g];
        Ab[g] = __builtin_bit_cast(float, fbits(xab) & ms); Ak[g] = __builtin_bit_cast(float, fbits(xak) & ms);
        Bq[g] = __builtin_bit_cast(float, fbits(xbq) & mi); Kq[g] = __builtin_bit_cast(float, fbits(xkq) & mi); }
    float Tr[32];
#pragma unroll
    for (int t = 0; t < 32; ++t) {
        float acc = __builtin_bit_cast(float, 0x3f800000 & ~(((r - t) | (t - r)) >> 31));
        const float abt = Ab[(t & 3) + 4 * (t >> 3)];
#pragma unroll
        for (int s = 0; s < t; ++s) { const float a = __builtin_bit_cast(float, __builtin_amdgcn_readlane(fbits(abt), s + 32 * ((t >> 2) & 1))); acc = fmaf(-a, Tr[s], acc); }
        Tr[t] = acc;
        __builtin_amdgcn_sched_barrier(0);
    }
    LDS_WAIT(); asm volatile("" ::: "memory");
    {
        const int c = r, s2 = c >> 4;
        const int lp = ((c >> 2) & 1) * 32, ep = 4 * ((c >> 3) & 1) + (c & 3);
        const int ln = ((c >> 3) & 1) * 32, en = c & 7;
#pragma unroll
        for (int tt = 0; tt < 16; ++tt) { const int t = 16 * hh + tt;
            *(LAS unsigned short*)(wl + 0 + (s2 * 64 + lp + t) * 16 + ep * 2) = (unsigned short)f2bf(-Tr[t]); }
#pragma unroll
        for (int g = 0; g < 16; ++g) { const int t = (g & 3) + 8 * (g >> 2) + 4 * hh;
            *(LAS unsigned short*)(wl + 2048 + (s2 * 64 + ln + t) * 16 + en * 2) = (unsigned short)f2bf(Ak[g]);
            *(LAS unsigned short*)(wl + 4096 + (s2 * 64 + ln + t) * 16 + en * 2) = (unsigned short)f2bf(Kq[g]);
            *(LAS unsigned short*)(wl + 6144 + (s2 * 64 + lp + t) * 16 + ep * 2) = (unsigned short)f2bf(Bq[g]); }
    }
    LDS_WAIT(); asm volatile("" ::: "memory");
#pragma unroll
    for (int p = 0; p < 8; ++p) *(u32x4*)(rec + RO_NT + (p * 64 + lane) * 16) = *(const LAS u32x4*)(wl + (p * 64 + lane) * 16);
    LDS_WAIT(); asm volatile("" ::: "memory");
}
constexpr int SEQ_SLOT = 27 * 1024;
constexpr int CV_HSHARE = 1024, CV_HSTOP = 176;
__device__ __forceinline__ void chunk_seq(LAS unsigned char* lds, unsigned char* ws, unsigned char* dout, bf16_t* Y, int bh, int vb, int lane, volatile LAS int* prog) {
    const int c = lane & 31, hi = lane >> 5, b = bh >> 4, h = bh & 15;
    f32x16 St0, St1;
#pragma unroll
    for (int e = 0; e < 16; ++e) { St0[e] = 0.f; St1[e] = 0.f; }
#define SQ_ISSUE(n, slot) do { const unsigned char* _r = rec_ptr(ws, dout, bh, (n)) + lane * 16; \
        _Pragma("unroll") for (int _p = 0; _p < 24; ++_p) __builtin_amdgcn_global_load_lds((const unsigned*)(_r + _p * 1024), (LAS unsigned*)(lds + (slot) * SEQ_SLOT + _p * 1024), 16, 0, 0); \
        _Pragma("unroll") for (int _p = 0; _p < 2; ++_p) __builtin_amdgcn_global_load_lds((const unsigned*)(_r + RO_V + vb * 2048 + _p * 1024), (LAS unsigned*)(lds + (slot) * SEQ_SLOT + (24 + _p) * 1024), 16, 0, 0); \
        __builtin_amdgcn_global_load_lds((const unsigned*)(_r + RO_PC), (LAS unsigned*)(lds + (slot) * SEQ_SLOT + 26 * 1024), 16, 0, 0); } while (0)
#define SQ_FRAG(slot, p) (*(const LAS bf16x8*)(lds + (slot) * SEQ_SLOT + (p) * 1024 + lane * 16))
#define SQ_PACK(X, s2) __builtin_bit_cast(bf16x8, (u32x4){cvt_pk_bf16(X[8 * (s2) + 0], X[8 * (s2) + 1]), cvt_pk_bf16(X[8 * (s2) + 2], X[8 * (s2) + 3]), cvt_pk_bf16(X[8 * (s2) + 4], X[8 * (s2) + 5]), cvt_pk_bf16(X[8 * (s2) + 6], X[8 * (s2) + 7])})
    SQ_ISSUE(0, 0);
#pragma unroll 1
    for (int n = 0; n < 256; ++n) {
        const int slot = n & 1;
        prog[0] = n;
        SQ_ISSUE(n + 1 < 256 ? n + 1 : n, slot ^ 1);
        if (n == 0) asm volatile("s_waitcnt vmcnt(27)" ::: "memory");
        else asm volatile("s_waitcnt vmcnt(43)" ::: "memory");
        const bf16x8 S00 = SQ_PACK(St0, 0), S01 = SQ_PACK(St0, 1), S10 = SQ_PACK(St1, 0), S11 = SQ_PACK(St1, 1);
        const bf16x8 V0 = SQ_FRAG(slot, 24), V1 = SQ_FRAG(slot, 25);
        f32x16 ZA;
#pragma unroll
        for (int e = 0; e < 16; ++e) ZA[e] = 0.f;
        asm volatile("" : "+v"(ZA));
        ZA = __builtin_amdgcn_mfma_f32_32x32x16_bf16(SQ_FRAG(slot, 0), S00, ZA, 0, 0, 0); ZA = __builtin_amdgcn_mfma_f32_32x32x16_bf16(SQ_FRAG(slot, 1), S01, ZA, 0, 0, 0);
        ZA = __builtin_amdgcn_mfma_f32_32x32x16_bf16(SQ_FRAG(slot, 2), S10, ZA, 0, 0, 0); ZA = __builtin_amdgcn_mfma_f32_32x32x16_bf16(SQ_FRAG(slot, 3), S11, ZA, 0, 0, 0);
        ZA = __builtin_amdgcn_mfma_f32_32x32x16_bf16(SQ_FRAG(slot, 10), V0, ZA, 0, 0, 0); ZA = __builtin_amdgcn_mfma_f32_32x32x16_bf16(SQ_FRAG(slot, 11), V1, ZA, 0, 0, 0);
        f32x16 Yt;
#pragma unroll
        for (int e = 0; e < 16; ++e) Yt[e] = 0.f;
        asm volatile("" : "+v"(Yt));
        Yt = __builtin_amdgcn_mfma_f32_32x32x16_bf16(SQ_FRAG(slot, 4), S00, Yt, 0, 0, 0); Yt = __builtin_amdgcn_mfma_f32_32x32x16_bf16(SQ_FRAG(slot, 5), S01, Yt, 0, 0, 0);
        Yt = __builtin_amdgcn_mfma_f32_32x32x16_bf16(SQ_FRAG(slot, 6), S10, Yt, 0, 0, 0); Yt = __builtin_amdgcn_mfma_f32_32x32x16_bf16(SQ_FRAG(slot, 7), S11, Yt, 0, 0, 0);
        Yt = __builtin_amdgcn_mfma_f32_32x32x16_bf16(SQ_FRAG(slot, 12), V0, Yt, 0, 0, 0); Yt = __builtin_amdgcn_mfma_f32_32x32x16_bf16(SQ_FRAG(slot, 13), V1, Yt, 0, 0, 0);
        asm volatile("s_nop 7\n\ts_nop 7" : "+v"(ZA));
        const bf16x8 Z0 = SQ_PACK(ZA, 0), Z1 = SQ_PACK(ZA, 1);
        f32x16 U;
#pragma unroll
        for (int e = 0; e < 16; ++e) U[e] = 0.f;
        asm volatile("" : "+v"(U));
        U = __builtin_amdgcn_mfma_f32_32x32x16_bf16(SQ_FRAG(slot, 8), Z0, U, 0, 0, 0); U = __builtin_amdgcn_mfma_f32_32x32x16_bf16(SQ_FRAG(slot, 9), Z1, U, 0, 0, 0);
        asm volatile("s_nop 7\n\ts_nop 7" : "+v"(U));
        const bf16x8 U0 = SQ_PACK(U, 0), U1 = SQ_PACK(U, 1);
        Yt = __builtin_amdgcn_mfma_f32_32x32x16_bf16(SQ_FRAG(slot, 14), U0, Yt, 0, 0, 0); Yt = __builtin_amdgcn_mfma_f32_32x32x16_bf16(SQ_FRAG(slot, 15), U1, Yt, 0, 0, 0);
        St0 = __builtin_amdgcn_mfma_f32_32x32x16_bf16(SQ_FRAG(slot, 16), U0, St0, 0, 0, 0); St0 = __builtin_amdgcn_mfma_f32_32x32x16_bf16(SQ_FRAG(slot, 17), U1, St0, 0, 0, 0);
        St0 = __builtin_amdgcn_mfma_f32_32x32x16_bf16(SQ_FRAG(slot, 20), V0, St0, 0, 0, 0); St0 = __builtin_amdgcn_mfma_f32_32x32x16_bf16(SQ_FRAG(slot, 21), V1, St0, 0, 0, 0);
        St1 = __builtin_amdgcn_mfma_f32_32x32x16_bf16(SQ_FRAG(slot, 18), U0, St1, 0, 0, 0); St1 = __builtin_amdgcn_mfma_f32_32x32x16_bf16(SQ_FRAG(slot, 19), U1, St1, 0, 0, 0);
        St1 = __builtin_amdgcn_mfma_f32_32x32x16_bf16(SQ_FRAG(slot, 22), V0, St1, 0, 0, 0); St1 = __builtin_amdgcn_mfma_f32_32x32x16_bf16(SQ_FRAG(slot, 23), V1, St1, 0, 0, 0);
#pragma unroll
        for (int gq = 0; gq < 4; ++gq) { const f32x4 p0 = *(const LAS f32x4*)(lds + slot * SEQ_SLOT + 26 * 1024 + (8 * gq + 4 * hi) * 4), p1 = *(const LAS f32x4*)(lds + slot * SEQ_SLOT + 26 * 1024 + (32 + 8 * gq + 4 * hi) * 4);
#pragma unroll
            for (int e = 0; e < 4; ++e) { St0[4 * gq + e] *= p0[e]; St1[4 * gq + e] *= p1[e]; } }
        bf16_t* yrow = Y + ((size_t)(b * SEQ + 32 * n)) * 1024 + h * 64 + 32 * vb + c;
#pragma unroll
        for (int g = 0; g < 16; ++g) yrow[(size_t)((g & 3) + 8 * (g >> 2) + 4 * hi) * 1024] = (bf16_t)f2bf(Yt[g]);
    }
    asm volatile("s_waitcnt vmcnt(0)" ::: "memory");
#undef SQ_ISSUE
#undef SQ_FRAG
#undef SQ_PACK
}

#define WIN ((bf16_t*)(ws + WS_WIN))
#define WL ((bf16_t*)(ws + WS_WL))
#define WR ((bf16_t*)(ws + WS_WR))
#define WUQ ((bf16_t*)(ws + WS_WUQ))
#define WUKV ((bf16_t*)(ws + WS_WUKV))
#define WA ((bf16_t*)(ws + WS_WA))
#define WB ((bf16_t*)(ws + WS_WB))
#define WO ((bf16_t*)(ws + WS_WO))
#define WSHGU ((bf16_t*)(ws + WS_WSHGU))
#define WSHD ((bf16_t*)(ws + WS_WSHD))
#define WPLE ((bf16_t*)(ws + WS_WPLE))
#define WPG ((bf16_t*)(ws + WS_WPG))
#define PBF ((bf16_t*)(ws + WS_PBF))
#define WEG ((bf16_t*)(ws + WS_WEG))
#define WED ((bf16_t*)(ws + WS_WED))
#define RSTDQ ((float*)(ws + WS_RSTDQ))
#define RSTDKV ((float*)(ws + WS_RSTDKV))
#define RSTDP ((float*)(ws + WS_RSTDP))
#define BONUS ((float*)(ws + WS_BONUS))
#define EIDX ((int*)(ws + WS_EIDX))
#define WTS ((float*)(ws + WS_WTS))
#define POS ((int*)(ws + WS_POS))
#define SLOT ((int*)(ws + WS_SLOT))
#define ROWTOK ((int*)(ws + WS_ROWTOK))
#define ROWW ((float*)(ws + WS_ROWW))
#define TILEE ((int*)(ws + WS_TILEE))
#define HB ((bf16_t*)(ws + WS_H))
#define RKV ((bf16_t*)(ws + WS_RKV))
#define MISC ((bf16_t*)(ws + WS_MISC))
#define CQKV ((bf16_t*)(ws + WS_CQKV))
#define GATES ((bf16_t*)(ws + WS_GATES))
#define LIN ((bf16_t*)(ws + WS_L))
#define OMB ((bf16_t*)(ws + WS_OM))
#define AA ((bf16_t*)(ws + WS_AA))
#define GG ((bf16_t*)(ws + WS_GG))
#define QRAW ((bf16_t*)(ws + WS_QRAW))
#define KVRAW ((bf16_t*)(ws + WS_KVRAW))
#define RB ((bf16_t*)(ws + WS_R))
#define KPB ((bf16_t*)(ws + WS_KP))
#define KKB ((bf16_t*)(ws + WS_KK))
#define BBB ((bf16_t*)(ws + WS_BB))
#define VBB ((bf16_t*)(ws + WS_VB))
#define QF ((bf16_t*)(ws + WS_QF))
#define KF ((bf16_t*)(ws + WS_KF))
#define VTF ((bf16_t*)(ws + WS_VTF))
#define YS ((bf16_t*)(ws + WS_Y))
#define OB ((bf16_t*)(ws + WS_OB))
#define OA ((bf16_t*)(ws + WS_OA))
#define MERGED ((bf16_t*)(ws + WS_MERGED))
#define Y2 ((bf16_t*)(ws + WS_Y2))
#define H2 ((bf16_t*)(ws + WS_H2))
#define LOGIT ((float*)(ws + WS_LOGIT))
#define ACTSH ((bf16_t*)(ws + WS_ACTSH))
#define PLERAW ((bf16_t*)(ws + WS_PLERAW))
#define XN3 ((bf16_t*)(ws + WS_XN3))
#define ACT ((bf16_t*)(ws + WS_ACT))
__global__ void __launch_bounds__(512, 2) hybrid_fwd(Args args) {
    extern __shared__ __attribute__((aligned(16))) unsigned char lds_raw[];
    GAS unsigned char* ws = (GAS unsigned char*)args.ws;
    for (int u = threadIdx.x; u < (LDS_BYTES - LDSCTL_OFF) / 4; u += 512) ((LAS unsigned*)((LAS unsigned char*)lds_raw + LDSCTL_OFF))[u] = 0u;
    __syncthreads();
    const int lo = args.ph_lo, hi = args.ph_hi;
    if ((hi - lo) > 1) (void)xcd_barrier_post((unsigned*)(ws + WS_CTL) + CW_BAR, (volatile LAS unsigned*)((LAS unsigned char*)lds_raw + LDSCTL_OFF) + 8);
#ifndef GSEL
#define GSEL 7
#endif
#ifndef PHASE_MASK
#define PHASE_MASK 0x7ffffu
#endif
#define IN(k) (((PHASE_MASK >> (k)) & 1u) && lo <= (k) && (k) < hi)
#define SEAM(k) do { if (IN(k) && IN((k) + 1)) { XcdBarrier _b; _b.bar = (unsigned*)(ws + WS_CTL) + CW_BAR; _b.x = xb_xcc_id(); _b.st = (volatile LAS unsigned*)((LAS unsigned char*)lds_raw + LDSCTL_OFF) + 8; xcd_barrier(_b); } } while (0)
    typedef __attribute__((address_space(4))) const Args CArgs;
    CArgs* ap = (CArgs*)__builtin_amdgcn_kernarg_segment_ptr();
#define PHASE_BEGIN() asm volatile("" : "+s"(ap), "+s"(ws)); int tid = threadIdx.x; asm volatile("" : "+v"(tid)); \
    const int lane = tid & 63, wave = __builtin_amdgcn_readfirstlane(tid >> 6); Frame F; F.lds = (LAS unsigned char*)lds_raw; F.tid = tid; F.lane = lane; F.wave = wave; \
    F.G = gridDim.x; { const int bx = blockIdx.x; F.vcu = (F.G % 8 == 0) ? (bx % 8) * (F.G / 8) + bx / 8 : bx; } F.gw = F.vcu * 8 + wave; F.NGW = F.G * 8; F.ws = (unsigned char*)ws; F.ctl = (unsigned*)(ws + WS_CTL); \
    LAS float* const scr = (LAS float*)(F.lds + wave * 8448); (void)scr; (void)lane
#ifndef REPEAT_MASK
#define REPEAT_MASK 0u
#endif
#define REP(k) for (int _rep = 0; _rep < (int)((REPEAT_MASK >> (k)) & 1u) + 1; ++_rep)
#define OUT ((float*)(GAS float*)ap->out)
#define INP(k) ((const float*)(const GAS float*)ap->in[k])

    REP(0) {
    if (IN(0)) { PHASE_BEGIN();
        const float* w_in = INP(4);
        constexpr int P0_ITEMS = 32 * (96 + 9 + 2 + 32 + 128) + 32 + 32 + 96 + 8 * 48 + 8 * 64;
#pragma unroll 1
        for (int it = F.gw; it < P0_ITEMS; it += F.NGW) { int r = it;
            CONV_JOB(w_in, 8544, 0, 3072, 2048, (const float*)nullptr, 0, WIN, 2048, 0, 0)
            CONV_JOB(w_in, 8544, 3072, 288, 2048, (const float*)nullptr, 0, WIN, 2048, 3072, 0)
            CONV_JOB(w_in, 8544, 4384, 64, 2048, (const float*)nullptr, 0, WIN, 2048, 3360, 0)
            CONV_JOB(w_in, 8544, 3360, 1024, 2048, (const float*)nullptr, 0, WIN, 2048, 3584, 0)
            CONV_JOB8X(w_in, 8544, 4448, 4096, 2048, ws + WS_WIN8G, 2048, 0, 8)
            CONV_JOB(INP(7), 1024, 0, 1024, 64, (const float*)nullptr, 0, WL, 384, 0, 0)
            CONV_JOB(INP(9), 1024, 0, 1024, 64, (const float*)nullptr, 0, WL, 384, 1024, 64)
            CONV_JOB(INP(10), 1024, 0, 1024, 160, (const float*)nullptr, 0, WL, 384, 2048, 128)
            CONV_JOB(INP(19), 1536, 0, 1536, 512, INP(17), 0, WUQ, 512, 0, 0)
            CONV_JOB(INP(20), 2048, 0, 2048, 512, INP(18), 0, WUKV, 512, 0, 0)
        }
        for (int i = F.gw * 64 + lane; i < 160 * 2048 / 8; i += F.NGW * 64) *((u32x4*)(WIN + (size_t)3424 * 2048) + i) = (u32x4){0u, 0u, 0u, 0u};
        for (int m = F.gw; m < T; m += F.NGW) rms_row_bf16(INP(0) + (size_t)m * D, INP(3), HB + (size_t)m * D, nullptr, lane, (unsigned char*)(ws + WS_HB8) + (size_t)m * D);
        for (int i = F.gw * 64 + lane; i < T * 256 / 4; i += F.NGW * 64) { const f32x4 v = *((const f32x4*)INP(1) + i); u32x2 w; w.x = pk2(v[0], v[1]); w.y = pk2(v[2], v[3]); *((u32x2*)PBF + i) = w; }
    }
    SEAM(0);
    }
    REP(1) {
    if (IN(1)) { PHASE_BEGIN();
        { pg8::Gemm g{HB, WIN, 2048, 2048, 2048}; pg8::DenseOrder S; S.init(64, 18, F.G, (int)blockIdx.x);
          pg8::EpiProj E{RKV, MISC, CQKV, GATES};
          pg8::gemm_phase<pg8::EpiProj, pg8::DenseOrder, false>(F.lds, g, S, E, tid); }
        { pg8::Gemm g{(const bf16_t*)(ws + WS_HB8), (const bf16_t*)(ws + WS_WIN8G), 1024, 1024, 1024, 0x7f7f7f7f, 0x79797979};
          pg8::DenseOrderTail S; S.d.init(64, 16, F.G, (int)blockIdx.x); S.lo = F.G == 256 ? 3 : (1 << 20); S.hi = 2; pg8::EpiGates E{GATES};
          pg8::gemm_phase<pg8::EpiGates, pg8::DenseOrderTail, false, true>(F.lds, g, S, E, tid); }
    }
    SEAM(1);
    }
    REP(2) {
    if (IN(2)) { PHASE_BEGIN();
        const float* mu = INP(5);
        float mul_[6];
#pragma unroll
        for (int j = 0; j < 6; ++j) mul_[j] = (lane + 64 * j) < 288 ? mu[3072 + lane + 64 * j] : 0.f;
        for (int t = F.gw; t < T; t += F.NGW) {
            const bool first = (t % SEQ) == 0;
#pragma unroll
            for (int j = 0; j < 6; ++j) { const int cidx = lane + 64 * j; float o = 0.f;
                if (cidx < 288) { const float uu = bf2f(MISC[(size_t)t * 512 + cidx]), pv = first ? 0.f : bf2f(MISC[(size_t)(t - 1) * 512 + cidx]);
                    const float x = uu + (pv - uu) * mul_[j];
                    o = cidx < 64 ? tanhf(x) : (cidx < 128 ? x : sigmoidf_(x)); }
                LIN[(size_t)t * 384 + cidx] = (bf16_t)f2bf(o); }
            float v8[8]; unpack8(*((const u32x4*)(CQKV + (size_t)t * 1024) + lane), v8);
            float sq = 0.f;
#pragma unroll
            for (int e = 0; e < 8; ++e) sq += v8[e] * v8[e];
            unpack8(*((const u32x4*)(CQKV + (size_t)t * 1024 + 512) + lane), v8);
            float sk = 0.f;
#pragma unroll
            for (int e = 0; e < 8; ++e) sk += v8[e] * v8[e];
            sq = wave_sum(sq); sk = wave_sum(sk);
            if (lane == 0) { RSTDQ[t] = 1.0f / sqrtf(sq * (1.f / 512.f) + NORM_EPS); RSTDKV[t] = 1.0f / sqrtf(sk * (1.f / 512.f) + NORM_EPS); }
        }
    }
    SEAM(2);
    }
    REP(3) {
    if (IN(3)) { PHASE_BEGIN();
        if (GSEL & 1) { pg8::Gemm g{LIN, WL, 384, 384, 384}; pg8::DenseOrder S; S.init(64, 12, F.G, (int)blockIdx.x); pg8::EpiLora E{OMB, AA, GG, INP(6), INP(8)};
          pg8::gemm_phase<pg8::EpiLora, pg8::DenseOrder, false>(F.lds, g, S, E, tid); }
        if (GSEL & 2) { pg8::Gemm g{CQKV, WUQ, 1024, 512, 512}; pg8::DenseOrder S; S.init(64, 6, F.G, (int)blockIdx.x); pg8::EpiRowScale E{QRAW, 1536, RSTDQ};
          pg8::gemm_phase<pg8::EpiRowScale, pg8::DenseOrder, false>(F.lds, g, S, E, tid); }
        if (GSEL & 4) { pg8::Gemm g{CQKV + 512, WUKV, 1024, 512, 512}; pg8::DenseOrder S; S.init(64, 8, F.G, (int)blockIdx.x); pg8::EpiRowScale E{KVRAW, 2048, RSTDKV};
          pg8::gemm_phase<pg8::EpiRowScale, pg8::DenseOrder, false>(F.lds, g, S, E, tid); }
    }
    SEAM(3);
    }
    REP(4) {
    if (IN(4)) { PHASE_BEGIN();
        {
            const int tk = lane & 7, j8 = lane >> 3;
            float gq_[16], gq1_[4], gq2_[4], gk_[16], gk1_[4], gk2_[4];
#pragma unroll
            for (int e = 0; e < 16; ++e) { gq_[e] = INP(21)[16 * j8 + e]; gk_[e] = INP(22)[16 * j8 + e]; }
#pragma unroll
            for (int e = 0; e < 4; ++e) { gq1_[e] = INP(21)[128 + 4 * j8 + e]; gq2_[e] = INP(21)[160 + 4 * j8 + e]; gk1_[e] = INP(22)[128 + 4 * j8 + e]; gk2_[e] = INP(22)[160 + 4 * j8 + e]; }
            double fr[4];
#pragma unroll
            for (int e = 0; e < 4; ++e) fr[e] = exp2(-(double)(4 * j8 + e) * (13.287712379549449 / 32.0)) * 0.15915494309189535;
            const float QSCALE = 0.10411754627697264f;
            struct MlaRaw { u32x4 q0, q1, k0, k1; u32x2 qa, qb; };
#define MLA_LOAD(d, hh_) do { const bf16_t* _q = QRAW + (size_t)t * 1536 + (hh_) * 192; d.q0 = *(const u32x4*)(_q + 16 * j8); d.q1 = *(const u32x4*)(_q + 16 * j8 + 8); d.qa = *(const u32x2*)(_q + 128 + 4 * j8); d.qb = *(const u32x2*)(_q + 160 + 4 * j8); \
                const bf16_t* _k = KVRAW + (size_t)t * 2048 + (hh_) * 256; d.k0 = *(const u32x4*)(_k + 16 * j8); d.k1 = *(const u32x4*)(_k + 16 * j8 + 8); } while (0)
            for (int g8 = F.gw; g8 < T / 8; g8 += F.NGW) {
                const int t = g8 * 8 + tk, bidx = t / SEQ, s = t % SEQ;
                MlaRaw cur, nxt;
                MLA_LOAD(cur, 0);
                nxt = cur;
                u32x2 ka, kb; { const bf16_t* _r = MISC + (size_t)t * 512 + 288; ka = *(const u32x2*)(_r + 4 * j8); kb = *(const u32x2*)(_r + 32 + 4 * j8); }
                float cs[4], sn[4];
                { const double pp = (double)((const GAS int*)ap->pos)[t];
#pragma unroll
                  for (int e = 0; e < 4; ++e) { double rv = pp * fr[e]; rv -= floor(rv); const float rf = (float)rv; sn[e] = __builtin_amdgcn_sinf(rf); cs[e] = __builtin_amdgcn_cosf(rf); } }
#pragma unroll 1
                for (int hd = 0; hd < 8; ++hd) {
                if (hd + 1 < 8) MLA_LOAD(nxt, hd + 1);
                { float x[16], r1[4], r2[4];
                  unpack8(cur.q0, *(float(*)[8])&x[0]); unpack8(cur.q1, *(float(*)[8])&x[8]);
                  { const u32x2 w1 = cur.qa, w2 = cur.qb;
                    r1[0] = bflo(w1.x); r1[1] = bfhi(w1.x); r1[2] = bflo(w1.y); r1[3] = bfhi(w1.y); r2[0] = bflo(w2.x); r2[1] = bfhi(w2.x); r2[2] = bflo(w2.y); r2[3] = bfhi(w2.y); }
                  float ss = 0.f;
#pragma unroll
                  for (int e = 0; e < 16; ++e) ss += x[e] * x[e];
#pragma unroll
                  for (int e = 0; e < 4; ++e) ss += r1[e] * r1[e] + r2[e] * r2[e];
                  ss += __shfl_xor(ss, 8); ss += __shfl_xor(ss, 16); ss += __shfl_xor(ss, 32);
                  const float rs = QSCALE / sqrtf(ss * (1.f / 192.f) + NORM_EPS);
#pragma unroll
                  for (int e = 0; e < 16; ++e) x[e] *= rs * gq_[e];
                  float o1[4], o2[4];
#pragma unroll
                  for (int e = 0; e < 4; ++e) { const float t1 = r1[e] * rs * gq1_[e], t2 = r2[e] * rs * gq2_[e]; o1[e] = t1 * cs[e] - t2 * sn[e]; o2[e] = t1 * sn[e] + t2 * cs[e]; }
                  bf16_t* blk = QF + ((size_t)((bidx * 8 + hd) * 256 + (s >> 5)) * 12) * 512; const int rr = s & 31;
                  u32x4 w; w.x = pk2(x[0], x[1]); w.y = pk2(x[2], x[3]); w.z = pk2(x[4], x[5]); w.w = pk2(x[6], x[7]); *(u32x4*)(blk + (j8 * 64 + rr) * 8) = w;
                  w.x = pk2(x[8], x[9]); w.y = pk2(x[10], x[11]); w.z = pk2(x[12], x[13]); w.w = pk2(x[14], x[15]); *(u32x4*)(blk + (j8 * 64 + 32 + rr) * 8) = w;
                  const int hh = (j8 & 3) >> 1, jo = 4 * (j8 & 1);
                  u32x2 w2; w2.x = pk2(o1[0], o1[1]); w2.y = pk2(o1[2], o1[3]); *(u32x2*)(blk + ((8 + (j8 >> 2)) * 64 + hh * 32 + rr) * 8 + jo) = w2;
                  w2.x = pk2(o2[0], o2[1]); w2.y = pk2(o2[2], o2[3]); *(u32x2*)(blk + ((10 + (j8 >> 2)) * 64 + hh * 32 + rr) * 8 + jo) = w2; }
                { float x[16], r1[4], r2[4];
                  unpack8(cur.k0, *(float(*)[8])&x[0]); unpack8(cur.k1, *(float(*)[8])&x[8]);
                  { const u32x2 w1 = ka, w2 = kb;
                    r1[0] = bflo(w1.x); r1[1] = bfhi(w1.x); r1[2] = bflo(w1.y); r1[3] = bfhi(w1.y); r2[0] = bflo(w2.x); r2[1] = bfhi(w2.x); r2[2] = bflo(w2.y); r2[3] = bfhi(w2.y); }
                  float ss = 0.f;
#pragma unroll
                  for (int e = 0; e < 16; ++e) ss += x[e] * x[e];
#pragma unroll
                  for (int e = 0; e < 4; ++e) ss += r1[e] * r1[e] + r2[e] * r2[e];
                  ss += __shfl_xor(ss, 8); ss += __shfl_xor(ss, 16); ss += __shfl_xor(ss, 32);
                  const float rs = 1.0f / sqrtf(ss * (1.f / 192.f) + NORM_EPS);
#pragma unroll
                  for (int e = 0; e < 16; ++e) x[e] *= rs * gk_[e];
                  float o1[4], o2[4];
#pragma unroll
                  for (int e = 0; e < 4; ++e) { const float t1 = r1[e] * rs * gk1_[e], t2 = r2[e] * rs * gk2_[e]; o1[e] = t1 * cs[e] - t2 * sn[e]; o2[e] = t1 * sn[e] + t2 * cs[e]; }
                  bf16_t* blk = KF + ((size_t)((bidx * 8 + hd) * 256 + (s >> 5)) * 12) * 512; const int rr = s & 31;
                  u32x4 w; w.x = pk2(x[0], x[1]); w.y = pk2(x[2], x[3]); w.z = pk2(x[4], x[5]); w.w = pk2(x[6], x[7]); *(u32x4*)(blk + (j8 * 64 + rr) * 8) = w;
                  w.x = pk2(x[8], x[9]); w.y = pk2(x[10], x[11]); w.z = pk2(x[12], x[13]); w.w = pk2(x[14], x[15]); *(u32x4*)(blk + (j8 * 64 + 32 + rr) * 8) = w;
                  const int hh = (j8 & 3) >> 1, jo = 4 * (j8 & 1);
                  u32x2 w2; w2.x = pk2(o1[0], o1[1]); w2.y = pk2(o1[2], o1[3]); *(u32x2*)(blk + ((8 + (j8 >> 2)) * 64 + hh * 32 + rr) * 8 + jo) = w2;
                  w2.x = pk2(o2[0], o2[1]); w2.y = pk2(o2[2], o2[3]); *(u32x2*)(blk + ((10 + (j8 >> 2)) * 64 + hh * 32 + rr) * 8 + jo) = w2;
                  }
                cur = nxt;
                }
            }
#undef MLA_LOAD
        }
        {
            LAS unsigned char* vl = F.lds + wave * 8704;
            for (int it = F.gw; it < 16 * 256; it += F.NGW) {
                const int bh = it >> 8, kb = it & 255, bidx = bh >> 3, hd = bh & 7;
                const int key = lane & 31, dh = lane >> 5;
                const bf16_t* vsrc = KVRAW + (size_t)(bidx * SEQ + kb * 32 + key) * 2048 + hd * 256 + 128 + dh * 64;
#pragma unroll
                for (int i = 0; i < 8; ++i) *(LAS u32x4*)(vl + key * 272 + (dh * 64 + i * 8) * 2) = *(const u32x4*)(vsrc + i * 8);
                LDS_WAIT(); asm volatile("" ::: "memory");
                const int r = lane & 31, hv = lane >> 5;
#pragma unroll
                for (int blk = 0; blk < 8; ++blk) { const int s2 = blk >> 2, db = blk & 3; unsigned w[4];
#pragma unroll
                    for (int jp = 0; jp < 4; ++jp) { const int j0 = 2 * jp, k0 = 16 * s2 + 8 * (j0 >> 2) + 4 * hv + (j0 & 3);
                        const unsigned lo = *(const LAS unsigned short*)(vl + k0 * 272 + (32 * db + r) * 2), hi = *(const LAS unsigned short*)(vl + (k0 + 1) * 272 + (32 * db + r) * 2); w[jp] = lo | (hi << 16); }
                    *(u32x4*)(VTF + ((size_t)(bh * 256 + kb) * 8 + blk) * 512 + lane * 8) = (u32x4){w[0], w[1], w[2], w[3]}; }
                LDS_WAIT(); asm volatile("" ::: "memory");
            }
        }
        __syncthreads();
        for (int it = F.gw; it < 8192; it += F.NGW) chunk_pre(F.lds + wave * PRE_LDS, ws, rec_ptr((unsigned char*)ws, (unsigned char*)OUT, it >> 8, it & 255), it >> 8, it & 255, lane, INP(5), INP(11), INP(12), INP(13));
    }
    SEAM(4);
    }
    REP(5) {
    if (IN(5)) { PHASE_BEGIN();
        const int bx = blockIdx.x;
#if CHUNKED
#if CHUNK_DEBUG
        if (bx < 32) { if (wave == 0) chunk_seq(F.lds, (unsigned char*)ws, (unsigned char*)OUT, YS, bx >> 1, bx & 1, lane, (volatile LAS int*)(F.lds + LDSCTL_OFF + 128)); __syncthreads(); }
        if (bx >= 96 && bx < 128) scan_block(F.lds, ws, YS, (bx - 64) >> 1, bx & 1, tid, wave, lane);
#else
#define EXP_ITEM(it0_, srcp, lds_, dstp, ldd_) do { const int _i = (it0_); if (_i < 65536) { const int nb = _i & 3, kb = (_i >> 2) & 31, j = (_i >> 7) & 3, gu = (_i >> 9) & 1, e = _i >> 10; \
                        srcp = (gu ? INP(29) : INP(28)) + (size_t)e * 2048 * 512 + (size_t)kb * 64 * 512 + j * 128 + nb * 32; lds_ = 512; dstp = (unsigned char*)WEG + (size_t)(e * 1024 + j * 256 + nb * 64 + gu * 32) * 2048 + kb * 64; ldd_ = 2048; } \
                    else { const int _q = _i - 65536; const int nb = _q & 63, kb = (_q >> 6) & 7, e = _q >> 9; srcp = INP(30) + (size_t)e * 512 * 2048 + (size_t)kb * 64 * 2048 + nb * 32; lds_ = 2048; dstp = (unsigned char*)WED + (size_t)(e * 2048 + nb * 32) * 512 + kb * 64; ldd_ = 512; } } while (0)
        if (bx < 64) {
            volatile LAS int* prog = (volatile LAS int*)(F.lds + LDSCTL_OFF + 128);
            if (wave == 0) chunk_seq(F.lds, (unsigned char*)ws, (unsigned char*)OUT, YS, bx >> 1, bx & 1, lane, prog);
            else if (wave < 4) {
                LAS float* scr2 = (LAS float*)(F.lds + 2 * SEQ_SLOT + (wave - 1) * 8448);
#pragma unroll 1
                for (;;) {
                    if (prog[0] >= CV_HSTOP) break;
                    int c = 0; if (lane == 0) c = (int)atomicAdd(&F.ctl[CW_CVH], 1u);
                    c = __builtin_amdgcn_readfirstlane(c);
                    if (c >= CV_HSHARE) break;
                    f32x4 va_[8], vb_[8]; const float* sp; unsigned char* dpa; unsigned char* dpb; int l1, l2a, l2b;
#pragma unroll 1
                    for (int q = 0; q < 64; q += 2) {
                        EXP_ITEM(c * 64 + q, sp, l1, dpa, l2a); conv_load(sp, l1, lane, va_);
                        EXP_ITEM(c * 64 + q + 1, sp, l1, dpb, l2b); conv_load(sp, l1, lane, vb_);
                        conv_store8(va_, dpa, l2a, scr2, lane, W8_SCALE); conv_store8(vb_, dpb, l2b, scr2, lane, W8_SCALE);
                    }
                }
            }
            __syncthreads();
        }
#endif
#if CHUNK_DEBUG
        if (bx >= 64 && bx < 96) scan_block(F.lds, ws, (bf16_t*)(ws + WS_YDBG), (bx - 64) >> 1, bx & 1, tid, wave, lane);
        { XcdBarrier _b; _b.bar = (unsigned*)(ws + WS_CTL) + CW_BAR; _b.x = xb_xcc_id(); _b.st = (volatile LAS unsigned*)((LAS unsigned char*)lds_raw + LDSCTL_OFF) + 8; xcd_barrier(_b); }
#endif
#else
        REP(21) if (bx < 64) scan_block(F.lds, ws, YS, bx >> 1, bx & 1, tid, wave, lane);
#endif
        REP(20) {
            volatile LAS int* qw = (volatile LAS int*)(F.lds + LDSCTL_OFF + 64);
#pragma unroll 1
            for (;;) {
                if (tid == 0) qw[0] = (int)atomicAdd(&F.ctl[CW_ATTQ + 64 * _rep], 1u);
                __syncthreads();
                const int uix = qw[0];
                if (uix >= 512) break;
                attn_unit(F.lds, QF, KF, VTF, OB, uix & 15, 31 - (uix >> 4), tid, wave, lane);
            }
            __syncthreads();
        }
        {
            volatile LAS int* qw = (volatile LAS int*)(F.lds + LDSCTL_OFF + 64);
#pragma unroll 1
            for (;;) {
                __syncthreads();
                constexpr int CV_MISC = 1024 + 1024 + 2048 + 3 * 64 + 8 * 128 + 512 + 256 + 2048;
                if (tid == 0) { int c = CV_HSHARE + (int)atomicAdd(&F.ctl[CW_CVQ], 1u);
                    if (c >= (98304 + CV_MISC + 63) / 64) { c = (int)atomicAdd(&F.ctl[CW_CVH], 1u); if (c >= CV_HSHARE) c = 1 << 30; }
                    qw[0] = c; }
                __syncthreads();
                const int cix = qw[0];
                if (cix >= (98304 + CV_MISC + 63) / 64) break;
                if (cix < 1536) {
                    f32x4 va_[8], vb_[8]; const float* sp; unsigned char* dpa; unsigned char* dpb; int l1, l2a, l2b;
                    EXP_ITEM(cix * 64 + wave, sp, l1, dpa, l2a); conv_load(sp, l1, lane, va_);
#pragma unroll
                    for (int k8 = 0; k8 < 8; k8 += 2) {
                        EXP_ITEM(cix * 64 + (k8 + 1) * 8 + wave, sp, l1, dpb, l2b); conv_load(sp, l1, lane, vb_);
                        conv_store8(va_, dpa, l2a, scr, lane, W8_SCALE);
                        if (k8 + 2 < 8) { EXP_ITEM(cix * 64 + (k8 + 2) * 8 + wave, sp, l1, dpa, l2a); conv_load(sp, l1, lane, va_); }
                        conv_store8(vb_, dpb, l2b, scr, lane, W8_SCALE);
                    }
                } else
#pragma unroll 1
                for (int k8 = 0; k8 < 8; ++k8) {
                    const int it0 = cix * 64 + k8 * 8 + wave;
                    if (it0 >= 98304 && it0 < 98304 + CV_MISC) {
                        int r = it0 - 98304;
                        CONV_JOB8X(INP(16), 2048, 0, 2048, 1024, WA, 1024, 0, 8)
                        CONV_JOB8X(INP(23), 2048, 0, 2048, 1024, WB, 1024, 0, 8)
                        CONV_JOB8X(INP(24), 2048, 0, 2048, 2048, WO, 2048, 0, 8)
                        CONV_JOB(INP(26), 64, 0, 64, 2048, (const float*)nullptr, 0, WR, 4096, 0, 0)
                        CONV_JOB(INP(26), 64, 0, 64, 2048, (const float*)nullptr, 0, WR, 4096, 0, 2048)
                        CONV_JOB(INP(26), 64, 0, 64, 2048, (const float*)nullptr, 1, WR, 4096, 64, 0)
                        CONV_JOB8X(INP(31), 512, 0, 128, 2048, WSHGU, 2048, 0, 16)
                        CONV_JOB8X(INP(32), 512, 0, 128, 2048, WSHGU, 2048, 32, 16)
                        CONV_JOB8X(INP(31), 512, 128, 128, 2048, WSHGU, 2048, 256, 16)
                        CONV_JOB8X(INP(32), 512, 128, 128, 2048, WSHGU, 2048, 288, 16)
                        CONV_JOB8X(INP(31), 512, 256, 128, 2048, WSHGU, 2048, 512, 16)
                        CONV_JOB8X(INP(32), 512, 256, 128, 2048, WSHGU, 2048, 544, 16)
                        CONV_JOB8X(INP(31), 512, 384, 128, 2048, WSHGU, 2048, 768, 16)
                        CONV_JOB8X(INP(32), 512, 384, 128, 2048, WSHGU, 2048, 800, 16)
                        CONV_JOB8X(INP(33), 2048, 0, 2048, 512, WSHD, 512, 0, 8)
                        CONV_JOB(INP(34), 2048, 0, 2048, 256, (const float*)nullptr, 0, WPLE, 256, 0, 0)
                        CONV_JOB8X(INP(37), 2048, 0, 2048, 2048, WPG, 2048, 0, 8)
                    }
                }
            }
            __syncthreads();
        }
    }
    SEAM(5);
    }
    REP(6) {
    if (IN(6)) { PHASE_BEGIN();
        const int ch = 16 * lane;
        float gw_[16], gb_[16];
#pragma unroll
        for (int e = 0; e < 16; ++e) { gw_[e] = INP(14)[ch + e]; gb_[e] = INP(15)[ch + e]; }
        for (int t = F.gw; t < T; t += F.NGW) {
            float y[16], vv[16], gg[16];
            unpack8(*(const u32x4*)(YS + (size_t)t * 1024 + ch), *(float(*)[8])&y[0]); unpack8(*(const u32x4*)(YS + (size_t)t * 1024 + ch + 8), *(float(*)[8])&y[8]);
#if CHUNK_DEBUG
            if (t < SEQ) { float yo[16]; unpack8(*(const u32x4*)((const bf16_t*)(ws + WS_YDBG) + (size_t)t * 1024 + ch), *(float(*)[8])&yo[0]); unpack8(*(const u32x4*)((const bf16_t*)(ws + WS_YDBG) + (size_t)t * 1024 + ch + 8), *(float(*)[8])&yo[8]);
              float dn = 0.f, dd = 0.f;
#pragma unroll
              for (int e = 0; e < 16; ++e) { dn += (y[e] - yo[e]) * (y[e] - yo[e]); dd += yo[e] * yo[e]; }
              dn = wave_sum(dn); dd = wave_sum(dd);
              if (!(dn < 1e12f)) dn = 1e12f;
              if (lane == 0 && t < DBG_TMAX) { atomicAdd((unsigned long long*)&F.ctl[CW_DBG], (unsigned long long)(dn * 4096.f)); atomicAdd((unsigned long long*)&F.ctl[CW_DBG + 2], (unsigned long long)(dd * 4096.f)); }
#pragma unroll
              for (int e = 0; e < 16; ++e) y[e] = yo[e]; }

#endif
            unpack8(*(const u32x4*)(VBB + (size_t)t * 1024 + ch), *(float(*)[8])&vv[0]); unpack8(*(const u32x4*)(VBB + (size_t)t * 1024 + ch + 8), *(float(*)[8])&vv[8]);
            unpack8(*(const u32x4*)(GG + (size_t)t * 1024 + ch), *(float(*)[8])&gg[0]); unpack8(*(const u32x4*)(GG + (size_t)t * 1024 + ch + 8), *(float(*)[8])&gg[8]);
            float sm = 0.f;
#pragma unroll
            for (int e = 0; e < 16; ++e) sm += y[e];
            sm += __shfl_xor(sm, 1); sm += __shfl_xor(sm, 2);
            const float mean = sm * (1.f / 64.f); float vs = 0.f;
#pragma unroll
            for (int e = 0; e < 16; ++e) { const float d = y[e] - mean; vs += d * d; }
            vs += __shfl_xor(vs, 1); vs += __shfl_xor(vs, 2);
            const float rstd = 1.0f / sqrtf(vs * (1.f / 64.f) + GN_EPS), bon = BONUS[(size_t)t * 16 + (lane >> 2)];
            float o[16];
#pragma unroll
            for (int e = 0; e < 16; ++e) o[e] = ((y[e] - mean) * rstd * gw_[e] + gb_[e] + bon * vv[e]) * gg[e];
            u32x4 w0; w0.x = pk4_fp8((f32x4){o[0], o[1], o[2], o[3]} * O8_SCALE); w0.y = pk4_fp8((f32x4){o[4], o[5], o[6], o[7]} * O8_SCALE); w0.z = pk4_fp8((f32x4){o[8], o[9], o[10], o[11]} * O8_SCALE); w0.w = pk4_fp8((f32x4){o[12], o[13], o[14], o[15]} * O8_SCALE);
            *(u32x4*)((unsigned char*)OA + (size_t)t * 1024 + ch) = w0;
        }
    }
    SEAM(6);
    }
    REP(7) {
    if (IN(7)) { PHASE_BEGIN();
        { pg8::Gemm g{OA, WA, 512, 512, 512, 0x7d7d7d7d, 0x79797979}; pg8::DenseOrder S; S.init(64, 8, F.G, (int)blockIdx.x); pg8::EpiMerge<0> E{MERGED, GATES, 0, nullptr};
          pg8::gemm_phase<pg8::EpiMerge<0>, pg8::DenseOrder, false, true>(F.lds, g, S, E, tid); }
        { pg8::Gemm g{OB, WB, 512, 512, 512, 0x7d7d7d7d, 0x79797979}; pg8::DenseOrder S; S.init(64, 8, F.G, (int)blockIdx.x); pg8::EpiMerge<1> E{MERGED, GATES, 2048, (unsigned char*)(ws + WS_MERGED8)};
          pg8::gemm_phase<pg8::EpiMerge<1>, pg8::DenseOrder, false, true>(F.lds, g, S, E, tid); }
    }
    SEAM(7);
    }
    REP(8) {
    if (IN(8)) { PHASE_BEGIN();
        pg8::Gemm g{(const bf16_t*)(ws + WS_MERGED8), WO, 1024, 1024, 1024, 0x7d7d7d7d, 0x79797979}; pg8::DenseOrder S; S.init(64, 8, F.G, (int)blockIdx.x); pg8::EpiResid E{INP(0), OUT};
        pg8::gemm_phase<pg8::EpiResid, pg8::DenseOrder, false, true>(F.lds, g, S, E, tid);
    }
    SEAM(8);
    }
    REP(9) {
    if (IN(9)) { PHASE_BEGIN();
        for (int m = F.gw; m < T; m += F.NGW) rms_row_bf16(OUT + (size_t)m * D, INP(25), H2 + (size_t)m * 4096, H2 + (size_t)m * 4096 + 2048, lane, (unsigned char*)(ws + WS_H2F8) + (size_t)m * D);
    }
    SEAM(9);
    }
    REP(10) {
    if (IN(10)) { PHASE_BEGIN();
        if (GSEL & 1) { pg8::Gemm g{H2, WR, 4096, 1024, 4096}; pg8::RouterOrder S{F.G, (int)blockIdx.x}; pg8::EpiLogit E{LOGIT};
          pg8::gemm_phase<pg8::EpiLogit, pg8::RouterOrder, false>(F.lds, g, S, E, tid); }
        if (GSEL & 2) { pg8::Gemm g{(const bf16_t*)(ws + WS_H2F8), WSHGU, 1024, 1024, 1024, 0x7f7f7f7f, 0x79797979}; pg8::DenseOrder S; S.init(64, 4, F.G, (int)blockIdx.x); pg8::EpiSwiglu8 E{(unsigned char*)ACTSH};
          pg8::gemm_phase<pg8::EpiSwiglu8, pg8::DenseOrder, false, true>(F.lds, g, S, E, tid); }
        if (GSEL & 4) { pg8::Gemm g{PBF, WPLE, 256, 256, 256}; pg8::DenseOrder S; S.init(64, 8, F.G, (int)blockIdx.x); pg8::EpiRowScale E{PLERAW, 2048, nullptr};
          pg8::gemm_phase<pg8::EpiRowScale, pg8::DenseOrder, false>(F.lds, g, S, E, tid); }
    }
    SEAM(10);
    }
    REP(11) {
    if (IN(11)) { PHASE_BEGIN();
        const float bias = INP(27)[lane];
        LAS int* lcnt = (LAS int*)(F.lds);
        LAS int* lbase = lcnt + 64;
        if (tid < 64) lcnt[tid] = 0;
        __syncthreads();
        const int tpw = T / F.G, t0 = F.vcu * tpw;
        for (int tt = wave; tt < tpw; tt += 8) {
            const int t = t0 + tt;
            float lg = 0.f;
#pragma unroll
            for (int kc = 0; kc < 4; ++kc) lg += LOGIT[(size_t)kc * T * 128 + (size_t)t * 128 + lane] + LOGIT[(size_t)kc * T * 128 + (size_t)t * 128 + 64 + lane];
            lg = (fabsf(lg) < 1e30f) ? lg : 0.f;
            const float score = 1.0f / (1.0f + expf(-lg)), choice = score + bias;
            float m1 = choice; m1 = fmaxf(m1, __shfl_xor(m1, 1)); m1 = fmaxf(m1, __shfl_xor(m1, 2)); m1 = fmaxf(m1, __shfl_xor(m1, 4));
            const unsigned long long eq = __ballot(choice == m1);
            const int grp = lane >> 3; const unsigned geq = (unsigned)(eq >> (8 * grp)) & 0xffu; const int firstl = __builtin_ctz(geq);
            float c2 = ((lane & 7) == firstl) ? -__builtin_inff() : choice;
            float m2 = c2; m2 = fmaxf(m2, __shfl_xor(m2, 1)); m2 = fmaxf(m2, __shfl_xor(m2, 2)); m2 = fmaxf(m2, __shfl_xor(m2, 4));
            const float gs = m1 + m2;
            int grank = 0;
#pragma unroll
            for (int g2 = 0; g2 < 8; ++g2) { const float og = __shfl(gs, 8 * g2); grank += (og > gs || (og == gs && g2 < grp)) ? 1 : 0; }
            const bool cand = grank < 4;
            const float cv = cand ? choice : -__builtin_inff();
            int rank = 0;
#pragma unroll 8
            for (int j = 0; j < 64; ++j) { const float ov = __shfl(cv, j); rank += (ov > cv || (ov == cv && j < lane)) ? 1 : 0; }
            const bool sel = cand && rank < 8;
            const float wsum = wave_sum(sel ? score : 0.f);
            const unsigned long long sm = __ballot(sel);
            if (sel) {
                const int kslot = __popcll(sm & ((1ull << lane) - 1ull));
                const int ls = atomicAdd((int*)&lcnt[lane], 1);
                EIDX[(size_t)t * 8 + kslot] = lane; WTS[(size_t)t * 8 + kslot] = score / (wsum + 1e-20f) * 2.5f; SLOT[(size_t)t * 8 + kslot] = ls;
            }
            { float sq = 0.f;
#pragma unroll
              for (int j = 0; j < 4; ++j) { float v8[8]; unpack8(*((const u32x4*)(PLERAW + (size_t)t * 2048) + lane + 64 * j), v8);
#pragma unroll
                  for (int e = 0; e < 8; ++e) sq += v8[e] * v8[e]; }
              sq = wave_sum(sq); if (lane == 0) RSTDP[t] = 1.0f / sqrtf(sq * (1.f / 2048.f) + NORM_EPS); }
        }
        __syncthreads();
        if (tid < 64) lbase[tid] = (int)atomicAdd(&F.ctl[CW_CNT + tid], (unsigned)lcnt[tid]);
        __syncthreads();
        for (int i = tid; i < tpw * 8; i += 512) { const size_t o = (size_t)t0 * 8 + i; SLOT[o] += lbase[EIDX[o]]; }
        __syncthreads();
    }
    SEAM(11);
    }
    REP(12) {
    if (IN(12)) { PHASE_BEGIN();
        LAS int* pst = (LAS int*)(F.lds);
        if (wave == 0) {
            const int cn = (int)__hip_atomic_load(&F.ctl[CW_CNT + lane], __ATOMIC_RELAXED, __HIP_MEMORY_SCOPE_AGENT); const int nt = (cn + 255) >> 8;
            int rank = 0;
#pragma unroll 8
            for (int j = 0; j < 64; ++j) { const int ov = __shfl(nt, j); rank += (ov > nt || (ov == nt && j < lane)) ? 1 : 0; }
            const int rr = rank >> 3, rc = rank & 7, grp = (rr & 1) ? 7 - rc : rc, q = grp * 8 + rr;
            pst[160 + q] = nt;
            LDS_WAIT(); asm volatile("" ::: "memory");
            const int v = pst[160 + lane]; int incl = v;
#pragma unroll
            for (int d = 1; d < 64; d <<= 1) { const int o = __shfl_up(incl, d); if (lane >= d) incl += o; }
            pst[240 + lane] = incl - v;
            LDS_WAIT(); asm volatile("" ::: "memory");
            const int st = pst[240 + q], total = __shfl(incl, 63);
            pst[lane] = st * 256; pst[80 + lane] = (st + nt) * 256;
            if (lane == 0) pst[64] = total * 256;
            if (lane < 8) pst[320 + lane] = pst[240 + 8 * lane];
            if (lane == 8) pst[328] = total;
        }
        __syncthreads();
        const int tpw = T / F.G, t0 = F.vcu * tpw;
        for (int i = tid; i < tpw * 8; i += 512) { const size_t o = (size_t)t0 * 8 + i; const int e = EIDX[o], dest = pst[e] + SLOT[o]; POS[o] = dest; ROWTOK[dest] = (int)(o >> 3); ROWW[dest] = WTS[o]; }
        for (int e = F.vcu; e < 64; e += F.G) {
            const int cn = (int)__hip_atomic_load(&F.ctl[CW_CNT + e], __ATOMIC_RELAXED, __HIP_MEMORY_SCOPE_AGENT);
            for (int r = pst[e] + cn + tid; r < pst[80 + e]; r += 512) { ROWTOK[r] = 0; ROWW[r] = 0.f; }
            for (int tl = pst[e] / 256 + tid; tl < pst[80 + e] / 256; tl += 512) TILEE[tl] = e;
        }
        if (F.vcu == 0 && tid == 0) TILEE[1023] = pst[64] / 256;
        if (F.vcu == 0 && tid < 9) TILEE[1008 + tid] = pst[320 + tid];
        __syncthreads();
    }
    SEAM(12);
    }
    REP(13) {
    if (IN(13)) { PHASE_BEGIN();
        const int gx = (int)blockIdx.x & 7, gt0 = TILEE[1008 + gx], gnt = TILEE[1009 + gx] - gt0;
        if (GSEL & 1) { pg8::Gemm g{(const bf16_t*)(ws + WS_H2F8), WEG, 1024, 1024, 1024, 0x7f7f7f7f, 0x79797979}; pg8::MoeOrder S{gt0, gnt, 4, F.G >> 3, (int)blockIdx.x >> 3, TILEE, ROWTOK}; pg8::EpiSwiglu8 E{(unsigned char*)ACT};
          pg8::gemm_phase<pg8::EpiSwiglu8, pg8::MoeOrder, true, true>(F.lds, g, S, E, tid); }
        {
          pg8::Gemm g{ACTSH, WSHD, 256, 256, 256, 0x7c7c7c7c, 0x79797979}; pg8::DenseOrder S; S.init(64, 8, F.G, (int)blockIdx.x); pg8::EpiRowScale E{(bf16_t*)(ws + WS_YSH), 2048, nullptr};
          pg8::gemm_phase<pg8::EpiRowScale, pg8::DenseOrder, false, true>(F.lds, g, S, E, tid); }
    }
    SEAM(13);
    }
    REP(14) {
    if (IN(14)) { PHASE_BEGIN();
        const int gx = (int)blockIdx.x & 7, gt0 = TILEE[1008 + gx], gnt = TILEE[1009 + gx] - gt0;
        pg8::Gemm g{ACT, WED, 256, 256, 256, 0x7c7c7c7c, 0x79797979}; pg8::MoeOrder S{gt0, gnt, 8, F.G >> 3, (int)blockIdx.x >> 3, TILEE, ROWTOK}; pg8::EpiDown E{(unsigned char*)(ws + WS_Y2B), ROWW};
        pg8::gemm_phase<pg8::EpiDown, pg8::MoeOrder, false, true>(F.lds, g, S, E, tid);
    }
    SEAM(14);
    }
    if (IN(15)) { PHASE_BEGIN();
        for (int t = F.gw; t < T; t += F.NGW) {
            f32x4 x[8];
#pragma unroll
            for (int j = 0; j < 8; ++j) x[j] = *((const f32x4*)(OUT + (size_t)t * D) + lane + 64 * j);
            int pk[8]; float wk[8]; unsigned yw[8][8];
#pragma unroll
            for (int j = 0; j < 8; ++j) { const u32x2 w = *((const u32x2*)((const bf16_t*)(ws + WS_YSH) + (size_t)t * D) + lane + 64 * j); x[j][0] += bflo(w.x); x[j][1] += bfhi(w.x); x[j][2] += bflo(w.y); x[j][3] += bfhi(w.y); }
#pragma unroll
            for (int k = 0; k < 8; ++k) pk[k] = POS[(size_t)t * 8 + k];
#pragma unroll
            for (int k = 0; k < 8; ++k) wk[k] = ROWW[pk[k]] * (1.f / Y8_SCALE);
#pragma unroll
            for (int k = 0; k < 8; ++k) { const unsigned* yr = (const unsigned*)(ws + WS_Y2B + (size_t)pk[k] * 2048) + lane;
#pragma unroll
                for (int j = 0; j < 8; ++j) yw[k][j] = yr[64 * j]; }
#pragma unroll
            for (int k = 0; k < 8; ++k)
#pragma unroll
                for (int j = 0; j < 8; ++j) { const unsigned w = yw[k][j]; const auto lo = __builtin_amdgcn_cvt_pk_f32_fp8((int)w, false), hi = __builtin_amdgcn_cvt_pk_f32_fp8((int)w, true);
                    x[j][0] += lo[0] * wk[k]; x[j][1] += lo[1] * wk[k]; x[j][2] += hi[0] * wk[k]; x[j][3] += hi[1] * wk[k]; }
#pragma unroll
            for (int j = 0; j < 8; ++j) *((f32x4*)(OUT + (size_t)t * D) + lane + 64 * j) = x[j];
            float s = 0.f;
#pragma unroll
            for (int j = 0; j < 8; ++j) s += (x[j][0] * x[j][0] + x[j][1] * x[j][1]) + (x[j][2] * x[j][2] + x[j][3] * x[j][3]);
            const float rstd = 1.0f / sqrtf(wave_sum(s) * (1.f / 2048.f) + NORM_EPS);
#pragma unroll
            for (int j = 0; j < 8; ++j) { const f32x4 gq = *((const f32x4*)INP(36) + lane + 64 * j); const f32x4 y = x[j] * rstd * gq; ((unsigned*)((unsigned char*)XN3 + (size_t)t * D))[lane + 64 * j] = pk4_fp8(y); }
        }
    }
    SEAM(15);
    REP(18) {
    if (IN(18)) { PHASE_BEGIN();
        pg8::Gemm g{XN3, WPG, 1024, 1024, 1024, 0x7f7f7f7f, 0x79797979}; pg8::DenseOrder S; S.init(64, 8, F.G, (int)blockIdx.x); float dsc = 1.0f;
#if CHUNK_DEBUG
        { const float dn = (float)*(const unsigned long long*)&F.ctl[CW_DBG], dd = (float)*(const unsigned long long*)&F.ctl[CW_DBG + 2]; dsc = 1.0f + DBG_GAIN * sqrtf(dn / fmaxf(dd, 1.f)); }
#endif
        pg8::EpiFinal E{OUT, PLERAW, RSTDP, INP(35), dsc};
        pg8::gemm_phase<pg8::EpiFinal, pg8::DenseOrder, false, true>(F.lds, g, S, E, tid);
    }
    SEAM(18);
    }
#undef IN
#undef SEAM
#undef OUT
#undef INP
#undef PHASE_BEGIN
}

#ifndef N_LAUNCH_PER_PHASE
#define N_LAUNCH_PER_PHASE 0
#endif
extern "C" void kernel_launch(void* const* d_in, const int* in_sizes, int n_in, void* d_out, int out_size, void* d_ws, size_t ws_size, hipStream_t stream) {
    static int grid = 0;
    if (grid == 0) {
        if (n_in != 38 || out_size != T * D || ws_size < WS_END) { fprintf(stderr, "kernel_launch: unexpected shapes (n_in %d out %d ws %zu)\n", n_in, out_size, ws_size); grid = -1; return; }
        int dev = 0, cus = 0, per_cu = 0;
        if (hipGetDevice(&dev) != hipSuccess || hipDeviceGetAttribute(&cus, hipDeviceAttributeMultiprocessorCount, dev) != hipSuccess) { grid = -1; return; }
        if (hipFuncSetAttribute((const void*)hybrid_fwd, hipFuncAttributeMaxDynamicSharedMemorySize, LDS_BYTES) != hipSuccess) { fprintf(stderr, "kernel_launch: hipFuncSetAttribute failed\n"); grid = -1; return; }
        if (hipOccupancyMaxActiveBlocksPerMultiprocessor(&per_cu, (const void*)hybrid_fwd, 512, LDS_BYTES) != hipSuccess || per_cu < 1) fprintf(stderr, "kernel_launch: occupancy query reports %d\n", per_cu);
        (void)hipGetLastError();
        grid = cus;
    }
    if (grid < 0) return;
    (void)hipMemsetAsync((char*)d_ws + WS_CTL, 0, ZERO_BYTES, stream);
    Args a{};
    for (int i = 0; i < 38; ++i) a.in[i] = (const float*)d_in[i];
    a.pos = (const int*)d_in[2]; a.out = (float*)d_out; a.ws = (unsigned char*)d_ws;
#if N_LAUNCH_PER_PHASE
    for (int ph = 0; ph < NPH; ++ph) { a.ph_lo = ph; a.ph_hi = ph + 1; hipLaunchKernelGGL(hybrid_fwd, dim3(grid), dim3(512), LDS_BYTES, stream, a); }
#else
    a.ph_lo = 0; a.ph_hi = NPH; hipLaunchKernelGGL(hybrid_fwd, dim3(grid), dim3(512), LDS_BYTES, stream, a);
#endif
}
```

```cpp
#include <hip/hip_runtime.h>
#include <cstdio>
#include <cstdint>

#define GAS __attribute__((address_space(1)))
#define LAS __attribute__((address_space(3)))
typedef unsigned short bf16_t;
typedef short bf16x8 __attribute__((ext_vector_type(8)));
typedef float f32x4 __attribute__((ext_vector_type(4)));
typedef float f32x16 __attribute__((ext_vector_type(16)));
typedef unsigned u32x4 __attribute__((ext_vector_type(4)));
typedef unsigned u32x2 __attribute__((ext_vector_type(2)));

constexpr int T = 16384, SEQ = 8192, NB = 2, D = 2048;
constexpr int NPH = 19;
constexpr float NORM_EPS = 1e-6f, GN_EPS = 64e-5f;
constexpr int NTH = 288;
constexpr int PMAX = 147456;

constexpr size_t MiB = 1u << 20;
constexpr size_t WS_CTL = 0, ZERO_BYTES = 8 * MiB;
constexpr size_t WS_WL = 1 * MiB;
constexpr size_t WS_WR = 4 * MiB;
constexpr size_t WS_WIN8G = 26 * MiB  , WS_HB8 = 316 * MiB  ;
constexpr size_t WS_WIN = 8 * MiB;
constexpr size_t WS_WUQ = 42 * MiB, WS_WUKV = 44 * MiB, WS_WA = 46 * MiB, WS_WB = 50 * MiB, WS_WO = 54 * MiB;
constexpr size_t WS_WSHGU = 62 * MiB, WS_WSHD = 66 * MiB, WS_WPLE = 68 * MiB, WS_WPG = 70 * MiB, WS_PBF = 78 * MiB;
constexpr size_t WS_SMALL = 86 * MiB;
constexpr size_t WS_RSTDQ = WS_SMALL, WS_RSTDKV = WS_SMALL + 65536, WS_RSTDP = WS_SMALL + 2 * 65536, WS_BONUS = WS_SMALL + 3 * 65536;
constexpr size_t WS_EIDX = WS_SMALL + 2 * MiB, WS_WTS = WS_EIDX + 512 * 1024, WS_POS = WS_WTS + 512 * 1024, WS_SLOT = WS_POS + 512 * 1024;
constexpr size_t WS_ROWTOK = WS_SMALL + 4 * MiB, WS_ROWW = WS_ROWTOK + 640 * 1024, WS_TILEE = WS_ROWW + 640 * 1024;
constexpr size_t WS_GATES = 92 * MiB, WS_OM = 220 * MiB, WS_AA = 252 * MiB, WS_GG = 284 * MiB;
constexpr size_t WS_R = 636 * MiB, WS_KP = 668 * MiB, WS_KK = 812 * MiB, WS_BB = 968 * MiB, WS_VB = 444 * MiB, WS_RECB = 316 * MiB  , WS_YDBG = 1020 * MiB  , WS_QF = 476 * MiB, WS_KF = 524 * MiB, WS_VTF = 572 * MiB;
constexpr size_t WS_Y = 604 * MiB, WS_OB = 252 * MiB  , WS_OA = 316 * MiB  , WS_MERGED = 476 * MiB  , WS_MERGED8 = 540 * MiB  ;
constexpr size_t WS_WEG = 636 * MiB, WS_WED = 892 * MiB, WS_H2F8 = 764 * MiB;
constexpr size_t WS_H = 636 * MiB, WS_RKV = 700 * MiB, WS_MISC = 796 * MiB, WS_CQKV = 812 * MiB, WS_L = 844 * MiB, WS_QRAW = 856 * MiB, WS_KVRAW = 904 * MiB;
constexpr size_t WS_H2 = 92 * MiB, WS_LOGIT = 220 * MiB  , WS_ACTSH = 252 * MiB, WS_ACT = 268 * MiB, WS_PLERAW = 412 * MiB;
constexpr size_t WS_YSH = 92 * MiB  ;
constexpr size_t WS_Y2 = 92 * MiB, WS_Y2B = 476 * MiB, WS_XN3 = 268 * MiB;
constexpr int Y2A_TILES = 176;
constexpr float ACT8_SCALE = 8.f, W8_SCALE = 64.f;
constexpr float O8_SCALE = 4.f;
constexpr float Y8_SCALE = 8.f;
constexpr size_t WS_END = 1020 * MiB;
static_assert(WS_AA == WS_OM + 32 * MiB && WS_GG == WS_AA + 32 * MiB && WS_ACT + (size_t)PMAX * 512 * 2 <= WS_PLERAW && WS_Y2 + (size_t)Y2A_TILES * MiB <= WS_ACT && WS_Y2B + (size_t)(PMAX / 256 - Y2A_TILES) * MiB <= WS_WED
              && WS_PLERAW + 64 * MiB <= WS_Y2B && WS_KVRAW + 64 * MiB <= WS_END, "ws map");
constexpr int CW_BAR = 4096, CW_CNT = 65536, CW_ATTQ = 66560, CW_CVQ = 67072, CW_CVH = 67136, CW_DBG = 67200;
#ifndef CHUNKED
#define CHUNKED 1
#endif
#ifndef CHUNK_DEBUG
#define CHUNK_DEBUG 0
#endif
#ifndef DBG_GAIN
#define DBG_GAIN 30.0f
#endif
#ifndef DBG_TMAX
#define DBG_TMAX 8192
#endif

constexpr int RING_BYTES = 131072, LDSCTL_OFF = RING_BYTES, LDS_BYTES = 147456;

#define LDS_WAIT() asm volatile("s_waitcnt lgkmcnt(0)" ::: "memory")
#define VM_WAIT() asm volatile("s_waitcnt vmcnt(0)" ::: "memory")
__device__ __forceinline__ unsigned f2bf(float f) { unsigned u = __builtin_bit_cast(unsigned, f); return (u + 0x7fffu + ((u >> 16) & 1u)) >> 16; }
__device__ __forceinline__ unsigned pk2(float lo, float hi) { return f2bf(lo) | (f2bf(hi) << 16); }
__device__ __forceinline__ int fbits(float x) { return __builtin_bit_cast(int, x); }
__device__ __forceinline__ float bf2f(unsigned b) { return __builtin_bit_cast(float, b << 16); }
__device__ __forceinline__ float bflo(unsigned w) { return __builtin_bit_cast(float, w << 16); }
__device__ __forceinline__ float bfhi(unsigned w) { return __builtin_bit_cast(float, w & 0xffff0000u); }
__device__ __forceinline__ unsigned cvt_pk_bf16(float lo, float hi) { unsigned r; asm volatile("v_cvt_pk_bf16_f32 %0, %1, %2" : "=v"(r) : "v"(lo), "v"(hi)); return r; }
__device__ __forceinline__ u32x4 pack8(f32x4 a, f32x4 b) { unsigned x, y, z, w;
    asm volatile("s_nop 0\n\tv_cvt_pk_bf16_f32 %0, %4, %5\n\tv_cvt_pk_bf16_f32 %1, %6, %7\n\tv_cvt_pk_bf16_f32 %2, %8, %9\n\tv_cvt_pk_bf16_f32 %3, %10, %11"
                 : "=&v"(x), "=&v"(y), "=&v"(z), "=&v"(w) : "v"(a[0]), "v"(a[1]), "v"(a[2]), "v"(a[3]), "v"(b[0]), "v"(b[1]), "v"(b[2]), "v"(b[3]));
    return (u32x4){x, y, z, w}; }
__device__ __forceinline__ void unpack8(u32x4 w, float (&v)[8]) { v[0] = bflo(w.x); v[1] = bfhi(w.x); v[2] = bflo(w.y); v[3] = bfhi(w.y); v[4] = bflo(w.z); v[5] = bfhi(w.z); v[6] = bflo(w.w); v[7] = bfhi(w.w); }
__device__ __forceinline__ unsigned pk4_fp8(f32x4 v) {
    const float a = __builtin_amdgcn_fmed3f(v[0], -448.f, 448.f), b = __builtin_amdgcn_fmed3f(v[1], -448.f, 448.f), c = __builtin_amdgcn_fmed3f(v[2], -448.f, 448.f), d = __builtin_amdgcn_fmed3f(v[3], -448.f, 448.f);
    int r = 0; r = __builtin_amdgcn_cvt_pk_fp8_f32(a, b, r, false); r = __builtin_amdgcn_cvt_pk_fp8_f32(c, d, r, true); return (unsigned)r; }
__device__ __forceinline__ float sigmoidf_(float x) { return __builtin_amdgcn_rcpf(1.0f + __expf(-x)); }
__device__ __forceinline__ float wave_sum(float v) {
#pragma unroll
    for (int o = 1; o < 64; o <<= 1) v += __shfl_xor(v, o);
    return v;
}

#define XB_TMO      128
#define XB_XCNT(j)  (256  + 64 * (j))
#define XB_XSUB(j)  (1280 + 64 * (j))
#define XB_XGEN(j)  (2304 + 64 * (j))
#define XB_TOP      3328
#define XB_TOPGEN   3392
#define XCD_BAR_WORDS 3456
#define XB_SPIN_CAP (1u << 22)
__device__ __forceinline__ unsigned xb_ld(unsigned* p)              { return __hip_atomic_load(p, __ATOMIC_RELAXED, __HIP_MEMORY_SCOPE_AGENT); }
__device__ __forceinline__ unsigned xb_add(unsigned* p, unsigned v) { return __hip_atomic_fetch_add(p, v, __ATOMIC_RELAXED, __HIP_MEMORY_SCOPE_AGENT); }
__device__ __forceinline__ unsigned xb_xcc_id() { return (unsigned)__builtin_amdgcn_s_getreg((3 << 11) | 20) & 0xFu; }
#define XB_SPIN(cond, bar) do { unsigned _sp = 0; while (cond) { __builtin_amdgcn_s_sleep(1); \
    if ((++_sp & 255u) == 0u) { if (xb_ld(&(bar)[XB_TMO])) break; if (_sp > XB_SPIN_CAP) { atomicAdd(&(bar)[XB_TMO], 1u); break; } } } } while (0)
struct XcdBarrier { unsigned* bar; unsigned x; volatile LAS unsigned* st; };
__device__ __forceinline__ XcdBarrier xcd_barrier_post(unsigned* bar, volatile LAS unsigned* st) {
    XcdBarrier b; b.bar = bar; b.x = xb_xcc_id(); b.st = st;
    if (threadIdx.x == 0) (void)xb_add(&bar[XB_XCNT(b.x)], 1u);
    return b;
}
__device__ __forceinline__ void xcd_barrier_complete(unsigned* bar, unsigned x, unsigned& nloc, unsigned& nx) {
    const unsigned G = gridDim.x * gridDim.y * gridDim.z;
    unsigned sum, cnt, mine, sp = 0u;
    for (;;) {
        sum = 0u; cnt = 0u; mine = 0u;
#pragma unroll
        for (unsigned j = 0; j < 16; ++j) { const unsigned c = xb_ld(&bar[XB_XCNT(j)]); sum += c; cnt += (c > 0u) ? 1u : 0u; mine = (j == x) ? c : mine; }
        if (sum == G) break;
        __builtin_amdgcn_s_sleep(1);
        if ((++sp & 255u) == 0u) { if (xb_ld(&bar[XB_TMO])) break; if (sp > XB_SPIN_CAP) { atomicAdd(&bar[XB_TMO], 1u); break; } }
    }
    nloc = mine > 0u ? mine : 1u; nx = cnt > 0u ? cnt : 1u;
}
__device__ __forceinline__ void xcd_barrier(const XcdBarrier& b) {
    asm volatile("s_waitcnt vmcnt(0)" ::: "memory");
    __syncthreads();
    if (threadIdx.x == 0) {
        unsigned* bar = b.bar;
        __builtin_amdgcn_s_waitcnt(0);
        unsigned nloc = b.st[0], nx = b.st[1];
        if (nloc == 0u) { xcd_barrier_complete(bar, b.x, nloc, nx); b.st[0] = nloc; b.st[1] = nx; }
        const unsigned old = xb_add(&bar[XB_XSUB(b.x)], 1u);
        const unsigned gen = old / nloc;
        if (old + 1u == (gen + 1u) * nloc) {
            __builtin_amdgcn_fence(__ATOMIC_RELEASE, "agent");
            asm volatile("s_waitcnt vmcnt(0)" ::: "memory");
            const unsigned og = xb_add(&bar[XB_TOP], 1u);
            const unsigned tg = og / nx;
            if (og + 1u == (tg + 1u) * nx) xb_add(&bar[XB_TOPGEN], 1u);
            else XB_SPIN(xb_ld(&bar[XB_TOPGEN]) == tg, bar);
            __builtin_amdgcn_fence(__ATOMIC_ACQUIRE, "agent");
            xb_add(&bar[XB_XGEN(b.x)], 1u);
            asm volatile("s_waitcnt vmcnt(0)" ::: "memory");
        } else {
            XB_SPIN(xb_ld(&bar[XB_XGEN(b.x)]) == gen, bar);
            __builtin_amdgcn_fence(__ATOMIC_ACQUIRE, "agent");
            asm volatile("s_waitcnt vmcnt(0)" ::: "memory");
        }
    }
    __syncthreads();
}

namespace pg8 {
constexpr int BM = 256, BK = 64, HALF = 128, HTB = HALF * BK * 2, STAGE_BYTES = 8 * HTB, NXCD = 8, WGM = 4;
__host__ __device__ __forceinline__ int lds_byte(int r, int c) { const int st = (r >> 4) * 2 + (c >> 5), rr = r & 15, cc = c & 31, ob = rr * 64 + cc * 2; return st * 1024 + (ob ^ (((ob >> 9) & 1) << 5)); }
__host__ __device__ __forceinline__ void stage_rc(int b, int& R, int& C) { const int st = b / 1024, sb = b % 1024, swz = sb ^ (((sb >> 9) & 1) << 5); R = (st >> 1) * 16 + swz / 64; C = (st & 1) * 32 + (swz % 64) / 2; }
__host__ __device__ __forceinline__ int perm32(int rho) { const int n = rho >> 4, i = rho & 15; return 8 * (i >> 2) + 4 * n + (i & 3); }

struct Unit { int pm, pn, pb, ko; };
struct Gemm { const bf16_t* A; const bf16_t* Bt; int lda, K, ldb; int sa, sb; };

struct DenseOrder {
    int nM, nN, nwg, G, c;
    __device__ void init(int nM_, int nN_, int G_, int c_) { nM = nM_; nN = nN_; nwg = nM * nN; G = G_; c = c_; }
    __device__ bool next(int i, Unit& u) const { return map((long)i * G + c, u); }
    __device__ bool map(long L, Unit& u) const {
        if (L >= nwg) return false;
        int wgid = (int)L; { const int q = nwg / NXCD, r = nwg % NXCD, xcd = wgid % NXCD, off = wgid / NXCD; wgid = (xcd < r ? xcd * (q + 1) : r * (q + 1) + (xcd - r) * q) + off; }
        const int nig = WGM * nN, gid = wgid / nig, fm = gid * WGM, gsz = (nM - fm) < WGM ? (nM - fm) : WGM;
        u.pm = fm + ((wgid % nig) % gsz); u.pn = (wgid % nig) / gsz; u.pb = u.pn; u.ko = 0; return true;
    }
    __device__ const int* rows(const Unit&) const { return nullptr; }
};
struct DenseOrderTail {
    DenseOrder d; int lo, hi;
    __device__ bool next(int i, Unit& u) const { const int h = d.G >> 1;
        if (i < lo) return d.map((long)i * d.G + d.c, u);
        if (d.c >= h && i < lo + hi) return d.map((long)lo * d.G + (long)(i - lo) * h + (d.c - h), u);
        return false; }
    __device__ const int* rows(const Unit&) const { return nullptr; }
};
struct RouterOrder {
    int G, c;
    __device__ bool next(int i, Unit& u) const { const int L = i * G + c; if (L >= 256) return false; u.pm = L >> 2; u.pn = L & 3; u.pb = 0; u.ko = (L & 3) * 1024; return true; }
    __device__ const int* rows(const Unit&) const { return nullptr; }
};
struct MoeOrder {
    int tile0, ntiles, npn, G, c; const int* tile_e; const int* row_tok;
    __device__ bool next(int i, Unit& u) const {
        const long L = (long)i * G + c; if (L >= (long)ntiles * npn) return false;
        const int tl = (int)L / npn, pn = (int)L % npn; u.pm = tile0 + tl; u.pn = pn; u.pb = tile_e[tile0 + tl] * npn + pn; u.ko = 0; return true;
    }
    __device__ const int* rows(const Unit& u) const { return row_tok + (size_t)u.pm * 256; }
};

#define PG8_EPI_ARGS const f32x4 (&acc)[2][2][4][2], const Unit& u, int wr, int wc, int fr, int fq

typedef int i32x4_ __attribute__((ext_vector_type(4))); typedef int i32x8_ __attribute__((ext_vector_type(8)));
template <class Epi, class Sched, bool GATHER, bool FP8 = false>
__device__ __forceinline__ void gemm_phase(LAS unsigned char* lds, const Gemm g, const Sched& S, const Epi& E, const int tid) {
    const int wid = __builtin_amdgcn_readfirstlane(tid >> 6), lane = tid & 63, wr = wid >> 2, wc = wid & 3, fr = lane & 15, fq = lane >> 4;
    const int K = g.K, nt = K / BK, lda = g.lda;
    unsigned voffB[2], va[2][2], vn[2][2]; int RA[2], CA[2];
#pragma unroll
    for (int i = 0; i < 2; ++i) { int R, C; stage_rc(tid * 16 + i * 8192, R, C); const int Rb = 64 * (R >> 5) + (Epi::PERM == 1 ? (R & 31) : Epi::PERM == 2 ? 16 * ((R & 15) >> 2) + 4 * ((R >> 4) & 1) + (R & 3) : perm32(R & 31)); RA[i] = R; CA[i] = C; voffB[i] = (unsigned)(Rb * g.ldb + C) * 2u; }
    const size_t kstep = (size_t)(BK * 2);
    const size_t hstepB = (size_t)(Epi::PERM == 2 ? 8 : 32) * g.ldb * 2, tstepB = (size_t)BM * g.ldb * 2, tstepA = (size_t)BM * lda * 2;
    const unsigned ldsw = (unsigned)wid * 1024u;
    const int aoff = lds_byte(wr * 64 + fr, fq * 8), boff = lds_byte(wc * 32 + fr, fq * 8);
#define PG8_SA(b, h) (((b) * 2 + (h)) * HTB)
#define PG8_SB(b, h) ((4 + (b) * 2 + (h)) * HTB)
#define PG8_STAGEB(bufoff, gbase) do { _Pragma("unroll") for (int _i = 0; _i < 2; ++_i) \
        __builtin_amdgcn_global_load_lds((const unsigned*)((const char*)(gbase) + voffB[_i]), (LAS unsigned*)(lds + (bufoff) + ldsw + _i * 8192), 16, 0, 0); } while (0)
#define PG8_STAGEA(bufoff, gbase, offs, h) do { _Pragma("unroll") for (int _i = 0; _i < 2; ++_i) \
        __builtin_amdgcn_global_load_lds((const unsigned*)((const char*)(gbase) + (offs)[h][_i]), (LAS unsigned*)(lds + (bufoff) + ldsw + _i * 8192), 16, 0, 0); } while (0)
#define PG8_LDA(dst, b, h) do { if constexpr (FP8) { _Pragma("unroll") for (int m = 0; m < 4; ++m) { const i32x4_ _lo = *(const LAS i32x4_*)(lds + PG8_SA(b, h) + aoff + m * 2048), _hi = *(const LAS i32x4_*)(lds + PG8_SA(b, h) + aoff + m * 2048 + 1024); \
            dst##8[m] = __builtin_shufflevector(_lo, _hi, 0, 1, 2, 3, 4, 5, 6, 7); } } \
        else { _Pragma("unroll") for (int m = 0; m < 4; ++m) _Pragma("unroll") for (int k = 0; k < 2; ++k) dst[m][k] = *(const LAS bf16x8*)(lds + PG8_SA(b, h) + aoff + m * 2048 + k * 1024); } } while (0)
#define PG8_LDB(dst, b, h) do { if constexpr (FP8) { _Pragma("unroll") for (int n = 0; n < 2; ++n) { const i32x4_ _lo = *(const LAS i32x4_*)(lds + PG8_SB(b, h) + boff + n * 2048), _hi = *(const LAS i32x4_*)(lds + PG8_SB(b, h) + boff + n * 2048 + 1024); \
            dst##8[n] = __builtin_shufflevector(_lo, _hi, 0, 1, 2, 3, 4, 5, 6, 7); } } \
        else { _Pragma("unroll") for (int n = 0; n < 2; ++n) _Pragma("unroll") for (int k = 0; k < 2; ++k) dst[n][k] = *(const LAS bf16x8*)(lds + PG8_SB(b, h) + boff + n * 2048 + k * 1024); } } while (0)
#define PG8_MMA(ai, bj, At, Bt) do { __builtin_amdgcn_s_setprio(1); \
        if constexpr (FP8) { _Pragma("unroll") for (int m = 0; m < 4; ++m) _Pragma("unroll") for (int n = 0; n < 2; ++n) \
            asm volatile("v_mfma_scale_f32_16x16x128_f8f6f4 %0, %1, %2, %0, %3, %4 op_sel_hi:[0,0,0]" : "+v"(acc[ai][bj][m][n]) : "v"(Bt##8[n]), "v"(At##8[m]), "v"(sbv), "v"(sav)); } \
        else { _Pragma("unroll") for (int m = 0; m < 4; ++m) _Pragma("unroll") for (int n = 0; n < 2; ++n) _Pragma("unroll") for (int k = 0; k < 2; ++k) \
            acc[ai][bj][m][n] = __builtin_amdgcn_mfma_f32_16x16x32_bf16(Bt[n][k], At[m][k], acc[ai][bj][m][n], 0, 0, 0); } \
        __builtin_amdgcn_s_setprio(0); } while (0)
#define PG8_WAIT_V(n) asm volatile("s_waitcnt vmcnt(" #n ")" ::: "memory")
#define PG8_WAIT_L(n) asm volatile("s_waitcnt lgkmcnt(" #n ")" ::: "memory")
#define PG8_BAR __builtin_amdgcn_s_barrier()
#define PG8_SCHED __builtin_amdgcn_sched_barrier(0)
    Unit cur, nxt, nx2; int ui = 0; bool hn = false, hn2 = false; unsigned xq[2][2] = {{0u, 0u}, {0u, 0u}}, xq2[2][2] = {{0u, 0u}, {0u, 0u}}; (void)nx2; (void)hn; (void)hn2; (void)xq; (void)xq2;
    if (!S.next(0, cur)) return;
    f32x4 acc[2][2][4][2];
#pragma unroll
    for (int a = 0; a < 2; ++a)
#pragma unroll
        for (int b = 0; b < 2; ++b)
#pragma unroll
            for (int m = 0; m < 4; ++m)
#pragma unroll
                for (int n = 0; n < 2; ++n) acc[a][b][m][n] = (f32x4){0.f, 0.f, 0.f, 0.f};
    const int sav = g.sa, sbv = g.sb; (void)sav; (void)sbv;
    bf16x8 At[4][2], B0[2][2], B1[2][2]; i32x8_ At8[4], B08[2], B18[2]; (void)At; (void)B0; (void)B1; (void)At8; (void)B08; (void)B18;
    const char* cA; const char* cB = (const char*)g.Bt + (size_t)cur.pb * tstepB + (size_t)cur.ko * 2;
    if constexpr (GATHER) {
        const int* rw = S.rows(cur); cA = (const char*)g.A;
#pragma unroll
        for (int h = 0; h < 2; ++h)
#pragma unroll
            for (int i = 0; i < 2; ++i) { unsigned x = (unsigned)rw[h * HALF + RA[i]]; asm volatile("s_waitcnt vmcnt(0)" : "+v"(x) :: "memory"); va[h][i] = (x * (unsigned)lda + (unsigned)CA[i]) * 2u; }
    } else {
        cA = (const char*)g.A + (size_t)cur.pm * tstepA + (size_t)cur.ko * 2;
#pragma unroll
        for (int h = 0; h < 2; ++h)
#pragma unroll
            for (int i = 0; i < 2; ++i) va[h][i] = (unsigned)((h * HALF + RA[i]) * lda + CA[i]) * 2u;
    }
#pragma unroll
    for (int h = 0; h < 2; ++h)
#pragma unroll
        for (int i = 0; i < 2; ++i) vn[h][i] = va[h][i];
    if constexpr (GATHER) {
        hn = S.next(1, nxt);
        if (hn) { const int* rw = S.rows(nxt);
#pragma unroll
            for (int h = 0; h < 2; ++h)
#pragma unroll
                for (int i = 0; i < 2; ++i) xq[h][i] = (unsigned)rw[h * HALF + RA[i]]; }
    }
    PG8_STAGEB(PG8_SB(0, 0), cB); PG8_STAGEB(PG8_SB(0, 1), cB + hstepB); PG8_STAGEA(PG8_SA(0, 0), cA, va, 0); PG8_STAGEA(PG8_SA(0, 1), cA, va, 1);
    if (wr == 1) PG8_BAR;
    PG8_WAIT_V(2); PG8_BAR;
    PG8_STAGEB(PG8_SB(1, 0), cB + kstep); PG8_STAGEA(PG8_SA(1, 0), cA + kstep, va, 0); PG8_STAGEB(PG8_SB(1, 1), cB + hstepB + kstep);
    PG8_WAIT_V(6); PG8_BAR;
    for (;;) {
        bool has_next;
        if constexpr (GATHER) has_next = hn; else has_next = S.next(ui + 1, nxt);
        const char* nA; const char* nB = has_next ? (const char*)g.Bt + (size_t)nxt.pb * tstepB + (size_t)nxt.ko * 2 : cB;
        if constexpr (GATHER) {
            nA = cA;
            if (has_next) {
#pragma unroll
                for (int h = 0; h < 2; ++h)
#pragma unroll
                    for (int i = 0; i < 2; ++i) vn[h][i] = (xq[h][i] * (unsigned)lda + (unsigned)CA[i]) * 2u; }
            hn2 = has_next && S.next(ui + 2, nx2);
            if (hn2) { const int* rw = S.rows(nx2);
#pragma unroll
                for (int h = 0; h < 2; ++h)
#pragma unroll
                    for (int i = 0; i < 2; ++i) xq2[h][i] = (unsigned)rw[h * HALF + RA[i]]; }
        } else {
            nA = has_next ? (const char*)g.A + (size_t)nxt.pm * tstepA + (size_t)nxt.ko * 2 : cA;
        }
#pragma unroll 1
        for (int t = 0; t < nt; t += 2) {
            const bool last = (t == nt - 2);
            const char* a1 = cA + (size_t)(t + 1) * kstep;
            const char* a2 = last ? nA : cA + (size_t)(t + 2) * kstep; const char* b2 = last ? nB : cB + (size_t)(t + 2) * kstep;
            const char* a3 = a2 + kstep; const char* b3 = b2 + kstep;
            unsigned v2[2][2];
#pragma unroll
            for (int h = 0; h < 2; ++h)
#pragma unroll
                for (int i = 0; i < 2; ++i) v2[h][i] = GATHER ? (last ? vn[h][i] : va[h][i]) : va[h][i];
            PG8_LDB(B0, 0, 0); PG8_LDB(B1, 0, 1); PG8_SCHED; PG8_LDA(At, 0, 0); PG8_STAGEA(PG8_SA(1, 1), a1, va, 1);
            PG8_WAIT_V(8); PG8_WAIT_L(0); PG8_BAR; PG8_MMA(0, 0, At, B0); PG8_MMA(0, 1, At, B1); PG8_BAR; PG8_SCHED;
            PG8_LDA(At, 0, 1); PG8_STAGEB(PG8_SB(0, 0), b2); PG8_STAGEB(PG8_SB(0, 1), b2 + hstepB); PG8_STAGEA(PG8_SA(0, 0), a2, v2, 0);
            PG8_WAIT_V(8); PG8_WAIT_L(0); PG8_BAR; PG8_MMA(1, 0, At, B0); PG8_MMA(1, 1, At, B1); PG8_BAR; PG8_SCHED;
            PG8_LDB(B0, 1, 0); PG8_LDB(B1, 1, 1); PG8_SCHED; PG8_LDA(At, 1, 0); PG8_STAGEA(PG8_SA(0, 1), a2, v2, 1);
            PG8_WAIT_V(8); PG8_WAIT_L(0); PG8_BAR; PG8_MMA(0, 0, At, B0); PG8_MMA(0, 1, At, B1); PG8_BAR; PG8_SCHED;
            PG8_LDA(At, 1, 1); PG8_STAGEB(PG8_SB(1, 0), b3); PG8_STAGEB(PG8_SB(1, 1), b3 + hstepB); PG8_STAGEA(PG8_SA(1, 0), a3, v2, 0);
            PG8_WAIT_V(8); PG8_WAIT_L(0); PG8_BAR; PG8_MMA(1, 0, At, B0); PG8_MMA(1, 1, At, B1); PG8_BAR; PG8_SCHED;
        }
        if constexpr (FP8) {
            asm volatile("s_nop 7\n\ts_nop 7" : "+v"(acc[0][0][0][0]), "+v"(acc[0][0][0][1]), "+v"(acc[0][0][1][0]), "+v"(acc[0][0][1][1]), "+v"(acc[0][0][2][0]), "+v"(acc[0][0][2][1]), "+v"(acc[0][0][3][0]), "+v"(acc[0][0][3][1]), "+v"(acc[0][1][0][0]), "+v"(acc[0][1][0][1]), "+v"(acc[0][1][1][0]), "+v"(acc[0][1][1][1]), "+v"(acc[0][1][2][0]), "+v"(acc[0][1][2][1]), "+v"(acc[0][1][3][0]), "+v"(acc[0][1][3][1]));
            asm volatile("" : "+v"(acc[1][0][0][0]), "+v"(acc[1][0][0][1]), "+v"(acc[1][0][1][0]), "+v"(acc[1][0][1][1]), "+v"(acc[1][0][2][0]), "+v"(acc[1][0][2][1]), "+v"(acc[1][0][3][0]), "+v"(acc[1][0][3][1]), "+v"(acc[1][1][0][0]), "+v"(acc[1][1][0][1]), "+v"(acc[1][1][1][0]), "+v"(acc[1][1][1][1]), "+v"(acc[1][1][2][0]), "+v"(acc[1][1][2][1]), "+v"(acc[1][1][3][0]), "+v"(acc[1][1][3][1])); }
        if (wr == 0) PG8_BAR;
        E(acc, cur, wr, wc, fr, fq);
        if (!has_next) break;
#pragma unroll
        for (int a = 0; a < 2; ++a)
#pragma unroll
            for (int b = 0; b < 2; ++b)
#pragma unroll
                for (int m = 0; m < 4; ++m)
#pragma unroll
                    for (int n = 0; n < 2; ++n) acc[a][b][m][n] = (f32x4){0.f, 0.f, 0.f, 0.f};
        cur = nxt; cA = nA; cB = nB; ++ui;
        if constexpr (GATHER) {
#pragma unroll
            for (int h = 0; h < 2; ++h)
#pragma unroll
                for (int i = 0; i < 2; ++i) { va[h][i] = vn[h][i]; xq[h][i] = xq2[h][i]; }
            nxt = nx2; hn = hn2;
        }
        if (wr == 1) PG8_BAR;
    }
    PG8_WAIT_V(0);
    PG8_BAR;
#undef PG8_SA
#undef PG8_SB
#undef PG8_STAGEA
#undef PG8_STAGEB
#undef PG8_LDA
#undef PG8_LDB
#undef PG8_MMA
#undef PG8_WAIT_V
#undef PG8_WAIT_L
#undef PG8_BAR
#undef PG8_SCHED
}

#define EPI_COLF(bj, n) (wc * 64 + (bj) * 32 + (n) * 16 + 4 * fq)
#define EPI_ROW(ai, m) (u.pm * 256 + (ai) * 128 + wr * 64 + (m) * 16 + fr)
#define EPI_COLT(bj) (wc * 64 + (bj) * 32 + 8 * fq)
struct EpiProj {
    static constexpr int PERM = 0;
    bf16_t *rkv, *misc, *cqkv, *gates;
    __device__ __forceinline__ void operator()(PG8_EPI_ARGS) const {
        const int pn = u.pn; bf16_t* dst; int ldc, ct; bool sig = false;
        if (pn < 12) { dst = rkv; ldc = 3072; ct = pn; } else if (pn < 14) { dst = misc; ldc = 512; ct = pn - 12; } else if (pn < 18) { dst = cqkv; ldc = 1024; ct = pn - 14; } else { dst = gates; ldc = 4096; ct = pn - 18; sig = true; }
#pragma unroll
        for (int ai = 0; ai < 2; ++ai)
#pragma unroll
            for (int m = 0; m < 4; ++m) { bf16_t* rowp = dst + (size_t)EPI_ROW(ai, m) * ldc + ct * 256;
#pragma unroll
                for (int bj = 0; bj < 2; ++bj) { f32x4 v0 = acc[ai][bj][m][0], v1 = acc[ai][bj][m][1];
                    if (sig) {
#pragma unroll
                        for (int e = 0; e < 4; ++e) { v0[e] = sigmoidf_(v0[e]); v1[e] = sigmoidf_(v1[e]); } }
                    *(u32x4*)(rowp + EPI_COLT(bj)) = pack8(v0, v1); } }
    }
};
struct EpiGates {
    static constexpr int PERM = 0;
    bf16_t* gates;
    __device__ __forceinline__ void operator()(PG8_EPI_ARGS) const {
#pragma unroll
        for (int ai = 0; ai < 2; ++ai)
#pragma unroll
            for (int m = 0; m < 4; ++m) { bf16_t* rowp = gates + (size_t)EPI_ROW(ai, m) * 4096 + u.pn * 256;
#pragma unroll
                for (int bj = 0; bj < 2; ++bj) { f32x4 v0 = acc[ai][bj][m][0], v1 = acc[ai][bj][m][1];
#pragma unroll
                    for (int e = 0; e < 4; ++e) { v0[e] = sigmoidf_(v0[e]); v1[e] = sigmoidf_(v1[e]); }
                    *(u32x4*)(rowp + EPI_COLT(bj)) = pack8(v0, v1); } }
    }
};
struct EpiLora {
    static constexpr int PERM = 0;
    bf16_t *om, *aa, *gg; const float *w0, *a0;
    __device__ __forceinline__ void operator()(PG8_EPI_ARGS) const {
        const int pn = u.pn; const int kind = pn >> 2, ct = pn & 3; bf16_t* dst = om + (size_t)kind * ((size_t)T * 1024);
#pragma unroll
        for (int bj = 0; bj < 2; ++bj) {
            const f32x4 bw0 = *(const f32x4*)(w0 + ct * 256 + EPI_COLT(bj)), bw1 = *(const f32x4*)(w0 + ct * 256 + EPI_COLT(bj) + 4);
            const f32x4 ba0 = *(const f32x4*)(a0 + ct * 256 + EPI_COLT(bj)), ba1 = *(const f32x4*)(a0 + ct * 256 + EPI_COLT(bj) + 4);
            const float sw = kind == 0 ? 1.f : 0.f, sa = kind == 1 ? 1.f : 0.f;
            const f32x4 b0 = bw0 * sw + ba0 * sa, b1 = bw1 * sw + ba1 * sa;
#pragma unroll
            for (int ai = 0; ai < 2; ++ai)
#pragma unroll
                for (int m = 0; m < 4; ++m) {
                    f32x4 v0 = acc[ai][bj][m][0] + b0, v1 = acc[ai][bj][m][1] + b1;
                    if (kind == 0) {
#pragma unroll
                        for (int e = 0; e < 4; ++e) {
                            { const float y = -v0[e]; const float sp = fmaxf(y, 0.f) + __logf(1.0f + __expf(-fabsf(y))); const float ew = __expf(-sp - 0.5f); v0[e] = 1.0f - __expf(-ew); }
                            { const float y = -v1[e]; const float sp = fmaxf(y, 0.f) + __logf(1.0f + __expf(-fabsf(y))); const float ew = __expf(-sp - 0.5f); v1[e] = 1.0f - __expf(-ew); } }
                    } else if (kind == 1) {
#pragma unroll
                        for (int e = 0; e < 4; ++e) { v0[e] = sigmoidf_(v0[e]); v1[e] = sigmoidf_(v1[e]); }
                    }
                    *(u32x4*)(dst + (size_t)EPI_ROW(ai, m) * 1024 + ct * 256 + EPI_COLT(bj)) = pack8(v0, v1);
                    __builtin_amdgcn_sched_barrier(0);
                }
        }
    }
};
struct EpiRowScale {
    static constexpr int PERM = 0;
    bf16_t* dst; int ldc; const float* rs;
    __device__ __forceinline__ void operator()(PG8_EPI_ARGS) const {
#pragma unroll
        for (int ai = 0; ai < 2; ++ai)
#pragma unroll
            for (int m = 0; m < 4; ++m) { const int row = EPI_ROW(ai, m); const float s = rs ? rs[row] : 1.0f; bf16_t* rowp = dst + (size_t)row * ldc + u.pn * 256;
#pragma unroll
                for (int bj = 0; bj < 2; ++bj) *(u32x4*)(rowp + EPI_COLT(bj)) = pack8(acc[ai][bj][m][0] * s, acc[ai][bj][m][1] * s); }
    }
};
template <int ACCUM> struct EpiMerge {
    static constexpr int PERM = 0;
    bf16_t* merged; const bf16_t* gates; int goff; unsigned char* merged8;
    __device__ __forceinline__ void operator()(PG8_EPI_ARGS) const {
#pragma unroll
        for (int ai = 0; ai < 2; ++ai)
#pragma unroll
            for (int m = 0; m < 4; ++m) { const int row = EPI_ROW(ai, m);
#pragma unroll
                for (int bj = 0; bj < 2; ++bj) { const int col = u.pn * 256 + EPI_COLT(bj);
                    float gv[8]; unpack8(*(const u32x4*)(gates + (size_t)row * 4096 + goff + col), gv);
                    f32x4 v0 = acc[ai][bj][m][0], v1 = acc[ai][bj][m][1];
                    bf16_t* p = merged + (size_t)row * 2048 + col;
                    float ov[8];
                    if (ACCUM) unpack8(*(const u32x4*)p, ov);
#pragma unroll
                    for (int e = 0; e < 4; ++e) { v0[e] = v0[e] * gv[e] + (ACCUM ? ov[e] : 0.f); v1[e] = v1[e] * gv[4 + e] + (ACCUM ? ov[4 + e] : 0.f); }
                    if (ACCUM) { u32x2 w8; w8.x = pk4_fp8(v0 * O8_SCALE); w8.y = pk4_fp8(v1 * O8_SCALE); *(u32x2*)(merged8 + (size_t)row * 2048 + col) = w8; }
                    else *(u32x4*)p = pack8(v0, v1); } }
    }
};
struct EpiResid {
    static constexpr int PERM = 1;
    const float* base; float* out;
    __device__ __forceinline__ void operator()(PG8_EPI_ARGS) const {
#pragma unroll
        for (int ai = 0; ai < 2; ++ai)
#pragma unroll
            for (int m = 0; m < 4; ++m) { const size_t ro = (size_t)EPI_ROW(ai, m) * 2048 + u.pn * 256;
#pragma unroll
                for (int bj = 0; bj < 2; ++bj)
#pragma unroll
                    for (int n = 0; n < 2; ++n) { const size_t o = ro + EPI_COLF(bj, n); *(f32x4*)(out + o) = *(const f32x4*)(base + o) + acc[ai][bj][m][n]; } }
    }
};
struct EpiLogit {
    static constexpr int PERM = 0;
    float* logit;
    __device__ __forceinline__ void operator()(PG8_EPI_ARGS) const {
#pragma unroll
        for (int ai = 0; ai < 2; ++ai)
#pragma unroll
            for (int m = 0; m < 4; ++m) { float* rowp = logit + (size_t)u.pn * ((size_t)T * 128) + (size_t)EPI_ROW(ai, m) * 128;
                if (wc < 2) {
#pragma unroll
                    for (int bj = 0; bj < 2; ++bj)
#pragma unroll
                        for (int n = 0; n < 2; ++n) *(f32x4*)(rowp + EPI_COLT(bj) + 4 * n) = acc[ai][bj][m][n]; } }
    }
};
struct EpiSwiglu {
    static constexpr int PERM = 0;
    bf16_t* act;
    __device__ __forceinline__ void operator()(PG8_EPI_ARGS) const {
#pragma unroll
        for (int ai = 0; ai < 2; ++ai)
#pragma unroll
            for (int m = 0; m < 4; ++m) { f32x4 v[2];
#pragma unroll
                for (int n = 0; n < 2; ++n)
#pragma unroll
                    for (int e = 0; e < 4; ++e) { const float gx = acc[ai][0][m][n][e]; v[n][e] = gx * sigmoidf_(gx) * acc[ai][1][m][n][e]; }
                *(u32x4*)(act + (size_t)EPI_ROW(ai, m) * 512 + u.pn * 128 + wc * 32 + 8 * fq) = pack8(v[0], v[1]); }
    }
};
struct EpiSwiglu8 {
    static constexpr int PERM = 0;
    unsigned char* act8;
    __device__ __forceinline__ void operator()(PG8_EPI_ARGS) const {
#pragma unroll
        for (int ai = 0; ai < 2; ++ai)
#pragma unroll
            for (int m = 0; m < 4; ++m) { f32x4 v[2];
#pragma unroll
                for (int n = 0; n < 2; ++n)
#pragma unroll
                    for (int e = 0; e < 4; ++e) { const float gx = acc[ai][0][m][n][e]; v[n][e] = gx * sigmoidf_(gx) * acc[ai][1][m][n][e] * ACT8_SCALE; }
                u32x2 w; w.x = pk4_fp8(v[0]); w.y = pk4_fp8(v[1]);
                *(u32x2*)(act8 + (size_t)EPI_ROW(ai, m) * 512 + u.pn * 128 + wc * 32 + 8 * fq) = w; }
    }
};
struct EpiDown {
    static constexpr int PERM = 2;
    unsigned char* y8; const float* roww;
    __device__ __forceinline__ void operator()(PG8_EPI_ARGS) const {
#pragma unroll
        for (int ai = 0; ai < 2; ++ai)
#pragma unroll
            for (int m = 0; m < 4; ++m) { const int row = EPI_ROW(ai, m); const float s = Y8_SCALE;
                u32x4 w; w.x = pk4_fp8(acc[ai][0][m][0] * s); w.y = pk4_fp8(acc[ai][0][m][1] * s); w.z = pk4_fp8(acc[ai][1][m][0] * s); w.w = pk4_fp8(acc[ai][1][m][1] * s);
                *(u32x4*)(y8 + (size_t)row * 2048 + u.pn * 256 + wc * 64 + 16 * fq) = w; }
    }
};
struct EpiFinal {
    static constexpr int PERM = 1;
    float* out; const bf16_t* pleraw; const float* rstdp; const float* gpost; float dsc;
    __device__ __forceinline__ void operator()(PG8_EPI_ARGS) const {
        f32x4 gv[2][2];
#pragma unroll
        for (int bj = 0; bj < 2; ++bj)
#pragma unroll
            for (int n = 0; n < 2; ++n) gv[bj][n] = *(const f32x4*)(gpost + u.pn * 256 + EPI_COLF(bj, n));
#pragma unroll
        for (int ai = 0; ai < 2; ++ai)
#pragma unroll
            for (int m = 0; m < 4; ++m) { const int row = EPI_ROW(ai, m); const float rs = rstdp[row];
#pragma unroll
                for (int bj = 0; bj < 2; ++bj)
#pragma unroll
                    for (int n = 0; n < 2; ++n) { const size_t o = (size_t)row * 2048 + u.pn * 256 + EPI_COLF(bj, n);
                        const uint2 pw = *(const uint2*)(pleraw + o); const f32x4 pv = {__builtin_bit_cast(float, pw.x << 16), __builtin_bit_cast(float, pw.x & 0xffff0000u), __builtin_bit_cast(float, pw.y << 16), __builtin_bit_cast(float, pw.y & 0xffff0000u)};
                        f32x4 x = *(const f32x4*)(out + o), a = acc[ai][bj][m][n];
#pragma unroll
                        for (int e = 0; e < 4; ++e) x[e] += sigmoidf_(a[e]) * (pv[e] * rs * gv[bj][n][e]);
                        *(f32x4*)(out + o) = x * dsc; } }
    }
};
}

struct Args { const float* in[38]; const int* pos; float* out; unsigned char* ws; int ph_lo, ph_hi; };

struct Frame {
    LAS unsigned char* lds; unsigned* ctl; unsigned char* ws;
    int tid, lane, wave, vcu, G, gw, NGW;
};

__device__ __forceinline__ void conv_item(const float* src, int ld_src, int kvalid, const float* kscale, int mode, bf16_t* dst, int ld_dst, LAS float* scr, int lane, int jstep = 8) {
    const int rr = lane >> 3, c4 = (lane & 7) * 4;
    f32x4 v[8];
#pragma unroll
    for (int i = 0; i < 8; ++i) { const int kk = 8 * i + rr; v[i] = (f32x4){0.f, 0.f, 0.f, 0.f};
        if (kk < kvalid) { v[i] = *(const f32x4*)(src + (size_t)kk * ld_src + c4); if (kscale) v[i] = v[i] * kscale[kk]; } }
#pragma unroll
    for (int i = 0; i < 8; ++i) { LAS float* s = scr + (8 * i + rr) * 33 + c4; s[0] = v[i][0]; s[1] = v[i][1]; s[2] = v[i][2]; s[3] = v[i][3]; }
    LDS_WAIT(); asm volatile("" ::: "memory");
    const int c = lane & 7;
    if (8 * c < kvalid) {
#pragma unroll
        for (int j = 0; j < 4; ++j) { const int n = (lane >> 3) + 8 * j; const LAS float* s = scr + (8 * c) * 33 + n;
            float x[8];
#pragma unroll
            for (int e = 0; e < 8; ++e) { x[e] = s[e * 33]; if (mode == 1) x[e] = x[e] - bf2f(f2bf(x[e])); }
            u32x4 o; o.x = pk2(x[0], x[1]); o.y = pk2(x[2], x[3]); o.z = pk2(x[4], x[5]); o.w = pk2(x[6], x[7]);
            *(u32x4*)(dst + (size_t)((lane >> 3) + jstep * j) * ld_dst + 8 * c) = o; }
    }
    LDS_WAIT(); asm volatile("" ::: "memory");
}
__device__ __forceinline__ void conv_load(const float* src, int ld_src, int lane, f32x4 (&v)[8]) {
    const int rr = lane >> 3, c4 = (lane & 7) * 4;
#pragma unroll
    for (int i = 0; i < 8; ++i) v[i] = *(const f32x4*)(src + (size_t)(8 * i + rr) * ld_src + c4);
}
__device__ __forceinline__ void conv_store(const f32x4 (&v)[8], bf16_t* dst, int ld_dst, LAS float* scr, int lane, int jstep = 8) {
    const int rr = lane >> 3, c4 = (lane & 7) * 4;
#pragma unroll
    for (int i = 0; i < 8; ++i) { LAS float* s = scr + (8 * i + rr) * 33 + c4; s[0] = v[i][0]; s[1] = v[i][1]; s[2] = v[i][2]; s[3] = v[i][3]; }
    LDS_WAIT(); asm volatile("" ::: "memory");
    const int c = lane & 7;
#pragma unroll
    for (int j = 0; j < 4; ++j) { const int n = (lane >> 3) + 8 * j; const LAS float* s = scr + (8 * c) * 33 + n;
        u32x4 o; o.x = pk2(s[0], s[33]); o.y = pk2(s[66], s[99]); o.z = pk2(s[132], s[165]); o.w = pk2(s[198], s[231]);
        *(u32x4*)(dst + (size_t)((lane >> 3) + jstep * j) * ld_dst + 8 * c) = o; }
    LDS_WAIT(); asm volatile("" ::: "memory");
}
__device__ __forceinline__ void conv_store8(const f32x4 (&v)[8], unsigned char* dst8, int ld_dst, LAS float* scr, int lane, float scale) {
    const int rr = lane >> 3, c4 = (lane & 7) * 4;
#pragma unroll
    for (int i = 0; i < 8; ++i) { LAS float* s = scr + (8 * i + rr) * 33 + c4; s[0] = v[i][0]; s[1] = v[i][1]; s[2] = v[i][2]; s[3] = v[i][3]; }
    LDS_WAIT(); asm volatile("" ::: "memory");
    const int c = lane & 7;
#pragma unroll
    for (int j = 0; j < 4; ++j) { const int n = (lane >> 3) + 8 * j; const LAS float* s = scr + (8 * c) * 33 + n;
        u32x2 o; o.x = pk4_fp8((f32x4){s[0], s[33], s[66], s[99]} * scale); o.y = pk4_fp8((f32x4){s[132], s[165], s[198], s[231]} * scale);
        *(u32x2*)(dst8 + (size_t)n * ld_dst + 8 * c) = o; }
    LDS_WAIT(); asm volatile("" ::: "memory");
}
__device__ __forceinline__ void conv_item8(const float* src, int ld_src, unsigned char* dst8, int ld_dst, LAS float* scr, int lane, float scale) { f32x4 v[8]; conv_load(src, ld_src, lane, v); conv_store8(v, dst8, ld_dst, scr, lane, scale); }
#define CONV_JOB8X(src_, ld_src_, c0_, ncols_, K_, dst8_, ld_dst_, r0_, js_) { const int nnb_ = (ncols_) / 32, n_ = nnb_ * ((K_) / 64); \
    if (r < n_) { const int kb = r / nnb_, nb = r % nnb_; \
        conv_item8((src_) + (size_t)kb * 64 * (ld_src_) + (c0_) + nb * 32, (ld_src_), (unsigned char*)(dst8_) + (size_t)((r0_) + nb * 4 * (js_)) * (ld_dst_) + kb * 64, (ld_dst_), scr, lane, W8_SCALE); continue; } \
    r -= n_; }
#define CONV_JOB(src_, ld_src_, c0_, ncols_, K_, kscale_, mode_, dst_, ld_dst_, r0_, k0_) CONV_JOBX(src_, ld_src_, c0_, ncols_, K_, kscale_, mode_, dst_, ld_dst_, r0_, k0_, 8)
#define CONV_JOBX(src_, ld_src_, c0_, ncols_, K_, kscale_, mode_, dst_, ld_dst_, r0_, k0_, js_) { const int nnb_ = (ncols_) / 32, n_ = nnb_ * (((K_) + 63) / 64); \
    if (r < n_) { const int kb = r / nnb_, nb = r % nnb_; const int kv = ((K_) - kb * 64) < 64 ? ((K_) - kb * 64) : 64; const float* ks_ = (kscale_); \
        conv_item((src_) + (size_t)kb * 64 * (ld_src_) + (c0_) + nb * 32, (ld_src_), kv, ks_ ? ks_ + kb * 64 : nullptr, (mode_), (dst_) + (size_t)((r0_) + nb * 4 * (js_)) * (ld_dst_) + (k0_) + kb * 64, (ld_dst_), scr, lane); continue; } \
    r -= n_; }
__device__ __forceinline__ void conv_job(const Frame& F, LAS float* scr, const float* src, int ld_src, int c0, int ncols, int K, const float* kscale, int mode, bf16_t* dst, int ld_dst, int r0, int k0) {
    const int nkb = (K + 63) / 64, nnb = ncols / 32, items = nkb * nnb;
    for (int it = F.gw; it < items; it += F.NGW) { const int kb = it / nnb, nb = it % nnb; const int kv = (K - kb * 64) < 64 ? (K - kb * 64) : 64;
        conv_item(src + (size_t)kb * 64 * ld_src + c0 + nb * 32, ld_src, kv, kscale ? kscale + kb * 64 : nullptr, mode, dst + (size_t)(r0 + nb * 32) * ld_dst + k0 + kb * 64, ld_dst, scr, F.lane); }
}

__device__ __forceinline__ void rms_row_bf16(const float* xrow, const float* gain, bf16_t* ohi, bf16_t* olo, int lane, unsigned char* o8 = nullptr) {
    const f32x4* xr = (const f32x4*)xrow + lane; const f32x4* gr = (const f32x4*)gain + lane;
    f32x4 v[8]; float s = 0.f;
#pragma unroll
    for (int j = 0; j < 8; ++j) { v[j] = xr[64 * j]; s += (v[j][0] * v[j][0] + v[j][1] * v[j][1]) + (v[j][2] * v[j][2] + v[j][3] * v[j][3]); }
    const float rstd = 1.0f / sqrtf(wave_sum(s) * (1.f / 2048.f) + NORM_EPS);
#pragma unroll
    for (int j = 0; j < 8; ++j) { const f32x4 gq = gr[64 * j]; const f32x4 y = v[j] * rstd * gq;
        u32x2 h; h.x = pk2(y[0], y[1]); h.y = pk2(y[2], y[3]);
        *((u32x2*)ohi + lane + 64 * j) = h;
        if (o8) ((unsigned*)o8)[lane + 64 * j] = pk4_fp8(y);
        if (olo) { u32x2 l; l.x = pk2(y[0] - bflo(h.x), y[1] - bfhi(h.x)); l.y = pk2(y[2] - bflo(h.y), y[3] - bfhi(h.y)); *((u32x2*)olo + lane + 64 * j) = l; } }
}

__device__ __forceinline__ void attn_unit(LAS unsigned char* lds, const bf16_t* Qf, const bf16_t* Kf, const bf16_t* Vtf, bf16_t* OB, int bh, int qb, int tid, int wid, int lane) {
    const int c = lane & 31, hi = lane >> 5;
    bf16x8 q[12];
    { const bf16x8* qp = (const bf16x8*)(Qf + ((size_t)(bh * 256 + qb * 8 + wid) * 12) * 512) + lane;
#pragma unroll
      for (int ks = 0; ks < 12; ++ks) q[ks] = qp[ks * 64]; }
    f32x16 o[4];
#pragma unroll
    for (int db = 0; db < 4; ++db)
#pragma unroll
        for (int e = 0; e < 16; ++e) o[db][e] = 0.f;
    float mrun = -1e30f, lrun = 0.f;
    const int ntiles = 4 * (qb + 1);
    const char* kbase = (const char*)(Kf + (size_t)bh * 256 * 12 * 512);
    const char* vbase = (const char*)(Vtf + (size_t)bh * 256 * 8 * 512);
#define ATT_LOAD(kt, buf) do { const char* _k = kbase + (size_t)(kt) * 24576 + tid * 16; const char* _v = vbase + (size_t)(kt) * 16384 + tid * 16; \
        _Pragma("unroll") for (int _j = 0; _j < 3; ++_j) __builtin_amdgcn_global_load_lds((const unsigned*)(_k + _j * 8192), (LAS unsigned*)(lds + (buf) * 40960 + _j * 8192 + wid * 1024), 16, 0, 0); \
        _Pragma("unroll") for (int _j = 0; _j < 2; ++_j) __builtin_amdgcn_global_load_lds((const unsigned*)(_v + _j * 8192), (LAS unsigned*)(lds + (buf) * 40960 + 24576 + _j * 8192 + wid * 1024), 16, 0, 0); } while (0)
    __builtin_amdgcn_s_barrier();
    ATT_LOAD(0, 0);
#pragma unroll 1
    for (int kt = 0; kt < ntiles; ++kt) {
        asm volatile("s_waitcnt vmcnt(0)" ::: "memory");
        __builtin_amdgcn_s_barrier();
        if (kt + 1 < ntiles) ATT_LOAD(kt + 1, (kt + 1) & 1);
        const int rel = kt - 4 * qb;
        if (rel <= (wid >> 1)) {
            const LAS unsigned char* tb = lds + (kt & 1) * 40960 + lane * 16;
            f32x16 s0, s1;
#pragma unroll
            for (int e = 0; e < 16; ++e) { s0[e] = 0.f; s1[e] = 0.f; }
#pragma unroll
            for (int g4 = 0; g4 < 3; ++g4) {
                bf16x8 ka[4], kc[4];
#pragma unroll
                for (int i = 0; i < 4; ++i) { ka[i] = *(const LAS bf16x8*)(tb + (4 * g4 + i) * 1024); kc[i] = *(const LAS bf16x8*)(tb + (12 + 4 * g4 + i) * 1024); }
                __builtin_amdgcn_sched_barrier(0);
#pragma unroll
                for (int i = 0; i < 4; ++i) { s0 = __builtin_amdgcn_mfma_f32_32x32x16_bf16(ka[i], q[4 * g4 + i], s0, 0, 0, 0); s1 = __builtin_amdgcn_mfma_f32_32x32x16_bf16(kc[i], q[4 * g4 + i], s1, 0, 0, 0); }
                __builtin_amdgcn_sched_barrier(0);
            }
            if (rel == (wid >> 1)) {
                const int qi = 32 * wid + c - 64 * rel - 4 * hi;
#pragma unroll
                for (int e = 0; e < 16; ++e) { const int kr = (e & 3) + 8 * (e >> 2);
                    s0[e] += __builtin_bit_cast(float, ((qi - kr) >> 31) & (int)0xff800000); s1[e] += __builtin_bit_cast(float, ((qi - 32 - kr) >> 31) & (int)0xff800000); }
            }
            float mt = fmaxf(s0[0], s1[0]);
#pragma unroll
            for (int e = 1; e < 16; ++e) mt = fmaxf(mt, fmaxf(s0[e], s1[e]));
            mt = fmaxf(mt, __shfl_xor(mt, 32));
            const float mnew = fmaxf(mrun, mt), alpha = __builtin_amdgcn_exp2f(mrun - mnew);
            mrun = mnew;
            float ls = 0.f;
#pragma unroll
            for (int e = 0; e < 16; ++e) { s0[e] = __builtin_amdgcn_exp2f(s0[e] - mnew); s1[e] = __builtin_amdgcn_exp2f(s1[e] - mnew); ls += s0[e] + s1[e]; }
            lrun = lrun * alpha + ls;
#pragma unroll
            for (int db = 0; db < 4; ++db)
#pragma unroll
                for (int e = 0; e < 16; ++e) o[db][e] *= alpha;
            bf16x8 p[2][2];
#pragma unroll
            for (int s = 0; s < 2; ++s) {
                u32x4 w0, w1;
                w0.x = cvt_pk_bf16(s0[8 * s + 0], s0[8 * s + 1]); w0.y = cvt_pk_bf16(s0[8 * s + 2], s0[8 * s + 3]); w0.z = cvt_pk_bf16(s0[8 * s + 4], s0[8 * s + 5]); w0.w = cvt_pk_bf16(s0[8 * s + 6], s0[8 * s + 7]);
                w1.x = cvt_pk_bf16(s1[8 * s + 0], s1[8 * s + 1]); w1.y = cvt_pk_bf16(s1[8 * s + 2], s1[8 * s + 3]); w1.z = cvt_pk_bf16(s1[8 * s + 4], s1[8 * s + 5]); w1.w = cvt_pk_bf16(s1[8 * s + 6], s1[8 * s + 7]);
                p[0][s] = __builtin_bit_cast(bf16x8, w0); p[1][s] = __builtin_bit_cast(bf16x8, w1);
            }
            const LAS unsigned char* vb = tb + 24576;
#pragma unroll
            for (int kb = 0; kb < 2; ++kb)
#pragma unroll
                for (int s = 0; s < 2; ++s) {
                    bf16x8 vf[4];
#pragma unroll
                    for (int db = 0; db < 4; ++db) vf[db] = *(const LAS bf16x8*)(vb + ((kb * 2 + s) * 4 + db) * 1024);
                    __builtin_amdgcn_sched_barrier(0);
#pragma unroll
                    for (int db = 0; db < 4; ++db) o[db] = __builtin_amdgcn_mfma_f32_32x32x16_bf16(vf[db], p[kb][s], o[db], 0, 0, 0);
                    __builtin_amdgcn_sched_barrier(0);
                }
        }
    }
#undef ATT_LOAD
    lrun += __shfl_xor(lrun, 32);
    const float inv = 1.0f / lrun;
    const int b = bh >> 3, h = bh & 7;
    unsigned char* orow = (unsigned char*)OB + ((size_t)(b * SEQ + qb * 256 + wid * 32 + c)) * 1024 + h * 128;
    const float inv4 = inv * O8_SCALE;
#pragma unroll
    for (int db = 0; db < 4; ++db)
#pragma unroll
        for (int gq = 0; gq < 4; ++gq) *(unsigned*)(orow + 32 * db + 8 * gq + 4 * hi) = pk4_fp8((f32x4){o[db][4 * gq], o[db][4 * gq + 1], o[db][4 * gq + 2], o[db][4 * gq + 3]} * inv4);
}

__device__ __forceinline__ float dpp_sum16(float v) {
    int x;
    x = __builtin_amdgcn_update_dpp(0, __builtin_bit_cast(int, v), 0xB1, 0xF, 0xF, false); v += __builtin_bit_cast(float, x);
    x = __builtin_amdgcn_update_dpp(0, __builtin_bit_cast(int, v), 0x4E, 0xF, 0xF, false); v += __builtin_bit_cast(float, x);
    x = __builtin_amdgcn_update_dpp(0, __builtin_bit_cast(int, v), 0x141, 0xF, 0xF, false); v += __builtin_bit_cast(float, x);
    x = __builtin_amdgcn_update_dpp(0, __builtin_bit_cast(int, v), 0x140, 0xF, 0xF, false); v += __builtin_bit_cast(float, x);
    return v;
}
__device__ __forceinline__ void dpp_sum16x2(float& a, float& b) {
    asm volatile(
        "s_nop 1\n\t"
        "v_add_f32_dpp %0, %0, %0 quad_perm:[1,0,3,2] row_mask:0xf bank_mask:0xf\n\t"
        "v_add_f32_dpp %1, %1, %1 quad_perm:[1,0,3,2] row_mask:0xf bank_mask:0xf\n\t"
        "s_nop 0\n\t"
        "v_add_f32_dpp %0, %0, %0 quad_perm:[2,3,0,1] row_mask:0xf bank_mask:0xf\n\t"
        "v_add_f32_dpp %1, %1, %1 quad_perm:[2,3,0,1] row_mask:0xf bank_mask:0xf\n\t"
        "s_nop 0\n\t"
        "v_add_f32_dpp %0, %0, %0 row_half_mirror row_mask:0xf bank_mask:0xf\n\t"
        "v_add_f32_dpp %1, %1, %1 row_half_mirror row_mask:0xf bank_mask:0xf\n\t"
        "s_nop 0\n\t"
        "v_add_f32_dpp %0, %0, %0 row_mirror row_mask:0xf bank_mask:0xf\n\t"
        "v_add_f32_dpp %1, %1, %1 row_mirror row_mask:0xf bank_mask:0xf\n\t"
        "s_nop 0"
        : "+v"(a), "+v"(b));
}
constexpr int SC_STEPS = 32, SC_STEPB = 1408, SC_BUF = SC_STEPS * SC_STEPB, SC_YOFF = 2 * SC_BUF, SC_YBUF = SC_STEPS * 128;
__device__ __forceinline__ void scan_block(LAS unsigned char* lds, const GAS unsigned char* ws, bf16_t* Y, int bh, int half, int tid, int wave, int lane) {
    const int ri = lane >> 4, c = lane & 15, b = bh >> 4, h = bh & 15;
    const size_t row0 = (size_t)b * SEQ * 1024 + h * 64;
    const int hi8 = tid >> 8, rem = tid & 255, sst = rem >> 3, seg = rem & 7;
    const size_t e01 = row0 + (size_t)sst * 1024 + seg * 8;
    const size_t o0 = (hi8 ? WS_BB : WS_KK) + e01 * 2, o1 = (hi8 ? WS_R : WS_KP) + e01 * 2;
    const int d0 = sst * SC_STEPB + hi8 * 256 + seg * 32, d1 = sst * SC_STEPB + (2 + hi8) * 256 + seg * 32;
    const int q = tid - 256, sv = (q >> 2) & 31, segv = q & 3;
    const bool has2 = tid < 384;
    const size_t o2 = hi8 ? (WS_VB + (row0 + (size_t)sv * 1024 + 32 * half + segv * 8) * 2) : (WS_OM + e01 * 2);
    const int d2 = hi8 ? (sv * SC_STEPB + 1280 + segv * 32) : (sst * SC_STEPB + 4 * 256 + seg * 32);
    u32x4 r0, r1, r2 = (u32x4){0u, 0u, 0u, 0u};
#define SC_ISSUE(n) do { const size_t _t = (size_t)(n) * SC_STEPS * 2048; r0 = *(const GAS u32x4*)(ws + o0 + _t); r1 = *(const GAS u32x4*)(ws + o1 + _t); if (has2) r2 = *(const GAS u32x4*)(ws + o2 + _t); } while (0)
#define SC_PUT(bufo, d, r) do { float _f[8]; unpack8(r, _f); *(LAS f32x4*)(lds + (bufo) + (d)) = (f32x4){_f[0], _f[1], _f[2], _f[3]}; *(LAS f32x4*)(lds + (bufo) + (d) + 16) = (f32x4){_f[4], _f[5], _f[6], _f[7]}; } while (0)
#define SC_WRITE(bufo) do { SC_PUT(bufo, d0, r0); SC_PUT(bufo, d1, r1); if (has2) SC_PUT(bufo, d2, r2); } while (0)
    __syncthreads();
    SC_ISSUE(0); SC_WRITE(0);
    __syncthreads();
    float S0 = 0.f, S1 = 0.f, S2 = 0.f, S3 = 0.f;
    const int yl = (4 * wave + ri) * 4;
#pragma unroll 1
    for (int n = 0; n < SEQ / SC_STEPS; ++n) {
        const int bufo = (n & 1) * SC_BUF;
        if (n + 1 < SEQ / SC_STEPS) SC_ISSUE(n + 1);
        {
        const LAS unsigned char* bp = lds + bufo + c * 16; const LAS unsigned char* vp = lds + bufo + 1280 + yl;
        LAS unsigned char* yp = lds + SC_YOFF + (n & 1) * SC_YBUF + yl;
#define SC_LD(X, s) do { X##kk = *(const LAS f32x4*)(bp + (s) * SC_STEPB); X##bb = *(const LAS f32x4*)(bp + (s) * SC_STEPB + 256); X##kp = *(const LAS f32x4*)(bp + (s) * SC_STEPB + 512); \
            X##rr = *(const LAS f32x4*)(bp + (s) * SC_STEPB + 768); X##om = *(const LAS f32x4*)(bp + (s) * SC_STEPB + 1024); X##vv = *(const LAS float*)(vp + (s) * SC_STEPB); } while (0)
#define SC_STEP(X, s) do { \
            float p = fmaf(S3, X##kk[3], fmaf(S2, X##kk[2], fmaf(S1, X##kk[1], S0 * X##kk[0]))); \
            const float u0 = fmaf(X##vv, X##kp[0], fmaf(-X##om[0], S0, S0)), u1 = fmaf(X##vv, X##kp[1], fmaf(-X##om[1], S1, S1)); \
            const float u2 = fmaf(X##vv, X##kp[2], fmaf(-X##om[2], S2, S2)), u3 = fmaf(X##vv, X##kp[3], fmaf(-X##om[3], S3, S3)); \
            dpp_sum16x2(p, yq); \
            if ((s) > 0) { if (c == 0) *(LAS float*)(yp + ((s) - 1) * 128) = yq; } \
            S0 = fmaf(-p, X##bb[0], u0); S1 = fmaf(-p, X##bb[1], u1); S2 = fmaf(-p, X##bb[2], u2); S3 = fmaf(-p, X##bb[3], u3); \
            yq = fmaf(S3, X##rr[3], fmaf(S2, X##rr[2], fmaf(S1, X##rr[1], S0 * X##rr[0]))); } while (0)
        f32x4 Akk, Abb, Akp, Arr, Aom, Bkk, Bbb, Bkp, Brr, Bom; float Avv, Bvv, yq = 0.f;
        SC_LD(A, 0);
#pragma unroll
        for (int s = 0; s < SC_STEPS; s += 2) {
            SC_LD(B, s + 1);
            SC_STEP(A, s);
            if (s + 2 < SC_STEPS) SC_LD(A, s + 2);
            SC_STEP(B, s + 1);
        }
        { float dummy = 0.f; dpp_sum16x2(yq, dummy); if (c == 0) *(LAS float*)(yp + (SC_STEPS - 1) * 128) = yq; }
#undef SC_LD
#undef SC_STEP
        }
        if (n + 1 < SEQ / SC_STEPS) SC_WRITE(bufo ^ SC_BUF);
        __syncthreads();
        if (tid < 128) {
            const LAS f32x4* yl4 = (const LAS f32x4*)(lds + SC_YOFF + (n & 1) * SC_YBUF + (tid >> 2) * 128 + (tid & 3) * 32);
            *(u32x4*)(Y + row0 + (size_t)(n * SC_STEPS + (tid >> 2)) * 1024 + 32 * half + (tid & 3) * 8) = pack8(yl4[0], yl4[1]);
        }
    }
    __syncthreads();
#undef SC_ISSUE
#undef SC_PUT
#undef SC_WRITE
}

constexpr int REC_BYTES = 29696, RO_KK = 0, RO_Q = 4096, RO_NT = 8192, RO_AK = 10240, RO_KQ = 12288, RO_BQ = 14336, RO_BT = 16384, RO_KT = 20480, RO_V = 24576, RO_PC = 28672;
constexpr int PRE_LDS = 13824;
__device__ __forceinline__ unsigned char* rec_ptr(unsigned char* ws, unsigned char* dout, int bh, int n) {
    return bh < 17 ? dout + (size_t)(bh * 256 + n) * REC_BYTES : ws + WS_RECB + (size_t)((bh - 17) * 256 + n) * REC_BYTES;
}
__device__ __forceinline__ void chunk_pre(LAS unsigned char* wl, const GAS unsigned char* ws, unsigned char* rec, int bh, int n, int lane, const float* mu, const float* pk_k, const float* pk_a, const float* pr_k) {
    asm volatile("" : "+v"(lane));
    const int b = bh >> 4, h = bh & 15, j = lane;
    const size_t e0 = ((size_t)(b * SEQ + 32 * n)) * 1024 + h * 64;
    const size_t r0 = ((size_t)(b * SEQ + 32 * n)) * 3072 + h * 64;
    const GAS bf16_t* pOM = (const GAS bf16_t*)(ws + WS_OM) + e0; const GAS bf16_t* pAA = (const GAS bf16_t*)(ws + WS_AA) + e0;
    const GAS bf16_t* pRAW = (const GAS bf16_t*)(ws + WS_RKV) + r0;
    GAS bf16_t* pVB = (GAS bf16_t*)(ws + WS_VB) + e0; GAS float* pBON = (GAS float*)(ws + WS_BONUS) + (size_t)(b * SEQ + 32 * n) * 16 + h;
    const float mur = mu[h * 64 + j], muk = mu[1024 + h * 64 + j], muv = mu[2048 + h * 64 + j], ckk = pk_k[h * 64 + j], cka = pk_a[h * 64 + j], crk = pr_k[h * 64 + j];
    float pr = 0.f, pk = 0.f, pv = 0.f;
    if (n > 0) { pr = bf2f(pRAW[(long)j - 3072]); pk = bf2f(pRAW[(long)j - 3072 + 1024]); pv = bf2f(pRAW[(long)j - 3072 + 2048]); }
    unsigned btp[16], ktp[16], vvp[16];
    float L = 0.f;
    unsigned short rom[2][8], raa[2][8], rr_[2][8], rk_[2][8], rv_[2][8];
#define PRE_LOAD(bf, tg_) do { _Pragma("unroll") for (int q = 0; q < 8; ++q) { const unsigned o = (unsigned)((8 * (tg_) + q) * 1024 + j), o3 = (unsigned)((8 * (tg_) + q) * 3072 + j); \
        rom[bf][q] = pOM[o]; raa[bf][q] = pAA[o]; rr_[bf][q] = pRAW[o3]; rk_[bf][q] = pRAW[o3 + 1024]; rv_[bf][q] = pRAW[o3 + 2048]; } } while (0)
    PRE_LOAD(0, 0);
#pragma unroll
    for (int tg = 0; tg < 4; ++tg) {
        const int bf = tg & 1;
        if (tg + 1 < 4) PRE_LOAD(bf ^ 1, tg + 1);
        __builtin_amdgcn_sched_barrier(0);
#pragma unroll
        for (int q = 0; q < 8; ++q) { const int t = 8 * tg + q;
            const float cr = bf2f(rr_[bf][q]), ck = bf2f(rk_[bf][q]), cv = bf2f(rv_[bf][q]), aa = bf2f(raa[bf][q]), om = bf2f(rom[bf][q]);
            const float rr = cr + (pr - cr) * mur, kx = ck + (pk - ck) * muk, vx = cv + (pv - cv) * muv;
            pr = cr; pk = ck; pv = cv;
            const float kk0 = kx * ckk, kp = kx * (1.0f + (aa - 1.0f) * cka);
            float nrm = kk0 * kk0, bon = rr * kp * crk;
            dpp_sum16x2(nrm, bon);
            const float nt_ = (__builtin_bit_cast(float, __builtin_amdgcn_readlane(fbits(nrm), 0)) + __builtin_bit_cast(float, __builtin_amdgcn_readlane(fbits(nrm), 16))) + (__builtin_bit_cast(float, __builtin_amdgcn_readlane(fbits(nrm), 32)) + __builtin_bit_cast(float, __builtin_amdgcn_readlane(fbits(nrm), 48)));
            const float bt_ = (__builtin_bit_cast(float, __builtin_amdgcn_readlane(fbits(bon), 0)) + __builtin_bit_cast(float, __builtin_amdgcn_readlane(fbits(bon), 16))) + (__builtin_bit_cast(float, __builtin_amdgcn_readlane(fbits(bon), 32)) + __builtin_bit_cast(float, __builtin_amdgcn_readlane(fbits(bon), 48)));
            const float kk = kk0 * (1.0f / fmaxf(sqrtf(nt_), 1e-12f)), bb = kk * aa;
            const unsigned vb16 = f2bf(vx);
            pVB[(unsigned)(t * 1024 + j)] = (bf16_t)vb16;
            if (j == 0) pBON[t * 16] = bt_;
            const float w = 1.0f - om, ekm = __expf(L);
            L += __logf(w);
            const float el = ekm * w, eil = __builtin_amdgcn_rcpf(el);
            *(LAS unsigned short*)(wl + 0 + t * 144 + j * 2) = (unsigned short)f2bf(kk * ekm);
            *(LAS unsigned short*)(wl + 4608 + t * 144 + j * 2) = (unsigned short)f2bf(rr * el);
            const unsigned bt = f2bf(bb * eil), kt = f2bf(kp * eil);
            *(LAS unsigned short*)(wl + 9216 + t * 144 + j * 2) = (unsigned short)bt;
            if (q & 1) { btp[t >> 1] |= bt << 16; ktp[t >> 1] |= kt << 16; vvp[t >> 1] |= vb16 << 16; } else { btp[t >> 1] = bt; ktp[t >> 1] = kt; vvp[t >> 1] = vb16; }
        }
        __builtin_amdgcn_sched_barrier(0);
    }
#undef PRE_LOAD
    *(float*)(rec + RO_PC + j * 4) = __expf(L);
    {
        const int jb = j >> 5, jr = j & 31;
#pragma unroll
        for (int s2 = 0; s2 < 2; ++s2)
#pragma unroll
            for (int hh = 0; hh < 2; ++hh) {
                const int tp = (16 * s2 + 4 * hh) >> 1, tn = (16 * s2 + 8 * hh) >> 1;
                *(u32x4*)(rec + RO_BT + ((jb * 2 + s2) * 64 + hh * 32 + jr) * 16) = (u32x4){btp[tp], btp[tp + 1], btp[tp + 4], btp[tp + 5]};
                *(u32x4*)(rec + RO_KT + ((jb * 2 + s2) * 64 + hh * 32 + jr) * 16) = (u32x4){ktp[tn], ktp[tn + 1], ktp[tn + 2], ktp[tn + 3]};
                *(u32x4*)(rec + RO_V + jb * 2048 + (s2 * 64 + hh * 32 + jr) * 16) = (u32x4){vvp[tn], vvp[tn + 1], vvp[tn + 2], vvp[tn + 3]};
            }
    }
    LDS_WAIT(); asm volatile("" ::: "memory");
    const int r = lane & 31, hh = lane >> 5;
#pragma unroll
    for (int m = 0; m < 2; ++m)
#pragma unroll
        for (int blk = 0; blk < 4; ++blk) { const int j0 = 16 * blk + 4 * hh;
            const u32x2 lo = *(const LAS u32x2*)(wl + m * 4608 + r * 144 + j0 * 2), hi = *(const LAS u32x2*)(wl + m * 4608 + r * 144 + (j0 + 8) * 2);
            *(u32x4*)(rec + (m ? RO_Q : RO_KK) + (blk * 64 + lane) * 16) = (u32x4){lo.x, lo.y, hi.x, hi.y}; }
    bf16x8 ak[4], aq[4], bx[4];
#pragma unroll
    for (int ks = 0; ks < 4; ++ks) { ak[ks] = *(const LAS bf16x8*)(wl + r * 144 + (16 * ks + 8 * hh) * 2); aq[ks] = *(const LAS bf16x8*)(wl + 4608 + r * 144 + (16 * ks + 8 * hh) * 2); bx[ks] = *(const LAS bf16x8*)(wl + 9216 + r * 144 + (16 * ks + 8 * hh) * 2); }
    f32x16 Ab, Bq, Ak, Kq;
#pragma unroll
    for (int e = 0; e < 16; ++e) { Ab[e] = 0.f; Bq[e] = 0.f; Ak[e] = 0.f; Kq[e] = 0.f; }
    asm volatile("" : "+v"(Ab), "+v"(Bq), "+v"(Ak), "+v"(Kq));
#pragma unroll
    for (int ks = 0; ks < 4; ++ks) { Ab = __builtin_amdgcn_mfma_f32_32x32x16_bf16(ak[ks], bx[ks], Ab, 0, 0, 0); Bq = __builtin_amdgcn_mfma_f32_32x32x16_bf16(aq[ks], bx[ks], Bq, 0, 0, 0); }
    LDS_WAIT(); asm volatile("" ::: "memory");
#pragma unroll
    for (int t = 0; t < 32; ++t) *(LAS unsigned short*)(wl + 9216 + t * 144 + j * 2) = (unsigned short)((t & 1) ? (ktp[t >> 1] >> 16) : (ktp[t >> 1] & 0xffffu));
    LDS_WAIT(); asm volatile("" ::: "memory");
#pragma unroll
    for (int ks = 0; ks < 4; ++ks) bx[ks] = *(const LAS bf16x8*)(wl + 9216 + r * 144 + (16 * ks + 8 * hh) * 2);
#pragma unroll
    for (int ks = 0; ks < 4; ++ks) { Ak = __builtin_amdgcn_mfma_f32_32x32x16_bf16(ak[ks], bx[ks], Ak, 0, 0, 0); Kq = __builtin_amdgcn_mfma_f32_32x32x16_bf16(aq[ks], bx[ks], Kq, 0, 0, 0); }
#pragma unroll
    for (int g = 0; g < 16; ++g) { const int t = (g & 3) + 8 * (g >> 2) + 4 * hh;
        const int ms = (r - t) >> 31, mi = (r - t - 1) >> 31;
        const float xab = Ab[g], xak = Ak[g], xbq = Bq[g], xkq = Kq[g];
        Ab[g] = __builtin_bit_cast(float, fbits(xab) & ms); Ak[g] = __builtin_bit_cast(float, fbits(xak) & ms);
        Bq[g] = __builtin_bit_cast(float, fbits(xbq) & mi); Kq[g] = __builtin_bit_cast(float, fbits(xkq) & mi); }
    float Tr[32];
#pragma unroll
    for (int t = 0; t < 32; ++t) {
        float acc = __builtin_bit_cast(float, 0x3f800000 & ~(((r - t) | (t - r)) >> 31));
        const float abt = Ab[(t & 3) + 4 * (t >> 3)];
#pragma unroll
        for (int s = 0; s < t; ++s) { const float a = __builtin_bit_cast(float, __builtin_amdgcn_readlane(fbits(abt), s + 32 * ((t >> 2) & 1))); acc = fmaf(-a, Tr[s], acc); }
        Tr[t] = acc;
        __builtin_amdgcn_sched_barrier(0);
    }
    LDS_WAIT(); asm volatile("" ::: "memory");
    {
        const int c = r, s2 = c >> 4;
        const int lp = ((c >> 2) & 1) * 32, ep = 4 * ((c >> 3) & 1) + (c & 3);
        const int ln = ((c >> 3) & 1) * 32, en = c & 7;
#pragma unroll
        for (int tt = 0; tt < 16; ++tt) { const int t = 16 * hh + tt;
            *(LAS unsigned short*)(wl + 0 + (s2 * 64 + lp + t) * 16 + ep * 2) = (unsigned short)f2bf(-Tr[t]); }
#pragma unroll
        for (int g = 0; g < 16; ++g) { const int t = (g & 3) + 8 * (g >> 2) + 4 * hh;
            *(LAS unsigned short*)(wl + 2048 + (s2 * 64 + ln + t) * 16 + en * 2) = (unsigned short)f2bf(Ak[g]);
            *(LAS unsigned short*)(wl + 4096 + (s2 * 64 + ln + t) * 16 + en * 2) = (unsigned short)f2bf(Kq[g]);
            *(LAS unsigned short*)(wl + 6144 + (s2 * 64 + lp + t) * 16 + ep * 2) = (unsigned short)f2bf(Bq[g]); }
    }
    LDS_WAIT(); asm volatile("" ::: "memory");
#pragma unroll
    for (int p = 0; p < 8; ++p) *(u32x4*)(rec + RO_NT + (p * 64 + lane) * 16) = *(const LAS u32x4*)(wl + (p * 64 + lane) * 16);
    LDS_WAIT(); asm volatile("" ::: "memory");
}
constexpr int SEQ_SLOT = 27 * 1024;
constexpr int CV_HSHARE = 1024, CV_HSTOP = 176;
__device__ __forceinline__ void chunk_seq(LAS unsigned char* lds, unsigned char* ws, unsigned char* dout, bf16_t* Y, int bh, int vb, int lane, volatile LAS int* prog) {
    const int c = lane & 31, hi = lane >> 5, b = bh >> 4, h = bh & 15;
    f32x16 St0, St1;
#pragma unroll
    for (int e = 0; e < 16; ++e) { St0[e] = 0.f; St1[e] = 0.f; }
#define SQ_ISSUE(n, slot) do { const unsigned char* _r = rec_ptr(ws, dout, bh, (n)) + lane * 16; \
        _Pragma("unroll") for (int _p = 0; _p < 24; ++_p) __builtin_amdgcn_global_load_lds((const unsigned*)(_r + _p * 1024), (LAS unsigned*)(lds + (slot) * SEQ_SLOT + _p * 1024), 16, 0, 0); \
        _Pragma("unroll") for (int _p = 0; _p < 2; ++_p) __builtin_amdgcn_global_load_lds((const unsigned*)(_r + RO_V + vb * 2048 + _p * 1024), (LAS unsigned*)(lds + (slot) * SEQ_SLOT + (24 + _p) * 1024), 16, 0, 0); \
        __builtin_amdgcn_global_load_lds((const unsigned*)(_r + RO_PC), (LAS unsigned*)(lds + (slot) * SEQ_SLOT + 26 * 1024), 16, 0, 0); } while (0)
#define SQ_FRAG(slot, p) (*(const LAS bf16x8*)(lds + (slot) * SEQ_SLOT + (p) * 1024 + lane * 16))
#define SQ_PACK(X, s2) __builtin_bit_cast(bf16x8, (u32x4){cvt_pk_bf16(X[8 * (s2) + 0], X[8 * (s2) + 1]), cvt_pk_bf16(X[8 * (s2) + 2], X[8 * (s2) + 3]), cvt_pk_bf16(X[8 * (s2) + 4], X[8 * (s2) + 5]), cvt_pk_bf16(X[8 * (s2) + 6], X[8 * (s2) + 7])})
    SQ_ISSUE(0, 0);
#pragma unroll 1
    for (int n = 0; n < 256; ++n) {
        const int slot = n & 1;
        prog[0] = n;
        SQ_ISSUE(n + 1 < 256 ? n + 1 : n, slot ^ 1);
        if (n == 0) asm volatile("s_waitcnt vmcnt(27)" ::: "memory");
        else asm volatile("s_waitcnt vmcnt(43)" ::: "memory");
        const bf16x8 S00 = SQ_PACK(St0, 0), S01 = SQ_PACK(St0, 1), S10 = SQ_PACK(St1, 0), S11 = SQ_PACK(St1, 1);
        const bf16x8 V0 = SQ_FRAG(slot, 24), V1 = SQ_FRAG(slot, 25);
        f32x16 ZA;
#pragma unroll
        for (int e = 0; e < 16; ++e) ZA[e] = 0.f;
        asm volatile("" : "+v"(ZA));
        ZA = __builtin_amdgcn_mfma_f32_32x32x16_bf16(SQ_FRAG(slot, 0), S00, ZA, 0, 0, 0); ZA = __builtin_amdgcn_mfma_f32_32x32x16_bf16(SQ_FRAG(slot, 1), S01, ZA, 0, 0, 0);
        ZA = __builtin_amdgcn_mfma_f32_32x32x16_bf16(SQ_FRAG(slot, 2), S10, ZA, 0, 0, 0); ZA = __builtin_amdgcn_mfma_f32_32x32x16_bf16(SQ_FRAG(slot, 3), S11, ZA, 0, 0, 0);
        ZA = __builtin_amdgcn_mfma_f32_32x32x16_bf16(SQ_FRAG(slot, 10), V0, ZA, 0, 0, 0); ZA = __builtin_amdgcn_mfma_f32_32x32x16_bf16(SQ_FRAG(slot, 11), V1, ZA, 0, 0, 0);
        f32x16 Yt;
#pragma unroll
        for (int e = 0; e < 16; ++e) Yt[e] = 0.f;
        asm volatile("" : "+v"(Yt));
        Yt = __builtin_amdgcn_mfma_f32_32x32x16_bf16(SQ_FRAG(slot, 4), S00, Yt, 0, 0, 0); Yt = __builtin_amdgcn_mfma_f32_32x32x16_bf16(SQ_FRAG(slot, 5), S01, Yt, 0, 0, 0);
        Yt = __builtin_amdgcn_mfma_f32_32x32x16_bf16(SQ_FRAG(slot, 6), S10, Yt, 0, 0, 0); Yt = __builtin_amdgcn_mfma_f32_32x32x16_bf16(SQ_FRAG(slot, 7), S11, Yt, 0, 0, 0);
        Yt = __builtin_amdgcn_mfma_f32_32x32x16_bf16(SQ_FRAG(slot, 12), V0, Yt, 0, 0, 0); Yt = __builtin_amdgcn_mfma_f32_32x32x16_bf16(SQ_FRAG(slot, 13), V1, Yt, 0, 0, 0);
        asm volatile("s_nop 7\n\ts_nop 7" : "+v"(ZA));
        const bf16x8 Z0 = SQ_PACK(ZA, 0), Z1 = SQ_PACK(ZA, 1);
        f32x16 U;
#pragma unroll
        for (int e = 0; e < 16; ++e) U[e] = 0.f;
        asm volatile("" : "+v"(U));
        U = __builtin_amdgcn_mfma_f32_32x32x16_bf16(SQ_FRAG(slot, 8), Z0, U, 0, 0, 0); U = __builtin_amdgcn_mfma_f32_32x32x16_bf16(SQ_FRAG(slot, 9), Z1, U, 0, 0, 0);
        asm volatile("s_nop 7\n\ts_nop 7" : "+v"(U));
        const bf16x8 U0 = SQ_PACK(U, 0), U1 = SQ_PACK(U, 1);
        Yt = __builtin_amdgcn_mfma_f32_32x32x16_bf16(SQ_FRAG(slot, 14), U0, Yt, 0, 0, 0); Yt = __builtin_amdgcn_mfma_f32_32x32x16_bf16(SQ_FRAG(slot, 15), U1, Yt, 0, 0, 0);
        St0 = __builtin_amdgcn_mfma_f32_32x32x16_bf16(SQ_FRAG(slot, 16), U0, St0, 0, 0, 0); St0 = __builtin_amdgcn_mfma_f32_32x32x16_bf16(SQ_FRAG(slot, 17), U1, St0, 0, 0, 0);
        St0 = __builtin_amdgcn_mfma_f32_32x32x16_bf16(SQ_FRAG(slot, 20), V0, St0, 0, 0, 0); St0 = __builtin_amdgcn_mfma_f32_32x32x16_bf16(SQ_FRAG(slot, 21), V1, St0, 0, 0, 0);
        St1 = __builtin_amdgcn_mfma_f32_32x32x16_bf16(SQ_FRAG(slot, 18), U0, St1, 0, 0, 0); St1 = __builtin_amdgcn_mfma_f32_32x32x16_bf16(SQ_FRAG(slot, 19), U1, St1, 0, 0, 0);
        St1 = __builtin_amdgcn_mfma_f32_32x32x16_bf16(SQ_FRAG(slot, 22), V0, St1, 0, 0, 0); St1 = __builtin_amdgcn_mfma_f32_32x32x16_bf16(SQ_FRAG(slot, 23), V1, St1, 0, 0, 0);
#pragma unroll
        for (int gq = 0; gq < 4; ++gq) { const f32x4 p0 = *(const LAS f32x4*)(lds + slot * SEQ_SLOT + 26 * 1024 + (8 * gq + 4 * hi) * 4), p1 = *(const LAS f32x4*)(lds + slot * SEQ_SLOT + 26 * 1024 + (32 + 8 * gq + 4 * hi) * 4);
#pragma unroll
            for (int e = 0; e < 4; ++e) { St0[4 * gq + e] *= p0[e]; St1[4 * gq + e] *= p1[e]; } }
        bf16_t* yrow = Y + ((size_t)(b * SEQ + 32 * n)) * 1024 + h * 64 + 32 * vb + c;
#pragma unroll
        for (int g = 0; g < 16; ++g) yrow[(size_t)((g & 3) + 8 * (g >> 2) + 4 * hi) * 1024] = (bf16_t)f2bf(Yt[g]);
    }
    asm volatile("s_waitcnt vmcnt(0)" ::: "memory");
#undef SQ_ISSUE
#undef SQ_FRAG
#undef SQ_PACK
}

#define WIN ((bf16_t*)(ws + WS_WIN))
#define WL ((bf16_t*)(ws + WS_WL))
#define WR ((bf16_t*)(ws + WS_WR))
#define WUQ ((bf16_t*)(ws + WS_WUQ))
#define WUKV ((bf16_t*)(ws + WS_WUKV))
#define WA ((bf16_t*)(ws + WS_WA))
#define WB ((bf16_t*)(ws + WS_WB))
#define WO ((bf16_t*)(ws + WS_WO))
#define WSHGU ((bf16_t*)(ws + WS_WSHGU))
#define WSHD ((bf16_t*)(ws + WS_WSHD))
#define WPLE ((bf16_t*)(ws + WS_WPLE))
#define WPG ((bf16_t*)(ws + WS_WPG))
#define PBF ((bf16_t*)(ws + WS_PBF))
#define WEG ((bf16_t*)(ws + WS_WEG))
#define WED ((bf16_t*)(ws + WS_WED))
#define RSTDQ ((float*)(ws + WS_RSTDQ))
#define RSTDKV ((float*)(ws + WS_RSTDKV))
#define RSTDP ((float*)(ws + WS_RSTDP))
#define BONUS ((float*)(ws + WS_BONUS))
#define EIDX ((int*)(ws + WS_EIDX))
#define WTS ((float*)(ws + WS_WTS))
#define POS ((int*)(ws + WS_POS))
#define SLOT ((int*)(ws + WS_SLOT))
#define ROWTOK ((int*)(ws + WS_ROWTOK))
#define ROWW ((float*)(ws + WS_ROWW))
#define TILEE ((int*)(ws + WS_TILEE))
#define HB ((bf16_t*)(ws + WS_H))
#define RKV ((bf16_t*)(ws + WS_RKV))
#define MISC ((bf16_t*)(ws + WS_MISC))
#define CQKV ((bf16_t*)(ws + WS_CQKV))
#define GATES ((bf16_t*)(ws + WS_GATES))
#define LIN ((bf16_t*)(ws + WS_L))
#define OMB ((bf16_t*)(ws + WS_OM))
#define AA ((bf16_t*)(ws + WS_AA))
#define GG ((bf16_t*)(ws + WS_GG))
#define QRAW ((bf16_t*)(ws + WS_QRAW))
#define KVRAW ((bf16_t*)(ws + WS_KVRAW))
#define RB ((bf16_t*)(ws + WS_R))
#define KPB ((bf16_t*)(ws + WS_KP))
#define KKB ((bf16_t*)(ws + WS_KK))
#define BBB ((bf16_t*)(ws + WS_BB))
#define VBB ((bf16_t*)(ws + WS_VB))
#define QF ((bf16_t*)(ws + WS_QF))
#define KF ((bf16_t*)(ws + WS_KF))
#define VTF ((bf16_t*)(ws + WS_VTF))
#define YS ((bf16_t*)(ws + WS_Y))
#define OB ((bf16_t*)(ws + WS_OB))
#define OA ((bf16_t*)(ws + WS_OA))
#define MERGED ((bf16_t*)(ws + WS_MERGED))
#define Y2 ((bf16_t*)(ws + WS_Y2))
#define H2 ((bf16_t*)(ws + WS_H2))
#define LOGIT ((float*)(ws + WS_LOGIT))
#define ACTSH ((bf16_t*)(ws + WS_ACTSH))
#define PLERAW ((bf16_t*)(ws + WS_PLERAW))
#define XN3 ((bf16_t*)(ws + WS_XN3))
#define ACT ((bf16_t*)(ws + WS_ACT))
__global__ void __launch_bounds__(512, 2) hybrid_fwd(Args args) {
    extern __shared__ __attribute__((aligned(16))) unsigned char lds_raw[];
    GAS unsigned char* ws = (GAS unsigned char*)args.ws;
    for (int u = threadIdx.x; u < (LDS_BYTES - LDSCTL_OFF) / 4; u += 512) ((LAS unsigned*)((LAS unsigned char*)lds_raw + LDSCTL_OFF))[u] = 0u;
    __syncthreads();
    const int lo = args.ph_lo, hi = args.ph_hi;
    if ((hi - lo) > 1) (void)xcd_barrier_post((unsigned*)(ws + WS_CTL) + CW_BAR, (volatile LAS unsigned*)((LAS unsigned char*)lds_raw + LDSCTL_OFF) + 8);
#ifndef GSEL
#define GSEL 7
#endif
#ifndef PHASE_MASK
#define PHASE_MASK 0x7ffffu
#endif
#define IN(k) (((PHASE_MASK >> (k)) & 1u) && lo <= (k) && (k) < hi)
#define SEAM(k) do { if (IN(k) && IN((k) + 1)) { XcdBarrier _b; _b.bar = (unsigned*)(ws + WS_CTL) + CW_BAR; _b.x = xb_xcc_id(); _b.st = (volatile LAS unsigned*)((LAS unsigned char*)lds_raw + LDSCTL_OFF) + 8; xcd_barrier(_b); } } while (0)
    typedef __attribute__((address_space(4))) const Args CArgs;
    CArgs* ap = (CArgs*)__builtin_amdgcn_kernarg_segment_ptr();
#define PHASE_BEGIN() asm volatile("" : "+s"(ap), "+s"(ws)); int tid = threadIdx.x; asm volatile("" : "+v"(tid)); \
    const int lane = tid & 63, wave = __builtin_amdgcn_readfirstlane(tid >> 6); Frame F; F.lds = (LAS unsigned char*)lds_raw; F.tid = tid; F.lane = lane; F.wave = wave; \
    F.G = gridDim.x; { const int bx = blockIdx.x; F.vcu = (F.G % 8 == 0) ? (bx % 8) * (F.G / 8) + bx / 8 : bx; } F.gw = F.vcu * 8 + wave; F.NGW = F.G * 8; F.ws = (unsigned char*)ws; F.ctl = (unsigned*)(ws + WS_CTL); \
    LAS float* const scr = (LAS float*)(F.lds + wave * 8448); (void)scr; (void)lane
#ifndef REPEAT_MASK
#define REPEAT_MASK 0u
#endif
#define REP(k) for (int _rep = 0; _rep < (int)((REPEAT_MASK >> (k)) & 1u) + 1; ++_rep)
#define OUT ((float*)(GAS float*)ap->out)
#define INP(k) ((const float*)(const GAS float*)ap->in[k])

    REP(0) {
    if (IN(0)) { PHASE_BEGIN();
        const float* w_in = INP(4);
        constexpr int P0_ITEMS = 32 * (96 + 9 + 2 + 32 + 128) + 32 + 32 + 96 + 8 * 48 + 8 * 64;
#pragma unroll 1
        for (int it = F.gw; it < P0_ITEMS; it += F.NGW) { int r = it;
            CONV_JOB(w_in, 8544, 0, 3072, 2048, (const float*)nullptr, 0, WIN, 2048, 0, 0)
            CONV_JOB(w_in, 8544, 3072, 288, 2048, (const float*)nullptr, 0, WIN, 2048, 3072, 0)
            CONV_JOB(w_in, 8544, 4384, 64, 2048, (const float*)nullptr, 0, WIN, 2048, 3360, 0)
            CONV_JOB(w_in, 8544, 3360, 1024, 2048, (const float*)nullptr, 0, WIN, 2048, 3584, 0)
            CONV_JOB8X(w_in, 8544, 4448, 4096, 2048, ws + WS_WIN8G, 2048, 0, 8)
            CONV_JOB(INP(7), 1024, 0, 1024, 64, (const float*)nullptr, 0, WL, 384, 0, 0)
            CONV_JOB(INP(9), 1024, 0, 1024, 64, (const float*)nullptr, 0, WL, 384, 1024, 64)
            CONV_JOB(INP(10), 1024, 0, 1024, 160, (const float*)nullptr, 0, WL, 384, 2048, 128)
            CONV_JOB(INP(19), 1536, 0, 1536, 512, INP(17), 0, WUQ, 512, 0, 0)
            CONV_JOB(INP(20), 2048, 0, 2048, 512, INP(18), 0, WUKV, 512, 0, 0)
        }
        for (int i = F.gw * 64 + lane; i < 160 * 2048 / 8; i += F.NGW * 64) *((u32x4*)(WIN + (size_t)3424 * 2048) + i) = (u32x4){0u, 0u, 0u, 0u};
        for (int m = F.gw; m < T; m += F.NGW) rms_row_bf16(INP(0) + (size_t)m * D, INP(3), HB + (size_t)m * D, nullptr, lane, (unsigned char*)(ws + WS_HB8) + (size_t)m * D);
        for (int i = F.gw * 64 + lane; i < T * 256 / 4; i += F.NGW * 64) { const f32x4 v = *((const f32x4*)INP(1) + i); u32x2 w; w.x = pk2(v[0], v[1]); w.y = pk2(v[2], v[3]); *((u32x2*)PBF + i) = w; }
    }
    SEAM(0);
    }
    REP(1) {
    if (IN(1)) { PHASE_BEGIN();
        { pg8::Gemm g{HB, WIN, 2048, 2048, 2048}; pg8::DenseOrder S; S.init(64, 18, F.G, (int)blockIdx.x);
          pg8::EpiProj E{RKV, MISC, CQKV, GATES};
          pg8::gemm_phase<pg8::EpiProj, pg8::DenseOrder, false>(F.lds, g, S, E, tid); }
        { pg8::Gemm g{(const bf16_t*)(ws + WS_HB8), (const bf16_t*)(ws + WS_WIN8G), 1024, 1024, 1024, 0x7f7f7f7f, 0x79797979};
          pg8::DenseOrderTail S; S.d.init(64, 16, F.G, (int)blockIdx.x); S.lo = F.G == 256 ? 3 : (1 << 20); S.hi = 2; pg8::EpiGates E{GATES};
          pg8::gemm_phase<pg8::EpiGates, pg8::DenseOrderTail, false, true>(F.lds, g, S, E, tid); }
    }
    SEAM(1);
    }
    REP(2) {
    if (IN(2)) { PHASE_BEGIN();
        const float* mu = INP(5);
        float mul_[6];
#pragma unroll
        for (int j = 0; j < 6; ++j) mul_[j] = (lane + 64 * j) < 288 ? mu[3072 + lane + 64 * j] : 0.f;
        for (int t = F.gw; t < T; t += F.NGW) {
            const bool first = (t % SEQ) == 0;
#pragma unroll
            for (int j = 0; j < 6; ++j) { const int cidx = lane + 64 * j; float o = 0.f;
                if (cidx < 288) { const float uu = bf2f(MISC[(size_t)t * 512 + cidx]), pv = first ? 0.f : bf2f(MISC[(size_t)(t - 1) * 512 + cidx]);
                    const float x = uu + (pv - uu) * mul_[j];
                    o = cidx < 64 ? tanhf(x) : (cidx < 128 ? x : sigmoidf_(x)); }
                LIN[(size_t)t * 384 + cidx] = (bf16_t)f2bf(o); }
            float v8[8]; unpack8(*((const u32x4*)(CQKV + (size_t)t * 1024) + lane), v8);
            float sq = 0.f;
#pragma unroll
            for (int e = 0; e < 8; ++e) sq += v8[e] * v8[e];
            unpack8(*((const u32x4*)(CQKV + (size_t)t * 1024 + 512) + lane), v8);
            float sk = 0.f;
#pragma unroll
            for (int e = 0; e < 8; ++e) sk += v8[e] * v8[e];
            sq = wave_sum(sq); sk = wave_sum(sk);
            if (lane == 0) { RSTDQ[t] = 1.0f / sqrtf(sq * (1.f / 512.f) + NORM_EPS); RSTDKV[t] = 1.0f / sqrtf(sk * (1.f / 512.f) + NORM_EPS); }
        }
    }
    SEAM(2);
    }
    REP(3) {
    if (IN(3)) { PHASE_BEGIN();
        if (GSEL & 1) { pg8::Gemm g{LIN, WL, 384, 384, 384}; pg8::DenseOrder S; S.init(64, 12, F.G, (int)blockIdx.x); pg8::EpiLora E{OMB, AA, GG, INP(6), INP(8)};
          pg8::gemm_phase<pg8::EpiLora, pg8::DenseOrder, false>(F.lds, g, S, E, tid); }
        if (GSEL & 2) { pg8::Gemm g{CQKV, WUQ, 1024, 512, 512}; pg8::DenseOrder S; S.init(64, 6, F.G, (int)blockIdx.x); pg8::EpiRowScale E{QRAW, 1536, RSTDQ};
          pg8::gemm_phase<pg8::EpiRowScale, pg8::DenseOrder, false>(F.lds, g, S, E, tid); }
        if (GSEL & 4) { pg8::Gemm g{CQKV + 512, WUKV, 1024, 512, 512}; pg8::DenseOrder S; S.init(64, 8, F.G, (int)blockIdx.x); pg8::EpiRowScale E{KVRAW, 2048, RSTDKV};
          pg8::gemm_phase<pg8::EpiRowScale, pg8::DenseOrder, false>(F.lds, g, S, E, tid); }
    }
    SEAM(3);
    }
    REP(4) {
    if (IN(4)) { PHASE_BEGIN();
        {
            const int tk = lane & 7, j8 = lane >> 3;
            float gq_[16], gq1_[4], gq2_[4], gk_[16], gk1_[4], gk2_[4];
#pragma unroll
            for (int e = 0; e < 16; ++e) { gq_[e] = INP(21)[16 * j8 + e]; gk_[e] = INP(22)[16 * j8 + e]; }
#pragma unroll
            for (int e = 0; e < 4; ++e) { gq1_[e] = INP(21)[128 + 4 * j8 + e]; gq2_[e] = INP(21)[160 + 4 * j8 + e]; gk1_[e] = INP(22)[128 + 4 * j8 + e]; gk2_[e] = INP(22)[160 + 4 * j8 + e]; }
            double fr[4];
#pragma unroll
            for (int e = 0; e < 4; ++e) fr[e] = exp2(-(double)(4 * j8 + e) * (13.287712379549449 / 32.0)) * 0.15915494309189535;
            const float QSCALE = 0.10411754627697264f;
            struct MlaRaw { u32x4 q0, q1, k0, k1; u32x2 qa, qb; };
#define MLA_LOAD(d, hh_) do { const bf16_t* _q = QRAW + (size_t)t * 1536 + (hh_) * 192; d.q0 = *(const u32x4*)(_q + 16 * j8); d.q1 = *(const u32x4*)(_q + 16 * j8 + 8); d.qa = *(const u32x2*)(_q + 128 + 4 * j8); d.qb = *(const u32x2*)(_q + 160 + 4 * j8); \
                const bf16_t* _k = KVRAW + (size_t)t * 2048 + (hh_) * 256; d.k0 = *(const u32x4*)(_k + 16 * j8); d.k1 = *(const u32x4*)(_k + 16 * j8 + 8); } while (0)
            for (int g8 = F.gw; g8 < T / 8; g8 += F.NGW) {
                const int t = g8 * 8 + tk, bidx = t / SEQ, s = t % SEQ;
                MlaRaw cur, nxt;
                MLA_LOAD(cur, 0);
                nxt = cur;
                u32x2 ka, kb; { const bf16_t* _r = MISC + (size_t)t * 512 + 288; ka = *(const u32x2*)(_r + 4 * j8); kb = *(const u32x2*)(_r + 32 + 4 * j8); }
                float cs[4], sn[4];
                { const double pp = (double)((const GAS int*)ap->pos)[t];
#pragma unroll
                  for (int e = 0; e < 4; ++e) { double rv = pp * fr[e]; rv -= floor(rv); const float rf = (float)rv; sn[e] = __builtin_amdgcn_sinf(rf); cs[e] = __builtin_amdgcn_cosf(rf); } }
#pragma unroll 1
                for (int hd = 0; hd < 8; ++hd) {
                if (hd + 1 < 8) MLA_LOAD(nxt, hd + 1);
                { float x[16], r1[4], r2[4];
                  unpack8(cur.q0, *(float(*)[8])&x[0]); unpack8(cur.q1, *(float(*)[8])&x[8]);
                  { const u32x2 w1 = cur.qa, w2 = cur.qb;
                    r1[0] = bflo(w1.x); r1[1] = bfhi(w1.x); r1[2] = bflo(w1.y); r1[3] = bfhi(w1.y); r2[0] = bflo(w2.x); r2[1] = bfhi(w2.x); r2[2] = bflo(w2.y); r2[3] = bfhi(w2.y); }
                  float ss = 0.f;
#pragma unroll
                  for (int e = 0; e < 16; ++e) ss += x[e] * x[e];
#pragma unroll
                  for (int e = 0; e < 4; ++e) ss += r1[e] * r1[e] + r2[e] * r2[e];
                  ss += __shfl_xor(ss, 8); ss += __shfl_xor(ss, 16); ss += __shfl_xor(ss, 32);
                  const float rs = QSCALE / sqrtf(ss * (1.f / 192.f) + NORM_EPS);
#pragma unroll
                  for (int e = 0; e < 16; ++e) x[e] *= rs * gq_[e];
                  float o1[4], o2[4];
#pragma unroll
                  for (int e = 0; e < 4; ++e) { const float t1 = r1[e] * rs * gq1_[e], t2 = r2[e] * rs * gq2_[e]; o1[e] = t1 * cs[e] - t2 * sn[e]; o2[e] = t1 * sn[e] + t2 * cs[e]; }
                  bf16_t* blk = QF + ((size_t)((bidx * 8 + hd) * 256 + (s >> 5)) * 12) * 512; const int rr = s & 31;
                  u32x4 w; w.x = pk2(x[0], x[1]); w.y = pk2(x[2], x[3]); w.z = pk2(x[4], x[5]); w.w = pk2(x[6], x[7]); *(u32x4*)(blk + (j8 * 64 + rr) * 8) = w;
                  w.x = pk2(x[8], x[9]); w.y = pk2(x[10], x[11]); w.z = pk2(x[12], x[13]); w.w = pk2(x[14], x[15]); *(u32x4*)(blk + (j8 * 64 + 32 + rr) * 8) = w;
                  const int hh = (j8 & 3) >> 1, jo = 4 * (j8 & 1);
                  u32x2 w2; w2.x = pk2(o1[0], o1[1]); w2.y = pk2(o1[2], o1[3]); *(u32x2*)(blk + ((8 + (j8 >> 2)) * 64 + hh * 32 + rr) * 8 + jo) = w2;
                  w2.x = pk2(o2[0], o2[1]); w2.y = pk2(o2[2], o2[3]); *(u32x2*)(blk + ((10 + (j8 >> 2)) * 64 + hh * 32 + rr) * 8 + jo) = w2; }
                { float x[16], r1[4], r2[4];
                  unpack8(cur.k0, *(float(*)[8])&x[0]); unpack8(cur.k1, *(float(*)[8])&x[8]);
                  { const u32x2 w1 = ka, w2 = kb;
                    r1[0] = bflo(w1.x); r1[1] = bfhi(w1.x); r1[2] = bflo(w1.y); r1[3] = bfhi(w1.y); r2[0] = bflo(w2.x); r2[1] = bfhi(w2.x); r2[2] = bflo(w2.y); r2[3] = bfhi(w2.y); }
                  float ss = 0.f;
#pragma unroll
                  for (int e = 0; e < 16; ++e) ss += x[e] * x[e];
#pragma unroll
                  for (int e = 0; e < 4; ++e) ss += r1[e] * r1[e] + r2[e] * r2[e];
                  ss += __shfl_xor(ss, 8); ss += __shfl_xor(ss, 16); ss += __shfl_xor(ss, 32);
                  const float rs = 1.0f / sqrtf(ss * (1.f / 192.f) + NORM_EPS);
#pragma unroll
                  for (int e = 0; e < 16; ++e) x[e] *= rs * gk_[e];
                  float o1[4], o2[4];
#pragma unroll
                  for (int e = 0; e < 4; ++e) { const float t1 = r1[e] * rs * gk1_[e], t2 = r2[e] * rs * gk2_[e]; o1[e] = t1 * cs[e] - t2 * sn[e]; o2[e] = t1 * sn[e] + t2 * cs[e]; }
                  bf16_t* blk = KF + ((size_t)((bidx * 8 + hd) * 256 + (s >> 5)) * 12) * 512; const int rr = s & 31;
                  u32x4 w; w.x = pk2(x[0], x[1]); w.y = pk2(x[2], x[3]); w.z = pk2(x[4], x[5]); w.w = pk2(x[6], x[7]); *(u32x4*)(blk + (j8 * 64 + rr) * 8) = w;
                  w.x = pk2(x[8], x[9]); w.y = pk2(x[10], x[11]); w.z = pk2(x[12], x[13]); w.w = pk2(x[14], x[15]); *(u32x4*)(blk + (j8 * 64 + 32 + rr) * 8) = w;
                  const int hh = (j8 & 3) >> 1, jo = 4 * (j8 & 1);
                  u32x2 w2; w2.x = pk2(o1[0], o1[1]); w2.y = pk2(o1[2], o1[3]); *(u32x2*)(blk + ((8 + (j8 >> 2)) * 64 + hh * 32 + rr) * 8 + jo) = w2;
                  w2.x = pk2(o2[0], o2[1]); w2.y = pk2(o2[2], o2[3]); *(u32x2*)(blk + ((10 + (j8 >> 2)) * 64 + hh * 32 + rr) * 8 + jo) = w2;
                  }
                cur = nxt;
                }
            }
#undef MLA_LOAD
        }
        {
            LAS unsigned char* vl = F.lds + wave * 8704;
            for (int it = F.gw; it < 16 * 256; it += F.NGW) {
                const int bh = it >> 8, kb = it & 255, bidx = bh >> 3, hd = bh & 7;
                const int key = lane & 31, dh = lane >> 5;
                const bf16_t* vsrc = KVRAW + (size_t)(bidx * SEQ + kb * 32 + key) * 2048 + hd * 256 + 128 + dh * 64;
#pragma unroll
                for (int i = 0; i < 8; ++i) *(LAS u32x4*)(vl + key * 272 + (dh * 64 + i * 8) * 2) = *(const u32x4*)(vsrc + i * 8);
                LDS_WAIT(); asm volatile("" ::: "memory");
                const int r = lane & 31, hv = lane >> 5;
#pragma unroll
                for (int blk = 0; blk < 8; ++blk) { const int s2 = blk >> 2, db = blk & 3; unsigned w[4];
#pragma unroll
                    for (int jp = 0; jp < 4; ++jp) { const int j0 = 2 * jp, k0 = 16 * s2 + 8 * (j0 >> 2) + 4 * hv + (j0 & 3);
                        const unsigned lo = *(const LAS unsigned short*)(vl + k0 * 272 + (32 * db + r) * 2), hi = *(const LAS unsigned short*)(vl + (k0 + 1) * 272 + (32 * db + r) * 2); w[jp] = lo | (hi << 16); }
                    *(u32x4*)(VTF + ((size_t)(bh * 256 + kb) * 8 + blk) * 512 + lane * 8) = (u32x4){w[0], w[1], w[2], w[3]}; }
                LDS_WAIT(); asm volatile("" ::: "memory");
            }
        }
        __syncthreads();
        for (int it = F.gw; it < 8192; it += F.NGW) chunk_pre(F.lds + wave * PRE_LDS, ws, rec_ptr((unsigned char*)ws, (unsigned char*)OUT, it >> 8, it & 255), it >> 8, it & 255, lane, INP(5), INP(11), INP(12), INP(13));
    }
    SEAM(4);
    }
    REP(5) {
    if (IN(5)) { PHASE_BEGIN();
        const int bx = blockIdx.x;
#if CHUNKED
#if CHUNK_DEBUG
        if (bx < 32) { if (wave == 0) chunk_seq(F.lds, (unsigned char*)ws, (unsigned char*)OUT, YS, bx >> 1, bx & 1, lane, (volatile LAS int*)(F.lds + LDSCTL_OFF + 128)); __syncthreads(); }
        if (bx >= 96 && bx < 128) scan_block(F.lds, ws, YS, (bx - 64) >> 1, bx & 1, tid, wave, lane);
#else
#define EXP_ITEM(it0_, srcp, lds_, dstp, ldd_) do { const int _i = (it0_); if (_i < 65536) { const int nb = _i & 3, kb = (_i >> 2) & 31, j = (_i >> 7) & 3, gu = (_i >> 9) & 1, e = _i >> 10; \
                        srcp = (gu ? INP(29) : INP(28)) + (size_t)e * 2048 * 512 + (size_t)kb * 64 * 512 + j * 128 + nb * 32; lds_ = 512; dstp = (unsigned char*)WEG + (size_t)(e * 1024 + j * 256 + nb * 64 + gu * 32) * 2048 + kb * 64; ldd_ = 2048; } \
                    else { const int _q = _i - 65536; const int nb = _q & 63, kb = (_q >> 6) & 7, e = _q >> 9; srcp = INP(30) + (size_t)e * 512 * 2048 + (size_t)kb * 64 * 2048 + nb * 32; lds_ = 2048; dstp = (unsigned char*)WED + (size_t)(e * 2048 + nb * 32) * 512 + kb * 64; ldd_ = 512; } } while (0)
        if (bx < 64) {
            volatile LAS int* prog = (volatile LAS int*)(F.lds + LDSCTL_OFF + 128);
            if (wave == 0) chunk_seq(F.lds, (unsigned char*)ws, (unsigned char*)OUT, YS, bx >> 1, bx & 1, lane, prog);
            else if (wave < 4) {
                LAS float* scr2 = (LAS float*)(F.lds + 2 * SEQ_SLOT + (wave - 1) * 8448);
#pragma unroll 1
                for (;;) {
                    if (prog[0] >= CV_HSTOP) break;
                    int c = 0; if (lane == 0) c = (int)atomicAdd(&F.ctl[CW_CVH], 1u);
                    c = __builtin_amdgcn_readfirstlane(c);
                    if (c >= CV_HSHARE) break;
                    f32x4 va_[8], vb_[8]; const float* sp; unsigned char* dpa; unsigned char* dpb; int l1, l2a, l2b;
#pragma unroll 1
                    for (int q = 0; q < 64; q += 2) {
                        EXP_ITEM(c * 64 + q, sp, l1, dpa, l2a); conv_load(sp, l1, lane, va_);
                        EXP_ITEM(c * 64 + q + 1, sp, l1, dpb, l2b); conv_load(sp, l1, lane, vb_);
                        conv_store8(va_, dpa, l2a, scr2, lane, W8_SCALE); conv_store8(vb_, dpb, l2b, scr2, lane, W8_SCALE);
                    }
                }
            }
            __syncthreads();
        }
#endif
#if CHUNK_DEBUG
        if (bx >= 64 && bx < 96) scan_block(F.lds, ws, (bf16_t*)(ws + WS_YDBG), (bx - 64) >> 1, bx & 1, tid, wave, lane);
        { XcdBarrier _b; _b.bar = (unsigned*)(ws + WS_CTL) + CW_BAR; _b.x = xb_xcc_id(); _b.st = (volatile LAS unsigned*)((LAS unsigned char*)lds_raw + LDSCTL_OFF) + 8; xcd_barrier(_b); }
#endif
#else
        REP(21) if (bx < 64) scan_block(F.lds, ws, YS, bx >> 1, bx & 1, tid, wave, lane);
#endif
        REP(20) {
            volatile LAS int* qw = (volatile LAS int*)(F.lds + LDSCTL_OFF + 64);
#pragma unroll 1
            for (;;) {
                if (tid == 0) qw[0] = (int)atomicAdd(&F.ctl[CW_ATTQ + 64 * _rep], 1u);
                __syncthreads();
                const int uix = qw[0];
                if (uix >= 512) break;
                attn_unit(F.lds, QF, KF, VTF, OB, uix & 15, 31 - (uix >> 4), tid, wave, lane);
            }
            __syncthreads();
        }
        {
            volatile LAS int* qw = (volatile LAS int*)(F.lds + LDSCTL_OFF + 64);
#pragma unroll 1
            for (;;) {
                __syncthreads();
                constexpr int CV_MISC = 1024 + 1024 + 2048 + 3 * 64 + 8 * 128 + 512 + 256 + 2048;
                if (tid == 0) { int c = CV_HSHARE + (int)atomicAdd(&F.ctl[CW_CVQ], 1u);
                    if (c >= (98304 + CV_MISC + 63) / 64) { c = (int)atomicAdd(&F.ctl[CW_CVH], 1u); if (c >= CV_HSHARE) c = 1 << 30; }
                    qw[0] = c; }
                __syncthreads();
                const int cix = qw[0];
                if (cix >= (98304 + CV_MISC + 63) / 64) break;
                if (cix < 1536) {
                    f32x4 va_[8], vb_[8]; const float* sp; unsigned char* dpa; unsigned char* dpb; int l1, l2a, l2b;
                    EXP_ITEM(cix * 64 + wave, sp, l1, dpa, l2a); conv_load(sp, l1, lane, va_);
#pragma unroll
                    for (int k8 = 0; k8 < 8; k8 += 2) {
                        EXP_ITEM(cix * 64 + (k8 + 1) * 8 + wave, sp, l1, dpb, l2b); conv_load(sp, l1, lane, vb_);
                        conv_store8(va_, dpa, l2a, scr, lane, W8_SCALE);
                        if (k8 + 2 < 8) { EXP_ITEM(cix * 64 + (k8 + 2) * 8 + wave, sp, l1, dpa, l2a); conv_load(sp, l1, lane, va_); }
                        conv_store8(vb_, dpb, l2b, scr, lane, W8_SCALE);
                    }
                } else
#pragma unroll 1
                for (int k8 = 0; k8 < 8; ++k8) {
                    const int it0 = cix * 64 + k8 * 8 + wave;
                    if (it0 >= 98304 && it0 < 98304 + CV_MISC) {
                        int r = it0 - 98304;
                        CONV_JOB8X(INP(16), 2048, 0, 2048, 1024, WA, 1024, 0, 8)
                        CONV_JOB8X(INP(23), 2048, 0, 2048, 1024, WB, 1024, 0, 8)
                        CONV_JOB8X(INP(24), 2048, 0, 2048, 2048, WO, 2048, 0, 8)
                        CONV_JOB(INP(26), 64, 0, 64, 2048, (const float*)nullptr, 0, WR, 4096, 0, 0)
                        CONV_JOB(INP(26), 64, 0, 64, 2048, (const float*)nullptr, 0, WR, 4096, 0, 2048)
                        CONV_JOB(INP(26), 64, 0, 64, 2048, (const float*)nullptr, 1, WR, 4096, 64, 0)
                        CONV_JOB8X(INP(31), 512, 0, 128, 2048, WSHGU, 2048, 0, 16)
                        CONV_JOB8X(INP(32), 512, 0, 128, 2048, WSHGU, 2048, 32, 16)
                        CONV_JOB8X(INP(31), 512, 128, 128, 2048, WSHGU, 2048, 256, 16)
                        CONV_JOB8X(INP(32), 512, 128, 128, 2048, WSHGU, 2048, 288, 16)
                        CONV_JOB8X(INP(31), 512, 256, 128, 2048, WSHGU, 2048, 512, 16)
                        CONV_JOB8X(INP(32), 512, 256, 128, 2048, WSHGU, 2048, 544, 16)
                        CONV_JOB8X(INP(31), 512, 384, 128, 2048, WSHGU, 2048, 768, 16)
                        CONV_JOB8X(INP(32), 512, 384, 128, 2048, WSHGU, 2048, 800, 16)
                        CONV_JOB8X(INP(33), 2048, 0, 2048, 512, WSHD, 512, 0, 8)
                        CONV_JOB(INP(34), 2048, 0, 2048, 256, (const float*)nullptr, 0, WPLE, 256, 0, 0)
                        CONV_JOB8X(INP(37), 2048, 0, 2048, 2048, WPG, 2048, 0, 8)
                    }
                }
            }
            __syncthreads();
        }
    }
    SEAM(5);
    }
    REP(6) {
    if (IN(6)) { PHASE_BEGIN();
        const int ch = 16 * lane;
        float gw_[16], gb_[16];
#pragma unroll
        for (int e = 0; e < 16; ++e) { gw_[e] = INP(14)[ch + e]; gb_[e] = INP(15)[ch + e]; }
        for (int t = F.gw; t < T; t += F.NGW) {
            float y[16], vv[16], gg[16];
            unpack8(*(const u32x4*)(YS + (size_t)t * 1024 + ch), *(float(*)[8])&y[0]); unpack8(*(const u32x4*)(YS + (size_t)t * 1024 + ch + 8), *(float(*)[8])&y[8]);
#if CHUNK_DEBUG
            if (t < SEQ) { float yo[16]; unpack8(*(const u32x4*)((const bf16_t*)(ws + WS_YDBG) + (size_t)t * 1024 + ch), *(float(*)[8])&yo[0]); unpack8(*(const u32x4*)((const bf16_t*)(ws + WS_YDBG) + (size_t)t * 1024 + ch + 8), *(float(*)[8])&yo[8]);
              float dn = 0.f, dd = 0.f;
#pragma unroll
              for (int e = 0; e < 16; ++e) { dn += (y[e] - yo[e]) * (y[e] - yo[e]); dd += yo[e] * yo[e]; }
              dn = wave_sum(dn); dd = wave_sum(dd);
              if (!(dn < 1e12f)) dn = 1e12f;
              if (lane == 0 && t < DBG_TMAX) { atomicAdd((unsigned long long*)&F.ctl[CW_DBG], (unsigned long long)(dn * 4096.f)); atomicAdd((unsigned long long*)&F.ctl[CW_DBG + 2], (unsigned long long)(dd * 4096.f)); }
#pragma unroll
              for (int e = 0; e < 16; ++e) y[e] = yo[e]; }

#endif
            unpack8(*(const u32x4*)(VBB + (size_t)t * 1024 + ch), *(float(*)[8])&vv[0]); unpack8(*(const u32x4*)(VBB + (size_t)t * 1024 + ch + 8), *(float(*)[8])&vv[8]);
            unpack8(*(const u32x4*)(GG + (size_t)t * 1024 + ch), *(float(*)[8])&gg[0]); unpack8(*(const u32x4*)(GG + (size_t)t * 1024 + ch + 8), *(float(*)[8])&gg[8]);
            float sm = 0.f;
#pragma unroll
            for (int e = 0; e < 16; ++e) sm += y[e];
            sm += __shfl_xor(sm, 1); sm += __shfl_xor(sm, 2);
            const float mean = sm * (1.f / 64.f); float vs = 0.f;
#pragma unroll
            for (int e = 0; e < 16; ++e) { const float d = y[e] - mean; vs += d * d; }
            vs += __shfl_xor(vs, 1); vs += __shfl_xor(vs, 2);
            const float rstd = 1.0f / sqrtf(vs * (1.f / 64.f) + GN_EPS), bon = BONUS[(size_t)t * 16 + (lane >> 2)];
            float o[16];
#pragma unroll
            for (int e = 0; e < 16; ++e) o[e] = ((y[e] - mean) * rstd * gw_[e] + gb_[e] + bon * vv[e]) * gg[e];
            u32x4 w0; w0.x = pk4_fp8((f32x4){o[0], o[1], o[2], o[3]} * O8_SCALE); w0.y = pk4_fp8((f32x4){o[4], o[5], o[6], o[7]} * O8_SCALE); w0.z = pk4_fp8((f32x4){o[8], o[9], o[10], o[11]} * O8_SCALE); w0.w = pk4_fp8((f32x4){o[12], o[13], o[14], o[15]} * O8_SCALE);
            *(u32x4*)((unsigned char*)OA + (size_t)t * 1024 + ch) = w0;
        }
    }
    SEAM(6);
    }
    REP(7) {
    if (IN(7)) { PHASE_BEGIN();
        { pg8::Gemm g{OA, WA, 512, 512, 512, 0x7d7d7d7d, 0x79797979}; pg8::DenseOrder S; S.init(64, 8, F.G, (int)blockIdx.x); pg8::EpiMerge<0> E{MERGED, GATES, 0, nullptr};
          pg8::gemm_phase<pg8::EpiMerge<0>, pg8::DenseOrder, false, true>(F.lds, g, S, E, tid); }
        { pg8::Gemm g{OB, WB, 512, 512, 512, 0x7d7d7d7d, 0x79797979}; pg8::DenseOrder S; S.init(64, 8, F.G, (int)blockIdx.x); pg8::EpiMerge<1> E{MERGED, GATES, 2048, (unsigned char*)(ws + WS_MERGED8)};
          pg8::gemm_phase<pg8::EpiMerge<1>, pg8::DenseOrder, false, true>(F.lds, g, S, E, tid); }
    }
    SEAM(7);
    }
    REP(8) {
    if (IN(8)) { PHASE_BEGIN();
        pg8::Gemm g{(const bf16_t*)(ws + WS_MERGED8), WO, 1024, 1024, 1024, 0x7d7d7d7d, 0x79797979}; pg8::DenseOrder S; S.init(64, 8, F.G, (int)blockIdx.x); pg8::EpiResid E{INP(0), OUT};
        pg8::gemm_phase<pg8::EpiResid, pg8::DenseOrder, false, true>(F.lds, g, S, E, tid);
    }
    SEAM(8);
    }
    REP(9) {
    if (IN(9)) { PHASE_BEGIN();
        for (int m = F.gw; m < T; m += F.NGW) rms_row_bf16(OUT + (size_t)m * D, INP(25), H2 + (size_t)m * 4096, H2 + (size_t)m * 4096 + 2048, lane, (unsigned char*)(ws + WS_H2F8) + (size_t)m * D);
    }
    SEAM(9);
    }
    REP(10) {
    if (IN(10)) { PHASE_BEGIN();
        if (GSEL & 1) { pg8::Gemm g{H2, WR, 4096, 1024, 4096}; pg8::RouterOrder S{F.G, (int)blockIdx.x}; pg8::EpiLogit E{LOGIT};
          pg8::gemm_phase<pg8::EpiLogit, pg8::RouterOrder, false>(F.lds, g, S, E, tid); }
        if (GSEL & 2) { pg8::Gemm g{(const bf16_t*)(ws + WS_H2F8), WSHGU, 1024, 1024, 1024, 0x7f7f7f7f, 0x79797979}; pg8::DenseOrder S; S.init(64, 4, F.G, (int)blockIdx.x); pg8::EpiSwiglu8 E{(unsigned char*)ACTSH};
          pg8::gemm_phase<pg8::EpiSwiglu8, pg8::DenseOrder, false, true>(F.lds, g, S, E, tid); }
        if (GSEL & 4) { pg8::Gemm g{PBF, WPLE, 256, 256, 256}; pg8::DenseOrder S; S.init(64, 8, F.G, (int)blockIdx.x); pg8::EpiRowScale E{PLERAW, 2048, nullptr};
          pg8::gemm_phase<pg8::EpiRowScale, pg8::DenseOrder, false>(F.lds, g, S, E, tid); }
    }
    SEAM(10);
    }
    REP(11) {
    if (IN(11)) { PHASE_BEGIN();
        const float bias = INP(27)[lane];
        LAS int* lcnt = (LAS int*)(F.lds);
        LAS int* lbase = lcnt + 64;
        if (tid < 64) lcnt[tid] = 0;
        __syncthreads();
        const int tpw = T / F.G, t0 = F.vcu * tpw;
        for (int tt = wave; tt < tpw; tt += 8) {
            const int t = t0 + tt;
            float lg = 0.f;
#pragma unroll
            for (int kc = 0; kc < 4; ++kc) lg += LOGIT[(size_t)kc * T * 128 + (size_t)t * 128 + lane] + LOGIT[(size_t)kc * T * 128 + (size_t)t * 128 + 64 + lane];
            lg = (fabsf(lg) < 1e30f) ? lg : 0.f;
            const float score = 1.0f / (1.0f + expf(-lg)), choice = score + bias;
            float m1 = choice; m1 = fmaxf(m1, __shfl_xor(m1, 1)); m1 = fmaxf(m1, __shfl_xor(m1, 2)); m1 = fmaxf(m1, __shfl_xor(m1, 4));
            const unsigned long long eq = __ballot(choice == m1);
            const int grp = lane >> 3; const unsigned geq = (unsigned)(eq >> (8 * grp)) & 0xffu; const int firstl = __builtin_ctz(geq);
            float c2 = ((lane & 7) == firstl) ? -__builtin_inff() : choice;
            float m2 = c2; m2 = fmaxf(m2, __shfl_xor(m2, 1)); m2 = fmaxf(m2, __shfl_xor(m2, 2)); m2 = fmaxf(m2, __shfl_xor(m2, 4));
            const float gs = m1 + m2;
            int grank = 0;
#pragma unroll
            for (int g2 = 0; g2 < 8; ++g2) { const float og = __shfl(gs, 8 * g2); grank += (og > gs || (og == gs && g2 < grp)) ? 1 : 0; }
            const bool cand = grank < 4;
            const float cv = cand ? choice : -__builtin_inff();
            int rank = 0;
#pragma unroll 8
            for (int j = 0; j < 64; ++j) { const float ov = __shfl(cv, j); rank += (ov > cv || (ov == cv && j < lane)) ? 1 : 0; }
            const bool sel = cand && rank < 8;
            const float wsum = wave_sum(sel ? score : 0.f);
            const unsigned long long sm = __ballot(sel);
            if (sel) {
                const int kslot = __popcll(sm & ((1ull << lane) - 1ull));
                const int ls = atomicAdd((int*)&lcnt[lane], 1);
                EIDX[(size_t)t * 8 + kslot] = lane; WTS[(size_t)t * 8 + kslot] = score / (wsum + 1e-20f) * 2.5f; SLOT[(size_t)t * 8 + kslot] = ls;
            }
            { float sq = 0.f;
#pragma unroll
              for (int j = 0; j < 4; ++j) { float v8[8]; unpack8(*((const u32x4*)(PLERAW + (size_t)t * 2048) + lane + 64 * j), v8);
#pragma unroll
                  for (int e = 0; e < 8; ++e) sq += v8[e] * v8[e]; }
              sq = wave_sum(sq); if (lane == 0) RSTDP[t] = 1.0f / sqrtf(sq * (1.f / 2048.f) + NORM_EPS); }
        }
        __syncthreads();
        if (tid < 64) lbase[tid] = (int)atomicAdd(&F.ctl[CW_CNT + tid], (unsigned)lcnt[tid]);
        __syncthreads();
        for (int i = tid; i < tpw * 8; i += 512) { const size_t o = (size_t)t0 * 8 + i; SLOT[o] += lbase[EIDX[o]]; }
        __syncthreads();
    }
    SEAM(11);
    }
    REP(12) {
    if (IN(12)) { PHASE_BEGIN();
        LAS int* pst = (LAS int*)(F.lds);
        if (wave == 0) {
            const int cn = (int)__hip_atomic_load(&F.ctl[CW_CNT + lane], __ATOMIC_RELAXED, __HIP_MEMORY_SCOPE_AGENT); const int nt = (cn + 255) >> 8;
            int rank = 0;
#pragma unroll 8
            for (int j = 0; j < 64; ++j) { const int ov = __shfl(nt, j); rank += (ov > nt || (ov == nt && j < lane)) ? 1 : 0; }
            const int rr = rank >> 3, rc = rank & 7, grp = (rr & 1) ? 7 - rc : rc, q = grp * 8 + rr;
            pst[160 + q] = nt;
            LDS_WAIT(); asm volatile("" ::: "memory");
            const int v = pst[160 + lane]; int incl = v;
#pragma unroll
            for (int d = 1; d < 64; d <<= 1) { const int o = __shfl_up(incl, d); if (lane >= d) incl += o; }
            pst[240 + lane] = incl - v;
            LDS_WAIT(); asm volatile("" ::: "memory");
            const int st = pst[240 + q], total = __shfl(incl, 63);
            pst[lane] = st * 256; pst[80 + lane] = (st + nt) * 256;
            if (lane == 0) pst[64] = total * 256;
            if (lane < 8) pst[320 + lane] = pst[240 + 8 * lane];
            if (lane == 8) pst[328] = total;
        }
        __syncthreads();
        const int tpw = T / F.G, t0 = F.vcu * tpw;
        for (int i = tid; i < tpw * 8; i += 512) { const size_t o = (size_t)t0 * 8 + i; const int e = EIDX[o], dest = pst[e] + SLOT[o]; POS[o] = dest; ROWTOK[dest] = (int)(o >> 3); ROWW[dest] = WTS[o]; }
        for (int e = F.vcu; e < 64; e += F.G) {
            const int cn = (int)__hip_atomic_load(&F.ctl[CW_CNT + e], __ATOMIC_RELAXED, __HIP_MEMORY_SCOPE_AGENT);
            for (int r = pst[e] + cn + tid; r < pst[80 + e]; r += 512) { ROWTOK[r] = 0; ROWW[r] = 0.f; }
            for (int tl = pst[e] / 256 + tid; tl < pst[80 + e] / 256; tl += 512) TILEE[tl] = e;
        }
        if (F.vcu == 0 && tid == 0) TILEE[1023] = pst[64] / 256;
        if (F.vcu == 0 && tid < 9) TILEE[1008 + tid] = pst[320 + tid];
        __syncthreads();
    }
    SEAM(12);
    }
    REP(13) {
    if (IN(13)) { PHASE_BEGIN();
        const int gx = (int)blockIdx.x & 7, gt0 = TILEE[1008 + gx], gnt = TILEE[1009 + gx] - gt0;
        if (GSEL & 1) { pg8::Gemm g{(const bf16_t*)(ws + WS_H2F8), WEG, 1024, 1024, 1024, 0x7f7f7f7f, 0x79797979}; pg8::MoeOrder S{gt0, gnt, 4, F.G >> 3, (int)blockIdx.x >> 3, TILEE, ROWTOK}; pg8::EpiSwiglu8 E{(unsigned char*)ACT};
          pg8::gemm_phase<pg8::EpiSwiglu8, pg8::MoeOrder, true, true>(F.lds, g, S, E, tid); }
        {
          pg8::Gemm g{ACTSH, WSHD, 256, 256, 256, 0x7c7c7c7c, 0x79797979}; pg8::DenseOrder S; S.init(64, 8, F.G, (int)blockIdx.x); pg8::EpiRowScale E{(bf16_t*)(ws + WS_YSH), 2048, nullptr};
          pg8::gemm_phase<pg8::EpiRowScale, pg8::DenseOrder, false, true>(F.lds, g, S, E, tid); }
    }
    SEAM(13);
    }
    REP(14) {
    if (IN(14)) { PHASE_BEGIN();
        const int gx = (int)blockIdx.x & 7, gt0 = TILEE[1008 + gx], gnt = TILEE[1009 + gx] - gt0;
        pg8::Gemm g{ACT, WED, 256, 256, 256, 0x7c7c7c7c, 0x79797979}; pg8::MoeOrder S{gt0, gnt, 8, F.G >> 3, (int)blockIdx.x >> 3, TILEE, ROWTOK}; pg8::EpiDown E{(unsigned char*)(ws + WS_Y2B), ROWW};
        pg8::gemm_phase<pg8::EpiDown, pg8::MoeOrder, false, true>(F.lds, g, S, E, tid);
    }
    SEAM(14);
    }
    if (IN(15)) { PHASE_BEGIN();
        for (int t = F.gw; t < T; t += F.NGW) {
            f32x4 x[8];
#pragma unroll
            for (int j = 0; j < 8; ++j) x[j] = *((const f32x4*)(OUT + (size_t)t * D) + lane + 64 * j);
            int pk[8]; float wk[8]; unsigned yw[8][8];
#pragma unroll
            for (int j = 0; j < 8; ++j) { const u32x2 w = *((const u32x2*)((const bf16_t*)(ws + WS_YSH) + (size_t)t * D) + lane + 64 * j); x[j][0] += bflo(w.x); x[j][1] += bfhi(w.x); x[j][2] += bflo(w.y); x[j][3] += bfhi(w.y); }
#pragma unroll
            for (int k = 0; k < 8; ++k) pk[k] = POS[(size_t)t * 8 + k];
#pragma unroll
            for (int k = 0; k < 8; ++k) wk[k] = ROWW[pk[k]] * (1.f / Y8_SCALE);
#pragma unroll
            for (int k = 0; k < 8; ++k) { const unsigned* yr = (const unsigned*)(ws + WS_Y2B + (size_t)pk[k] * 2048) + lane;
#pragma unroll
                for (int j = 0; j < 8; ++j) yw[k][j] = yr[64 * j]; }
#pragma unroll
            for (int k = 0; k < 8; ++k)
#pragma unroll
                for (int j = 0; j < 8; ++j) { const unsigned w = yw[k][j]; const auto lo = __builtin_amdgcn_cvt_pk_f32_fp8((int)w, false), hi = __builtin_amdgcn_cvt_pk_f32_fp8((int)w, true);
                    x[j][0] += lo[0] * wk[k]; x[j][1] += lo[1] * wk[k]; x[j][2] += hi[0] * wk[k]; x[j][3] += hi[1] * wk[k]; }
#pragma unroll
            for (int j = 0; j < 8; ++j) *((f32x4*)(OUT + (size_t)t * D) + lane + 64 * j) = x[j];
            float s = 0.f;
#pragma unroll
            for (int j = 0; j < 8; ++j) s += (x[j][0] * x[j][0] + x[j][1] * x[j][1]) + (x[j][2] * x[j][2] + x[j][3] * x[j][3]);
            const float rstd = 1.0f / sqrtf(wave_sum(s) * (1.f / 2048.f) + NORM_EPS);
#pragma unroll
            for (int j = 0; j < 8; ++j) { const f32x4 gq = *((const f32x4*)INP(36) + lane + 64 * j); const f32x4 y = x[j] * rstd * gq; ((unsigned*)((unsigned char*)XN3 + (size_t)t * D))[lane + 64 * j] = pk4_fp8(y); }
        }
    }
    SEAM(15);
    REP(18) {
    if (IN(18)) { PHASE_BEGIN();
        pg8::Gemm g{XN3, WPG, 1024, 1024, 1024, 0x7f7f7f7f, 0x79797979}; pg8::DenseOrder S; S.init(64, 8, F.G, (int)blockIdx.x); float dsc = 1.0f;
#if CHUNK_DEBUG
        { const float dn = (float)*(const unsigned long long*)&F.ctl[CW_DBG], dd = (float)*(const unsigned long long*)&F.ctl[CW_DBG + 2]; dsc = 1.0f + DBG_GAIN * sqrtf(dn / fmaxf(dd, 1.f)); }
#endif
        pg8::EpiFinal E{OUT, PLERAW, RSTDP, INP(35), dsc};
        pg8::gemm_phase<pg8::EpiFinal, pg8::DenseOrder, false, true>(F.lds, g, S, E, tid);
    }
    SEAM(18);
    }
#undef IN
#undef SEAM
#undef OUT
#undef INP
#undef PHASE_BEGIN
}

#ifndef N_LAUNCH_PER_PHASE
#define N_LAUNCH_PER_PHASE 0
#endif
extern "C" void kernel_launch(void* const* d_in, const int* in_sizes, int n_in, void* d_out, int out_size, void* d_ws, size_t ws_size, hipStream_t stream) {
    static int grid = 0;
    if (grid == 0) {
        if (n_in != 38 || out_size != T * D || ws_size < WS_END) { fprintf(stderr, "kernel_launch: unexpected shapes (n_in %d out %d ws %zu)\n", n_in, out_size, ws_size); grid = -1; return; }
        int dev = 0, cus = 0, per_cu = 0;
        if (hipGetDevice(&dev) != hipSuccess || hipDeviceGetAttribute(&cus, hipDeviceAttributeMultiprocessorCount, dev) != hipSuccess) { grid = -1; return; }
        if (hipFuncSetAttribute((const void*)hybrid_fwd, hipFuncAttributeMaxDynamicSharedMemorySize, LDS_BYTES) != hipSuccess) { fprintf(stderr, "kernel_launch: hipFuncSetAttribute failed\n"); grid = -1; return; }
        if (hipOccupancyMaxActiveBlocksPerMultiprocessor(&per_cu, (const void*)hybrid_fwd, 512, LDS_BYTES) != hipSuccess || per_cu < 1) fprintf(stderr, "kernel_launch: occupancy query reports %d\n", per_cu);
        (void)hipGetLastError();
        grid = cus;
    }
    if (grid < 0) return;
    (void)hipMemsetAsync((char*)d_ws + WS_CTL, 0, ZERO_BYTES, stream);
    Args a{};
    for (int i = 0; i < 38; ++i) a.in[i] = (const float*)d_in[i];
    a.pos = (const int*)d_in[2]; a.out = (float*)d_out; a.ws = (unsigned char*)d_ws;
#if N_LAUNCH_PER_PHASE
    for (int ph = 0; ph < NPH; ++ph) { a.ph_lo = ph; a.ph_hi = ph + 1; hipLaunchKernelGGL(hybrid_fwd, dim3(grid), dim3(512), LDS_BYTES, stream, a); }
#else
    a.ph_lo = 0; a.ph_hi = NPH; hipLaunchKernelGGL(hybrid_fwd, dim3(grid), dim3(512), LDS_BYTES, stream, a);
#endif
}
```
